# Optimizing an MI355X kernel written in HIP

```python
import math
import jax, jax.numpy as jnp
from jax import lax
import numpy as np

D_MODEL = 1024
BATCH = 2
SEQ = 8192
DEPTH = 2

N_A_LAYERS = DEPTH // 2
N_B_LAYERS = DEPTH - N_A_LAYERS
RET_HEADS = 4
RET_QK_DIM = D_MODEL // RET_HEADS
RET_V_DIM = 2 * RET_QK_DIM
RET_CHUNK = 128
RET_ROT_BASE = 10000.0
ATT_HEADS = 8
ATT_HEAD_DIM = D_MODEL // ATT_HEADS
ROPE_DIM = ATT_HEAD_DIM // 4
ROPE_THETA = 500000.0
MOBA_BLOCK = 256
MOBA_TOPK = 3
MOBA_Q_CHUNK = 32
N_GROUPS = 4
EXPERTS_PER_GROUP = 4
D_EXPERT = D_MODEL // 2
EXPERT_TOPK = 2
NORM_EPS = 1e-6

kernel_name = 'yoco_retention_moba_hmoe'


def rms_norm(x, g):
    x32 = x.astype(jnp.float32)
    y = x32 * lax.rsqrt(jnp.mean(x32 * x32, axis=-1, keepdims=True) + NORM_EPS)
    return (y * g.astype(jnp.float32)).astype(x.dtype)


def rotary(x, pos, rot_dim, theta):
    half = rot_dim // 2
    inv = 1.0 / (theta ** (jnp.arange(half, dtype=jnp.float32) / half))
    ang = pos.astype(jnp.float32)[:, None] * inv[None, :]
    cos = jnp.cos(ang)[:, None, :]
    sin = jnp.sin(ang)[:, None, :]
    xr = x[..., :rot_dim].astype(jnp.float32)
    x1, x2 = xr[..., :half], xr[..., half:]
    rot = jnp.concatenate([x1 * cos - x2 * sin, x2 * cos + x1 * sin], axis=-1).astype(x.dtype)
    return jnp.concatenate([rot, x[..., rot_dim:]], axis=-1)


def retention(x, w_in, w_out):
    B, S, _ = x.shape
    H, dk, dv, C = RET_HEADS, RET_QK_DIM, RET_V_DIM, RET_CHUNK
    f32 = jnp.float32
    proj = x @ w_in
    q, k, v, g = jnp.split(proj, [H * dk, 2 * H * dk, 2 * H * dk + H * dv], axis=-1)
    pos = jnp.arange(S)
    q = rotary(q.reshape(B, S, H, dk), pos, dk, RET_ROT_BASE)
    k = rotary(k.reshape(B, S, H, dk), pos, dk, RET_ROT_BASE) * (dk ** -0.5)
    v = v.reshape(B, S, H, dv)
    n_c = S // C
    qc = q.astype(f32).reshape(B, n_c, C, H, dk).transpose(1, 0, 3, 2, 4)
    kc = k.astype(f32).reshape(B, n_c, C, H, dk).transpose(1, 0, 3, 2, 4)
    vc = v.astype(f32).reshape(B, n_c, C, H, dv).transpose(1, 0, 3, 2, 4)
    log_gamma = jnp.log1p(-jnp.power(2.0, -5.0 - jnp.arange(H, dtype=f32)))
    idx = jnp.arange(C, dtype=f32)
    diff = idx[:, None] - idx[None, :]
    decay_mask = jnp.where(diff >= 0, jnp.exp(log_gamma[:, None, None] * jnp.maximum(diff, 0.0)), 0.0)
    q_decay = jnp.exp(log_gamma[:, None] * (idx + 1.0))
    k_decay = jnp.exp(log_gamma[:, None] * (C - 1.0 - idx))
    chunk_decay = jnp.exp(log_gamma * C)
    scores = jnp.einsum('nbhcd,nbhmd->nbhcm', qc, kc) * decay_mask[None, None]
    o_intra = jnp.einsum('nbhcm,nbhme->nbhce', scores, vc)

    def step(state, inp):
        qi, ki, vi = inp
        o = jnp.einsum('bhcd,bhde->bhce', qi * q_decay[None, :, :, None], state)
        state = state * chunk_decay[None, :, None, None] + jnp.einsum(
            'bhcd,bhce->bhde', ki * k_decay[None, :, :, None], vi)
        return state, o

    state0 = jnp.zeros((B, H, dk, dv), f32)
    _, o_cross = lax.scan(step, state0, (qc, kc, vc))
    o = (o_intra + o_cross).transpose(1, 0, 3, 2, 4).reshape(B, S, H, dv)
    o = o * lax.rsqrt(jnp.mean(o * o, axis=-1, keepdims=True) + NORM_EPS)
    y = jax.nn.silu(g.astype(f32)) * o.reshape(B, S, H * dv)
    return y.astype(x.dtype) @ w_out


def shared_kv(h, kv_norm, w_kv):
    B, S, _ = h.shape
    H, dh, BLK = ATT_HEADS, ATT_HEAD_DIM, MOBA_BLOCK
    hn = rms_norm(h, kv_norm)
    k, v = jnp.split(hn @ w_kv, 2, axis=-1)
    k = rotary(k.reshape(B, S, H, dh), jnp.arange(S), ROPE_DIM, ROPE_THETA)
    v = v.reshape(B, S, H, dh)
    n_blk = -(-S // BLK)
    pad = n_blk * BLK - S
    k = jnp.pad(k, ((0, 0), (0, pad), (0, 0), (0, 0))).transpose(0, 2, 1, 3).reshape(B, H, n_blk, BLK, dh)
    v = jnp.pad(v, ((0, 0), (0, pad), (0, 0), (0, 0))).transpose(0, 2, 1, 3).reshape(B, H, n_blk, BLK, dh)
    k_mean = jnp.mean(k.astype(jnp.float32), axis=3).astype(k.dtype)
    return k, v, k_mean


def moba_attention(x, w_q, w_o, kb, vb, k_mean):
    B, S, _ = x.shape
    H, dh, BLK, QC = ATT_HEADS, ATT_HEAD_DIM, MOBA_BLOCK, MOBA_Q_CHUNK
    n_blk = kb.shape[2]
    s_pad = n_blk * BLK
    topk = min(MOBA_TOPK, n_blk)
    q = (x @ w_q).reshape(B, S, H, dh)
    q = rotary(q, jnp.arange(S), ROPE_DIM, ROPE_THETA) * (dh ** -0.5)
    q = jnp.pad(q, ((0, 0), (0, s_pad - S), (0, 0), (0, 0))).transpose(0, 2, 1, 3)
    n_qc = s_pad // QC
    qs = q.reshape(B, H, n_qc, QC, dh).transpose(2, 0, 1, 3, 4)
    b_idx = jnp.arange(B)[:, None, None, None]
    h_idx = jnp.arange(H)[None, :, None, None]
    blk_ids = jnp.arange(n_blk)
    neg_inf = -jnp.inf

    def attend(args):
        qi, ci = args
        q0 = ci * QC
        blk = q0 // BLK
        gate = jnp.einsum('bhqd,bhnd->bhqn', qi, k_mean).astype(jnp.float32)
        gate = jnp.where(blk_ids < blk, gate, neg_inf)
        _, sel = lax.top_k(gate, topk)
        slot_ok = jnp.arange(topk) < blk
        ks = kb[b_idx, h_idx, sel]
        vs = vb[b_idx, h_idx, sel]
        s_sel = jnp.einsum('bhqd,bhqnkd->bhqnk', qi, ks).astype(jnp.float32)
        s_sel = jnp.where(slot_ok[:, None], s_sel, neg_inf).reshape(B, H, QC, topk * BLK)
        k_own = lax.dynamic_index_in_dim(kb, blk, axis=2, keepdims=False)
        v_own = lax.dynamic_index_in_dim(vb, blk, axis=2, keepdims=False)
        s_own = jnp.einsum('bhqd,bhkd->bhqk', qi, k_own).astype(jnp.float32)
        q_pos = q0 + jnp.arange(QC)
        k_pos = blk * BLK + jnp.arange(BLK)
        s_own = jnp.where(k_pos[None, :] <= q_pos[:, None], s_own, neg_inf)
        p = jax.nn.softmax(jnp.concatenate([s_sel, s_own], axis=-1), axis=-1).astype(vb.dtype)
        p_sel = p[..., :topk * BLK].reshape(B, H, QC, topk, BLK)
        p_own = p[..., topk * BLK:]
        return (jnp.einsum('bhqnk,bhqnkd->bhqd', p_sel, vs)
                + jnp.einsum('bhqk,bhkd->bhqd', p_own, v_own))

    o = lax.map(attend, (qs, jnp.arange(n_qc)))
    o = o.transpose(1, 0, 3, 2, 4).reshape(B, s_pad, H * dh)[:, :S]
    return o @ w_o


def hier_moe(x, w_rg, b_rg, w_re, b_re, w_gate, w_up, w_down):
    B, S, D = x.shape
    G, E = N_GROUPS, EXPERTS_PER_GROUP
    t = x.reshape(-1, D)
    g_prob = jax.nn.softmax((t @ w_rg).astype(jnp.float32) + b_rg, axis=-1)
    g_val, g_idx = lax.top_k(g_prob, 1)
    e_logits_all = jnp.einsum('td,gde->tge', t, w_re).astype(jnp.float32) + b_re
    e_logits = jnp.take_along_axis(e_logits_all, g_idx[:, :, None], axis=1)[:, 0]
    e_val, e_idx = lax.top_k(e_logits, EXPERT_TOPK)
    e_w = jax.nn.softmax(e_val, axis=-1)
    within = jnp.sum(jax.nn.one_hot(e_idx, E) * e_w[..., None], axis=1)
    group_w = jax.nn.one_hot(g_idx[:, 0], G) * g_val
    combine = (group_w[:, :, None] * within[:, None, :]).astype(x.dtype)
    y = jnp.zeros_like(t)
    for g in range(G):
        hg = jax.nn.silu(jnp.einsum('td,edf->tef', t, w_gate[g])) * jnp.einsum('td,edf->tef', t, w_up[g])
        y = y + jnp.einsum('tef,efd->td', hg * combine[:, g, :, None], w_down[g])
    return y.reshape(B, S, D)


def setup_inputs(seed: int = 0) -> dict:
    key = jax.random.key(seed)
    ks = jax.random.split(key, 18)
    f32 = jnp.float32

    def normal(k, shape, scale):
        return jax.random.normal(k, shape, f32) * scale

    def gain(k, shape):
        return 1.0 + 0.05 * jax.random.normal(k, shape, f32)

    out_scale = (2.0 * DEPTH) ** -0.5
    ret_in_cols = 2 * RET_HEADS * RET_QK_DIM + 2 * RET_HEADS * RET_V_DIM
    att_w = ATT_HEADS * ATT_HEAD_DIM
    return {
        'x': normal(ks[0], (BATCH, SEQ, D_MODEL), 1.0),
        'ret_norm': gain(ks[1], (N_A_LAYERS, D_MODEL)),
        'ret_w_in': normal(ks[2], (N_A_LAYERS, D_MODEL, ret_in_cols), D_MODEL ** -0.5),
        'ret_w_out': normal(ks[3], (N_A_LAYERS, RET_HEADS * RET_V_DIM, D_MODEL), (RET_HEADS * RET_V_DIM) ** -0.5 * out_scale),
        'kv_norm': gain(ks[4], (D_MODEL,)),
        'w_kv': normal(ks[5], (D_MODEL, 2 * att_w), D_MODEL ** -0.5),
        'attn_norm': gain(ks[6], (N_B_LAYERS, D_MODEL)),
        'w_q': normal(ks[7], (N_B_LAYERS, D_MODEL, att_w), D_MODEL ** -0.5),
        'w_o': normal(ks[8], (N_B_LAYERS, att_w, D_MODEL), att_w ** -0.5 * out_scale),
        'ffn_norm': gain(ks[9], (DEPTH, D_MODEL)),
        'router_group_w': normal(ks[10], (DEPTH, D_MODEL, N_GROUPS), D_MODEL ** -0.5),
        'router_group_b': normal(ks[11], (DEPTH, N_GROUPS), 0.01),
        'router_expert_w': normal(ks[12], (DEPTH, N_GROUPS, D_MODEL, EXPERTS_PER_GROUP), D_MODEL ** -0.5),
        'router_expert_b': normal(ks[13], (DEPTH, N_GROUPS, EXPERTS_PER_GROUP), 0.01),
        'expert_w_gate': normal(ks[14], (DEPTH, N_GROUPS, EXPERTS_PER_GROUP, D_MODEL, D_EXPERT), D_MODEL ** -0.5),
        'expert_w_up': normal(ks[15], (DEPTH, N_GROUPS, EXPERTS_PER_GROUP, D_MODEL, D_EXPERT), D_MODEL ** -0.5),
        'expert_w_down': normal(ks[16], (DEPTH, N_GROUPS, EXPERTS_PER_GROUP, D_EXPERT, D_MODEL), D_EXPERT ** -0.5 * out_scale),
        'final_norm': gain(ks[17], (D_MODEL,)),
    }


def reference(x, ret_norm, ret_w_in, ret_w_out, kv_norm, w_kv, attn_norm, w_q, w_o,
              ffn_norm, router_group_w, router_group_b, router_expert_w, router_expert_b,
              expert_w_gate, expert_w_up, expert_w_down, final_norm):
    h = x
    kb = vb = k_mean = None
    for layer in range(DEPTH):
        if layer < N_A_LAYERS:
            h = h + retention(rms_norm(h, ret_norm[layer]), ret_w_in[layer], ret_w_out[layer])
        else:
            if layer == N_A_LAYERS:
                kb, vb, k_mean = shared_kv(h, kv_norm, w_kv)
            j = layer - N_A_LAYERS
            h = h + moba_attention(rms_norm(h, attn_norm[j]), w_q[j], w_o[j], kb, vb, k_mean)
        h = h + hier_moe(rms_norm(h, ffn_norm[layer]), router_group_w[layer], router_group_b[layer],
                         router_expert_w[layer], router_expert_b[layer], expert_w_gate[layer],
                         expert_w_up[layer], expert_w_down[layer])
    return rms_norm(h, final_norm)
```

```cpp
#include <hip/hip_runtime.h>
#include <hip/hip_cooperative_groups.h>
#include <cstdio>
#include <cstdint>
namespace cg = cooperative_groups;

#ifndef MK_SINGLE
#define MK_SINGLE 0
#endif

typedef unsigned short bf16_t;
constexpr int T = 16384, SEQ = 8192;
constexpr size_t MiB = (size_t)1 << 20;
constexpr size_t OFF_CTRL = 0, OFF_ROUTE = 1 * MiB, OFF_KMEAN = 3 * MiB, OFF_TABRET = 4 * MiB, OFF_TABROPE = 12 * MiB,
                 OFF_WB = 16 * MiB, OFF_XN = 40 * MiB, OFF_BIG = 72 * MiB, WS_NEED = 296 * MiB;
constexpr size_t B_QK = 0, B_V = 64 * MiB, B_O = 128 * MiB, B_ST = 192 * MiB;
constexpr size_t B_HG = 48 * MiB, B_YG = 84 * MiB;
constexpr size_t B_K = 0, B_VB = 32 * MiB, B_Q = 64 * MiB, B_PART = 96 * MiB, B_AO = 192 * MiB;

struct Params {
    const float *x, *ret_norm, *ret_w_in, *ret_w_out, *kv_norm, *w_kv, *attn_norm, *w_q, *w_o, *ffn_norm, *rg_w, *rg_b, *re_w, *re_b, *wg, *wu, *wd, *final_norm;
    float* out; unsigned char* ws;
};

__device__ __forceinline__ bf16_t f2bf(float f) { unsigned u = __float_as_uint(f); u += 0x7fffu + ((u >> 16) & 1u); return (bf16_t)(u >> 16); }
__device__ __forceinline__ float bf2f(bf16_t h) { return __uint_as_float(((unsigned)h) << 16); }
__device__ __forceinline__ float bflo(unsigned u) { return __uint_as_float(u << 16); }
__device__ __forceinline__ float bfhi(unsigned u) { return __uint_as_float(u & 0xffff0000u); }
__device__ __forceinline__ unsigned pack2(float a, float b) { return (unsigned)f2bf(a) | ((unsigned)f2bf(b) << 16); }
__device__ __forceinline__ float wsum(float v) { for (int o = 32; o > 0; o >>= 1) v += __shfl_xor(v, o); return v; }
__device__ __forceinline__ float wmax(float v) { for (int o = 32; o > 0; o >>= 1) v = fmaxf(v, __shfl_xor(v, o)); return v; }
__device__ __forceinline__ float silu(float v) { return v / (1.f + __expf(-v)); }

__device__ void sincos_big(double a, double& s, double& c) {
    const double twopi = 6.283185307179586476925286766559;
    double k = rint(a / twopi); double r = a - k * twopi;
    double x2 = r * r, ts = r, tc = 1.0; s = r; c = 1.0;
#pragma unroll 1
    for (int n = 1; n <= 16; ++n) { tc *= -x2 / (double)((2 * n - 1) * (2 * n)); c += tc; ts *= -x2 / (double)((2 * n) * (2 * n + 1)); s += ts; }
}

struct Route { int* cnt; int *e0, *e1, *p0, *p1; float *w0, *w1; int* list; };
__device__ __forceinline__ Route get_route(const Params& p, int L) {
    Route r; r.cnt = (int*)(p.ws + OFF_CTRL) + L * 16;
    unsigned char* b = p.ws + OFF_ROUTE;
    r.e0 = (int*)b; r.e1 = r.e0 + T; r.p0 = r.e1 + T; r.p1 = r.p0 + T; r.w0 = (float*)(r.p1 + T); r.w1 = r.w0 + T; r.list = (int*)(b + 512 * 1024);
    return r;
}
__device__ __forceinline__ int expert_base(const int* cnt, int e) { int s = 0; for (int i = 0; i < e; ++i) s += (cnt[i] + 255) & ~255; return s; }

template <int MODE>
__device__ void norm_pass(const Params& p, int L) {
    const int wave = threadIdx.x >> 6, lane = threadIdx.x & 63;
    bf16_t* XN = (bf16_t*)(p.ws + OFF_XN);
    const bf16_t* YG = (const bf16_t*)(p.ws + OFF_BIG + B_YG);
    Route R = get_route(p, L);
    for (int t = blockIdx.x * 8 + wave; t < T; t += gridDim.x * 8) {
        const float* src = (MODE == 0 ? p.x : p.out) + (size_t)t * 1024;
        float4 v[4];
#pragma unroll
        for (int j = 0; j < 4; ++j) v[j] = *(const float4*)(src + j * 256 + lane * 4);
        if (MODE >= 2) {
            const int r0 = expert_base(R.cnt, R.e0[t]) + R.p0[t], r1 = expert_base(R.cnt, R.e1[t]) + R.p1[t];
#pragma unroll
            for (int j = 0; j < 4; ++j) {
                uint2 a = *(const uint2*)(YG + (size_t)r0 * 1024 + j * 256 + lane * 4), b = *(const uint2*)(YG + (size_t)r1 * 1024 + j * 256 + lane * 4);
                v[j].x += bflo(a.x) + bflo(b.x); v[j].y += bfhi(a.x) + bfhi(b.x); v[j].z += bflo(a.y) + bflo(b.y); v[j].w += bfhi(a.y) + bfhi(b.y);
            }
        }
        float ss = 0.f;
#pragma unroll
        for (int j = 0; j < 4; ++j) ss += v[j].x * v[j].x + v[j].y * v[j].y + v[j].z * v[j].z + v[j].w * v[j].w;
        ss = wsum(ss);
        const float rstd = 1.0f / sqrtf(ss * (1.0f / 1024.0f) + 1e-6f);
        if (MODE == 2) {
#pragma unroll
            for (int j = 0; j < 4; ++j) *(float4*)(p.out + (size_t)t * 1024 + j * 256 + lane * 4) = v[j];
        }
        if (MODE == 3) {
#pragma unroll
            for (int j = 0; j < 4; ++j) { float4 g = *(const float4*)(p.final_norm + j * 256 + lane * 4);
                float4 o; o.x = v[j].x * rstd * g.x; o.y = v[j].y * rstd * g.y; o.z = v[j].z * rstd * g.z; o.w = v[j].w * rstd * g.w;
                *(float4*)(p.out + (size_t)t * 1024 + j * 256 + lane * 4) = o; }
        } else {
#pragma unroll
            for (int j = 0; j < 4; ++j) { uint2 o; o.x = pack2(v[j].x * rstd, v[j].y * rstd); o.y = pack2(v[j].z * rstd, v[j].w * rstd);
                *(uint2*)(XN + (size_t)t * 1024 + j * 256 + lane * 4) = o; }
        }
        if (MODE == 1) {
            float acc[20];
#pragma unroll
            for (int i = 0; i < 20; ++i) acc[i] = 0.f;
#pragma unroll
            for (int j = 0; j < 4; ++j) {
                const float4 gn = *(const float4*)(p.ffn_norm + L * 1024 + j * 256 + lane * 4);
                const float tk[4] = {v[j].x * rstd * gn.x, v[j].y * rstd * gn.y, v[j].z * rstd * gn.z, v[j].w * rstd * gn.w};
#pragma unroll
                for (int c = 0; c < 4; ++c) {
                    const int k = j * 256 + lane * 4 + c;
                    const float4 w = *(const float4*)(p.rg_w + ((size_t)L * 1024 + k) * 4);
                    acc[0] += tk[c] * w.x; acc[1] += tk[c] * w.y; acc[2] += tk[c] * w.z; acc[3] += tk[c] * w.w;
#pragma unroll
                    for (int g = 0; g < 4; ++g) { const float4 we = *(const float4*)(p.re_w + (((size_t)L * 4 + g) * 1024 + k) * 4);
                        acc[4 + g * 4 + 0] += tk[c] * we.x; acc[4 + g * 4 + 1] += tk[c] * we.y; acc[4 + g * 4 + 2] += tk[c] * we.z; acc[4 + g * 4 + 3] += tk[c] * we.w; }
                }
            }
#pragma unroll
            for (int i = 0; i < 20; ++i) acc[i] = wsum(acc[i]);
            float lg[4];
#pragma unroll
            for (int g = 0; g < 4; ++g) lg[g] = acc[g] + p.rg_b[L * 4 + g];
            int gi = 0; float gm = lg[0];
#pragma unroll
            for (int g = 1; g < 4; ++g) if (lg[g] > gm) { gm = lg[g]; gi = g; }
            float den = 0.f;
#pragma unroll
            for (int g = 0; g < 4; ++g) den += expf(lg[g] - gm);
            const float gval = 1.0f / den;
            float el[4] = {0.f, 0.f, 0.f, 0.f};
#pragma unroll
            for (int g = 0; g < 4; ++g) if (g == gi) {
#pragma unroll
                for (int e = 0; e < 4; ++e) el[e] = acc[4 + g * 4 + e] + p.re_b[(L * 4 + g) * 4 + e]; }
            int i0 = 0; float v0 = el[0];
#pragma unroll
            for (int e = 1; e < 4; ++e) if (el[e] > v0) { v0 = el[e]; i0 = e; }
            int i1 = -1; float v1 = -INFINITY;
#pragma unroll
            for (int e = 0; e < 4; ++e) if (e != i0 && el[e] > v1) { v1 = el[e]; i1 = e; }
            const float ex = expf(v1 - v0); const float ew0 = 1.0f / (1.0f + ex), ew1 = ex / (1.0f + ex);
            if (lane == 0) {
                const int ea = gi * 4 + i0, eb = gi * 4 + i1;
                const int pa = atomicAdd(R.cnt + ea, 1), pb = atomicAdd(R.cnt + eb, 1);
                R.list[ea * T + pa] = t; R.list[eb * T + pb] = t;
                R.e0[t] = ea; R.e1[t] = eb; R.p0[t] = pa; R.p1[t] = pb; R.w0[t] = gval * ew0; R.w1[t] = gval * ew1;
            }
        }
    }
}

template <int NB, class AF, class BF, class EF>
__device__ __forceinline__ void gemm_tile_naive(int K, const AF& af, const BF& bf, const EF& ef, float* sm) {
    float (*As)[132] = (float (*)[132])sm;
    float (*Bs)[16][68] = (float (*)[16][68])(sm + 16 * 132);
    const int tid = threadIdx.x, ty = tid >> 4, tx = tid & 15;
    float acc[NB][4][4];
#pragma unroll
    for (int n = 0; n < NB; ++n)
#pragma unroll
        for (int i = 0; i < 4; ++i)
#pragma unroll
            for (int j = 0; j < 4; ++j) acc[n][i][j] = 0.f;
    const int ar = tid >> 2, ak = (tid & 3) * 4, bk = tid >> 5, bc = (tid & 31) * 2;
    for (int k0 = 0; k0 < K; k0 += 16) {
        const float4 a = af(ar, k0 + ak);
        float2 b[NB];
#pragma unroll
        for (int n = 0; n < NB; ++n) b[n] = bf(n, k0 + bk, bc);
        __syncthreads();
        As[ak + 0][ar] = a.x; As[ak + 1][ar] = a.y; As[ak + 2][ar] = a.z; As[ak + 3][ar] = a.w;
#pragma unroll
        for (int n = 0; n < NB; ++n) { Bs[n][bk][bc] = b[n].x; Bs[n][bk][bc + 1] = b[n].y; }
        __syncthreads();
#pragma unroll
        for (int kk = 0; kk < 16; ++kk) {
            const float4 av = *(const float4*)&As[kk][ty * 4];
            const float a4[4] = {av.x, av.y, av.z, av.w};
#pragma unroll
            for (int n = 0; n < NB; ++n) { const float4 bv = *(const float4*)&Bs[n][kk][tx * 4]; const float b4[4] = {bv.x, bv.y, bv.z, bv.w};
#pragma unroll
                for (int i = 0; i < 4; ++i)
#pragma unroll
                    for (int j = 0; j < 4; ++j) acc[n][i][j] += a4[i] * b4[j]; }
        }
    }
#pragma unroll
    for (int i = 0; i < 4; ++i)
#pragma unroll
        for (int j = 0; j < 4; ++j) ef(ty * 4 + i, tx * 4 + j, acc[0][i][j], NB == 2 ? acc[NB - 1][i][j] : 0.f);
}

__device__ __forceinline__ float4 ld_bf4(const bf16_t* p) { const uint2 u = *(const uint2*)p; return make_float4(bflo(u.x), bfhi(u.x), bflo(u.y), bfhi(u.y)); }

template <class EF>
__device__ void gemm_dense_naive(const bf16_t* A, int lda, int K, int N, const float* B0, int ldb0, const float* gain0, int nsplit, const float* B1, int ldb1, const float* gain1, const EF& ef, float* sm) {
    const int ntn = N / 64, ntm = T / 128;
    for (int tile = blockIdx.x; tile < ntn * ntm; tile += gridDim.x) {
        const int tm = tile / ntn, tn = tile % ntn, m0 = tm * 128, n0 = tn * 64;
        const float* B; int ldb; const float* gain; int nb0;
        if (n0 < nsplit) { B = B0; ldb = ldb0; gain = gain0; nb0 = n0; } else { B = B1; ldb = ldb1; gain = gain1; nb0 = n0 - nsplit; }
        auto af = [&](int r, int k) { return ld_bf4(A + (size_t)(m0 + r) * lda + k); };
        auto bf = [&](int, int k, int c) { float2 w = *(const float2*)(B + (size_t)k * ldb + nb0 + c); const float g = gain ? gain[k] : 1.f; w.x *= g; w.y *= g; return w; };
        auto e2 = [&](int r, int c, float v, float) { ef(m0 + r, n0 + c, v); };
        gemm_tile_naive<1>(K, af, bf, e2, sm);
    }
}

template <int STAGE>
__device__ void gemm_expert_naive(const Params& p, int L, float* sm) {
    Route R = get_route(p, L);
    const bf16_t* XN = (const bf16_t*)(p.ws + OFF_XN);
    bf16_t* HG = (bf16_t*)(p.ws + OFF_BIG + B_HG); bf16_t* YG = (bf16_t*)(p.ws + OFF_BIG + B_YG);
    const int ntn = STAGE == 1 ? 512 / 64 : 1024 / 64;
    int* tstart = (int*)(sm + 6000);
    __syncthreads();
    if (threadIdx.x == 0) { int s = 0; for (int e = 0; e < 16; ++e) { tstart[e] = s; s += ((R.cnt[e] + 127) >> 7) * ntn; } tstart[16] = s; }
    __syncthreads();
    for (int tile = blockIdx.x; tile < tstart[16]; tile += gridDim.x) {
        int e = 0;
#pragma unroll 1
        for (int i = 1; i < 16; ++i) if (tile >= tstart[i]) e = i;
        const int lt = tile - tstart[e], tm = lt / ntn, tn = lt % ntn, m0 = tm * 128, n0 = tn * 64, cnt = R.cnt[e], base = expert_base(R.cnt, e);
        const int* list = R.list + e * T;
        if (STAGE == 1) {
            const float* Wg = p.wg + ((size_t)(L * 16 + e)) * 1024 * 512; const float* Wu = p.wu + ((size_t)(L * 16 + e)) * 1024 * 512; const float* gain = p.ffn_norm + L * 1024;
            auto af = [&](int r, int k) { const int rr = m0 + r; if (rr >= cnt) return make_float4(0.f, 0.f, 0.f, 0.f); return ld_bf4(XN + (size_t)list[rr] * 1024 + k); };
            auto bf = [&](int n, int k, int c) { float2 w = *(const float2*)((n == 0 ? Wg : Wu) + (size_t)k * 512 + n0 + c); const float g = gain[k]; w.x *= g; w.y *= g; return w; };
            auto ef = [&](int r, int c, float g, float u) { const int rr = m0 + r; if (rr >= cnt) return; const int tok = list[rr]; const float cw = (R.e0[tok] == e) ? R.w0[tok] : R.w1[tok];
                HG[(size_t)(base + rr) * 512 + n0 + c] = f2bf(silu(g) * u * cw); };
            gemm_tile_naive<2>(1024, af, bf, ef, sm);
        } else {
            const float* Wd = p.wd + ((size_t)(L * 16 + e)) * 512 * 1024;
            auto af = [&](int r, int k) { const int rr = m0 + r; if (rr >= cnt) return make_float4(0.f, 0.f, 0.f, 0.f); return ld_bf4(HG + (size_t)(base + rr) * 512 + k); };
            auto bf = [&](int, int k, int c) { return *(const float2*)(Wd + (size_t)k * 1024 + n0 + c); };
            auto ef = [&](int r, int c, float v, float) { const int rr = m0 + r; if (rr >= cnt) return; YG[(size_t)(base + rr) * 1024 + n0 + c] = f2bf(v); };
            gemm_tile_naive<1>(512, af, bf, ef, sm);
        }
    }
}

__device__ void phase_prologue(const Params& p) {
    const int gtid = blockIdx.x * 512 + threadIdx.x, gsz = gridDim.x * 512;
    int* cnt = (int*)(p.ws + OFF_CTRL);
    if (gtid < 64) cnt[gtid] = 0;
    float* rc = (float*)(p.ws + OFF_TABRET); float* rs = rc + 8192 * 128;
    for (int i = gtid; i < 8192 * 128; i += gsz) { const int pos = i >> 7, f = i & 127;
        const float inv = (float)exp(-9.2103403719761836 * ((double)f / 128.0));
        const float ang = (float)pos * inv; double s, c; sincos_big((double)ang, s, c); rc[i] = (float)c; rs[i] = (float)s; }
    float* pc = (float*)(p.ws + OFF_TABROPE); float* ps = pc + 8192 * 16;
    for (int i = gtid; i < 8192 * 16; i += gsz) { const int pos = i >> 4, f = i & 15;
        const float inv = (float)exp(-13.122363377404328 * ((double)f / 16.0));
        const float ang = (float)pos * inv; double s, c; sincos_big((double)ang, s, c); pc[i] = (float)c; ps[i] = (float)s; }
    norm_pass<0>(p, 0);
}

__device__ void phase_ret_rotary(const Params& p) {
    bf16_t* QK = (bf16_t*)(p.ws + OFF_BIG + B_QK);
    const float* rc = (const float*)(p.ws + OFF_TABRET); const float* rs = rc + 8192 * 128;
    const size_t total = (size_t)T * 8 * 128;
    for (size_t i = (size_t)blockIdx.x * 512 + threadIdx.x; i < total; i += (size_t)gridDim.x * 512) {
        const int f = (int)(i & 127), slot = (int)((i >> 7) & 7), t = (int)(i >> 10), pos = t & 8191;
        bf16_t* px = QK + (size_t)t * 2048 + slot * 256 + f;
        const float x1 = bf2f(px[0]), x2 = bf2f(px[128]), c = rc[pos * 128 + f], s = rs[pos * 128 + f];
        const float sc = slot >= 4 ? 0.0625f : 1.f;
        px[0] = f2bf((x1 * c - x2 * s) * sc); px[128] = f2bf((x2 * c + x1 * s) * sc);
    }
}

__device__ void phase_ret_scan(const Params& p) {
    const bf16_t* QK = (const bf16_t*)(p.ws + OFF_BIG + B_QK); const bf16_t* V = (const bf16_t*)(p.ws + OFF_BIG + B_V); bf16_t* O = (bf16_t*)(p.ws + OFF_BIG + B_O);
    const int wave = threadIdx.x >> 6, lane = threadIdx.x & 63;
    for (int item = blockIdx.x * 8 + wave; item < 2048; item += gridDim.x * 8) {
        const int b = item >> 10, h = (item >> 8) & 3, ep = item & 255;
        const float gamma = 1.f - exp2f(-5.f - (float)h);
        float S[4][2];
#pragma unroll
        for (int d = 0; d < 4; ++d) { S[d][0] = 0.f; S[d][1] = 0.f; }
        const bf16_t* qp = QK + (size_t)b * SEQ * 2048 + h * 256 + lane * 4;
        const bf16_t* kp = qp + 1024;
        const bf16_t* vp = V + (size_t)b * SEQ * 2048 + h * 512 + ep * 2;
        bf16_t* op = O + (size_t)b * SEQ * 2048 + h * 512 + ep * 2;
#pragma unroll 4
        for (int t = 0; t < SEQ; ++t) {
            const uint2 qv = *(const uint2*)(qp + (size_t)t * 2048), kv = *(const uint2*)(kp + (size_t)t * 2048); const unsigned vv = *(const unsigned*)(vp + (size_t)t * 2048);
            const float q[4] = {bflo(qv.x), bfhi(qv.x), bflo(qv.y), bfhi(qv.y)}, k[4] = {bflo(kv.x), bfhi(kv.x), bflo(kv.y), bfhi(kv.y)};
            const float v0 = bflo(vv), v1 = bfhi(vv);
            float p0 = 0.f, p1 = 0.f;
#pragma unroll
            for (int d = 0; d < 4; ++d) { S[d][0] = gamma * S[d][0] + k[d] * v0; S[d][1] = gamma * S[d][1] + k[d] * v1; p0 += q[d] * S[d][0]; p1 += q[d] * S[d][1]; }
            p0 = wsum(p0); p1 = wsum(p1);
            if (lane == 0) *(unsigned*)(op + (size_t)t * 2048) = pack2(p0, p1);
        }
    }
}

__device__ void phase_ret_gnorm(const Params& p) {
    bf16_t* O = (bf16_t*)(p.ws + OFF_BIG + B_O);
    const int wave = threadIdx.x >> 6, lane = threadIdx.x & 63;
    for (int item = blockIdx.x * 8 + wave; item < T * 4; item += gridDim.x * 8) {
        bf16_t* po = O + (size_t)item * 512 + lane * 8;
        const uint4 u = *(const uint4*)po;
        float v[8] = {bflo(u.x), bfhi(u.x), bflo(u.y), bfhi(u.y), bflo(u.z), bfhi(u.z), bflo(u.w), bfhi(u.w)};
        float ss = 0.f;
#pragma unroll
        for (int i = 0; i < 8; ++i) ss += v[i] * v[i];
        ss = wsum(ss);
        const float rstd = 1.0f / sqrtf(ss * (1.0f / 512.0f) + 1e-6f);
        uint4 o; o.x = pack2(v[0] * rstd, v[1] * rstd); o.y = pack2(v[2] * rstd, v[3] * rstd); o.z = pack2(v[4] * rstd, v[5] * rstd); o.w = pack2(v[6] * rstd, v[7] * rstd);
        *(uint4*)po = o;
    }
}

__device__ void phase_rope(const Params& p) {
    bf16_t* Kb = (bf16_t*)(p.ws + OFF_BIG + B_K); bf16_t* Qb = (bf16_t*)(p.ws + OFF_BIG + B_Q);
    const float* pc = (const float*)(p.ws + OFF_TABROPE); const float* ps = pc + 8192 * 16;
    const size_t total = (size_t)T * 2 * 8 * 16;
    for (size_t i = (size_t)blockIdx.x * 512 + threadIdx.x; i < total; i += (size_t)gridDim.x * 512) {
        const int f = (int)(i & 15), h = (int)((i >> 4) & 7), which = (int)((i >> 7) & 1), t = (int)(i >> 8), pos = t & 8191;
        bf16_t* px = (which ? Qb : Kb) + (size_t)t * 1024 + h * 128 + f;
        const float x1 = bf2f(px[0]), x2 = bf2f(px[16]), c = pc[pos * 16 + f], s = ps[pos * 16 + f];
        px[0] = f2bf(x1 * c - x2 * s); px[16] = f2bf(x2 * c + x1 * s);
    }
}
__device__ void phase_qscale(const Params& p) {
    bf16_t* Qb = (bf16_t*)(p.ws + OFF_BIG + B_Q);
    const size_t total = (size_t)T * 1024;
    const float sc = 0.08838834764831845f;
    for (size_t i = (size_t)blockIdx.x * 512 + threadIdx.x; i < total; i += (size_t)gridDim.x * 512) Qb[i] = f2bf(bf2f(Qb[i]) * sc);
}

__device__ void phase_kmean(const Params& p) {
    const bf16_t* Kb = (const bf16_t*)(p.ws + OFF_BIG + B_K); float* km = (float*)(p.ws + OFF_KMEAN);
    for (int i = blockIdx.x * 512 + threadIdx.x; i < 2 * 32 * 1024; i += gridDim.x * 512) {
        const int col = i & 1023, n = (i >> 10) & 31, b = i >> 15, h = col >> 7, d = col & 127;
        const bf16_t* pk = Kb + ((size_t)b * SEQ + n * 256) * 1024 + col;
        float s = 0.f;
        for (int j = 0; j < 256; ++j) s += bf2f(pk[(size_t)j * 1024]);
        km[(((size_t)b * 8 + h) * 32 + n) * 128 + d] = s * (1.0f / 256.0f);
    }
}

__device__ void phase_moba_naive(const Params& p, float* sm) {
    const bf16_t* Kb = (const bf16_t*)(p.ws + OFF_BIG + B_K); const bf16_t* Vb = (const bf16_t*)(p.ws + OFF_BIG + B_VB); const bf16_t* Qb = (const bf16_t*)(p.ws + OFF_BIG + B_Q);
    const float* kmean = (const float*)(p.ws + OFF_KMEAN); bf16_t* AO = (bf16_t*)(p.ws + OFF_BIG + B_AO);
    const int wave = threadIdx.x >> 6, lane = threadIdx.x & 63;
    float* qs = sm + wave * 128;
    for (int item = blockIdx.x * 8 + wave; item < T * 8; item += gridDim.x * 8) {
        const int tg = item >> 3, h = item & 7, b = tg >> 13, s = tg & 8191, blk = s >> 8;
        const unsigned qq = *(const unsigned*)(Qb + (size_t)tg * 1024 + h * 128 + lane * 2);
        qs[lane * 2] = bflo(qq); qs[lane * 2 + 1] = bfhi(qq);
        __builtin_amdgcn_wave_barrier();
        float g = -INFINITY;
        if (lane < blk) { const float* km = kmean + (((size_t)b * 8 + h) * 32 + lane) * 128; float a = 0.f; for (int d = 0; d < 128; ++d) a += qs[d] * km[d]; g = a; }
        const int nsel = blk < 3 ? blk : 3;
        int sel[3];
#pragma unroll
        for (int j = 0; j < 3; ++j) {
            sel[j] = 0;
            if (j < nsel) { const float m = wmax(g); const unsigned long long bal = __ballot(g == m); const int idx = __ffsll((long long)bal) - 1; sel[j] = idx; if (lane == idx) g = -INFINITY; }
        }
        float sc[4][4];
#pragma unroll
        for (int seg = 0; seg < 4; ++seg) {
            const int bid = seg < 3 ? sel[seg] : blk; const bool valid = seg < 3 ? (seg < nsel) : true; const int nkeys = seg < 3 ? 256 : (s - blk * 256 + 1);
#pragma unroll
            for (int kk = 0; kk < 4; ++kk) {
                const int key = kk * 64 + lane; float v = -INFINITY;
                if (valid && key < nkeys) {
                    const bf16_t* kr = Kb + ((size_t)b * SEQ + bid * 256 + key) * 1024 + h * 128; float a = 0.f;
#pragma unroll 4
                    for (int d8 = 0; d8 < 16; ++d8) { const uint4 u = *(const uint4*)(kr + d8 * 8); const float* q8 = qs + d8 * 8;
                        a += q8[0] * bflo(u.x) + q8[1] * bfhi(u.x) + q8[2] * bflo(u.y) + q8[3] * bfhi(u.y) + q8[4] * bflo(u.z) + q8[5] * bfhi(u.z) + q8[6] * bflo(u.w) + q8[7] * bfhi(u.w); }
                    v = a;
                }
                sc[seg][kk] = v;
            }
        }
        float m = -INFINITY;
#pragma unroll
        for (int seg = 0; seg < 4; ++seg)
#pragma unroll
            for (int kk = 0; kk < 4; ++kk) m = fmaxf(m, sc[seg][kk]);
        m = wmax(m);
        float l = 0.f;
#pragma unroll
        for (int seg = 0; seg < 4; ++seg)
#pragma unroll
            for (int kk = 0; kk < 4; ++kk) { const float e = expf(sc[seg][kk] - m); sc[seg][kk] = e; l += e; }
        l = wsum(l);
        float o0 = 0.f, o1 = 0.f;
#pragma unroll
        for (int seg = 0; seg < 4; ++seg) {
            const int bid = seg < 3 ? sel[seg] : blk; const bool valid = seg < 3 ? (seg < nsel) : true; const int nkeys = seg < 3 ? 256 : (s - blk * 256 + 1);
            if (valid) {
#pragma unroll
                for (int kk = 0; kk < 4; ++kk) {
                    if (kk * 64 < nkeys) {
                        const bf16_t* vr = Vb + ((size_t)b * SEQ + bid * 256 + kk * 64) * 1024 + h * 128 + lane * 2;
                        for (int src = 0; src < 64; ++src) { const float pp = __shfl(sc[seg][kk], src); const unsigned vv = *(const unsigned*)(vr + (size_t)src * 1024); o0 += pp * bflo(vv); o1 += pp * bfhi(vv); }
                    }
                }
            }
        }
        const float il = 1.0f / l;
        *(unsigned*)(AO + (size_t)tg * 1024 + h * 128 + lane * 2) = pack2(o0 * il, o1 * il);
        __builtin_amdgcn_wave_barrier();
    }
}

constexpr int NPHASE = 22;
__device__ __forceinline__ void run_phase(const Params& p, int ph, float* sm) {
    unsigned char* big = p.ws + OFF_BIG;
    const bf16_t* XN = (const bf16_t*)(p.ws + OFF_XN);
    switch (ph) {
    case 0: phase_prologue(p); break;
    case 1: { bf16_t* QK = (bf16_t*)(big + B_QK); bf16_t* V = (bf16_t*)(big + B_V);
        auto ef = [=](int r, int c, float v) { if (c < 2048) QK[(size_t)r * 2048 + c] = f2bf(v); else V[(size_t)r * 2048 + c - 2048] = f2bf(v); };
        gemm_dense_naive(XN, 1024, 1024, 4096, p.ret_w_in, 6144, p.ret_norm, 1 << 30, nullptr, 0, nullptr, ef, sm); } break;
    case 2: phase_ret_rotary(p); break;
    case 3: phase_ret_scan(p); break;
    case 4: phase_ret_gnorm(p); break;
    case 5: { bf16_t* O = (bf16_t*)(big + B_O);
        auto ef = [=](int r, int c, float v) { bf16_t* po = O + (size_t)r * 2048 + c; *po = f2bf(silu(v) * bf2f(*po)); };
        gemm_dense_naive(XN, 1024, 1024, 2048, p.ret_w_in + 4096, 6144, p.ret_norm, 1 << 30, nullptr, 0, nullptr, ef, sm); } break;
    case 6: { const bf16_t* Y = (const bf16_t*)(big + B_O); const float* x = p.x; float* out = p.out;
        auto ef = [=](int r, int c, float v) { out[(size_t)r * 1024 + c] = x[(size_t)r * 1024 + c] + v; };
        gemm_dense_naive(Y, 2048, 2048, 1024, p.ret_w_out, 1024, nullptr, 1 << 30, nullptr, 0, nullptr, ef, sm); } break;
    case 7: norm_pass<1>(p, 0); break;
    case 8: gemm_expert_naive<1>(p, 0, sm); break;
    case 9: gemm_expert_naive<2>(p, 0, sm); break;
    case 10: norm_pass<2>(p, 0); break;
    case 11: { bf16_t* Kb = (bf16_t*)(big + B_K); bf16_t* Vb = (bf16_t*)(big + B_VB); bf16_t* Qb = (bf16_t*)(big + B_Q);
        auto ef = [=](int r, int c, float v) { if (c < 1024) Kb[(size_t)r * 1024 + c] = f2bf(v); else if (c < 2048) Vb[(size_t)r * 1024 + c - 1024] = f2bf(v); else Qb[(size_t)r * 1024 + c - 2048] = f2bf(v); };
        gemm_dense_naive(XN, 1024, 1024, 3072, p.w_kv, 2048, p.kv_norm, 2048, p.w_q, 1024, p.attn_norm, ef, sm); } break;
    case 12: phase_rope(p); break;
    case 13: phase_qscale(p); break;
    case 14: phase_kmean(p); break;
    case 15: phase_moba_naive(p, sm); break;
    case 16: { const bf16_t* AO = (const bf16_t*)(big + B_AO); float* out = p.out;
        auto ef = [=](int r, int c, float v) { out[(size_t)r * 1024 + c] += v; };
        gemm_dense_naive(AO, 1024, 1024, 1024, p.w_o, 1024, nullptr, 1 << 30, nullptr, 0, nullptr, ef, sm); } break;
    case 17: norm_pass<1>(p, 1); break;
    case 18: gemm_expert_naive<1>(p, 1, sm); break;
    case 19: gemm_expert_naive<2>(p, 1, sm); break;
    case 20: norm_pass<3>(p, 1); break;
    default: break;
    }
}

#if MK_SINGLE
__global__ void __launch_bounds__(512) mega(Params p, int ph0, int ph1) {
    __shared__ __attribute__((aligned(16))) float sm[8192];
    cg::grid_group grid = cg::this_grid();
    for (int ph = ph0; ph < ph1; ++ph) {
        run_phase(p, ph, sm);
        if (ph + 1 < ph1) grid.sync();
    }
}
#endif
template <int PH> __global__ void __launch_bounds__(512) phase_kernel(Params p) {
    __shared__ __attribute__((aligned(16))) float sm[8192];
    run_phase(p, PH, sm);
}
template <int PH> static void launch_phases(const Params& p, int grid, hipStream_t stream) {
    if constexpr (PH < NPHASE - 1) { phase_kernel<PH><<<grid, 512, 0, stream>>>(p); launch_phases<PH + 1>(p, grid, stream); }
}

extern "C" void kernel_launch(void* const* d_in, const int* in_sizes, int n_in, void* d_out, int out_size, void* d_ws, size_t ws_size, hipStream_t stream) {
    if (ws_size < WS_NEED) { fprintf(stderr, "workspace too small: %zu < %zu\n", ws_size, WS_NEED); return; }
    Params p{};
    p.x = (const float*)d_in[0]; p.ret_norm = (const float*)d_in[1]; p.ret_w_in = (const float*)d_in[2]; p.ret_w_out = (const float*)d_in[3]; p.kv_norm = (const float*)d_in[4];
    p.w_kv = (const float*)d_in[5]; p.attn_norm = (const float*)d_in[6]; p.w_q = (const float*)d_in[7]; p.w_o = (const float*)d_in[8]; p.ffn_norm = (const float*)d_in[9];
    p.rg_w = (const float*)d_in[10]; p.rg_b = (const float*)d_in[11]; p.re_w = (const float*)d_in[12]; p.re_b = (const float*)d_in[13]; p.wg = (const float*)d_in[14];
    p.wu = (const float*)d_in[15]; p.wd = (const float*)d_in[16]; p.final_norm = (const float*)d_in[17];
    p.out = (float*)d_out; p.ws = (unsigned char*)d_ws;
    static int grid_blocks = 0;
    if (!grid_blocks) {
        int dev = 0, cus = 0, per_cu = 0;
        hipGetDevice(&dev);
        hipDeviceGetAttribute(&cus, hipDeviceAttributeMultiprocessorCount, dev);
        per_cu = 1;
        grid_blocks = cus * per_cu;
    }
#if MK_SINGLE
    int ph0 = 0, ph1 = NPHASE - 1;
    void* args[] = {&p, &ph0, &ph1};
    hipError_t e = hipLaunchCooperativeKernel((void*)mega, dim3(grid_blocks), dim3(512), args, 0, stream);
    if (e != hipSuccess) fprintf(stderr, "cooperative launch failed: %s (grid %d)\n", hipGetErrorString(e), grid_blocks);
#else
    launch_phases<0>(p, grid_blocks, stream);
#endif
}
```

```cpp
#include <hip/hip_runtime.h>
#include <hip/hip_cooperative_groups.h>
#include <cstdio>
#include <cstdint>
namespace cg = cooperative_groups;

#ifndef MK_SINGLE
#define MK_SINGLE 1
#endif

typedef unsigned short bf16_t;
constexpr int T = 16384, SEQ = 8192;
constexpr size_t MiB = (size_t)1 << 20;
constexpr size_t OFF_CTRL = 0, OFF_ROUTE = 1 * MiB, OFF_KMEAN = 3 * MiB, OFF_TABRET = 4 * MiB, OFF_TABROPE = 12 * MiB,
                 OFF_WB = 16 * MiB, OFF_XN = 40 * MiB, OFF_BIG = 72 * MiB, WS_NEED = 296 * MiB;
constexpr size_t B_QK = 0, B_V = 64 * MiB, B_O = 128 * MiB, B_ST = 192 * MiB;
constexpr size_t B_HG = 48 * MiB, B_YG = 84 * MiB;
constexpr size_t B_K = 0, B_VB = 32 * MiB, B_Q = 64 * MiB, B_PART = 96 * MiB, B_AO = 192 * MiB;

struct Params {
    const float *x, *ret_norm, *ret_w_in, *ret_w_out, *kv_norm, *w_kv, *attn_norm, *w_q, *w_o, *ffn_norm, *rg_w, *rg_b, *re_w, *re_b, *wg, *wu, *wd, *final_norm;
    float* out; unsigned char* ws;
};

__device__ __forceinline__ int otid() { int t = threadIdx.x; asm volatile("" : "+v"(t)); return t; }
__device__ __forceinline__ int obid() { int b = blockIdx.x; asm volatile("" : "+s"(b)); return b; }
__device__ __forceinline__ bf16_t f2bf(float f) { unsigned u = __float_as_uint(f); u += 0x7fffu + ((u >> 16) & 1u); return (bf16_t)(u >> 16); }
__device__ __forceinline__ float bf2f(bf16_t h) { return __uint_as_float(((unsigned)h) << 16); }
__device__ __forceinline__ float bflo(unsigned u) { return __uint_as_float(u << 16); }
__device__ __forceinline__ float bfhi(unsigned u) { return __uint_as_float(u & 0xffff0000u); }
__device__ __forceinline__ unsigned pack2(float a, float b) { return (unsigned)f2bf(a) | ((unsigned)f2bf(b) << 16); }
__device__ __forceinline__ float wsum(float v) { for (int o = 32; o > 0; o >>= 1) v += __shfl_xor(v, o); return v; }
__device__ __forceinline__ float wmax(float v) { for (int o = 32; o > 0; o >>= 1) v = fmaxf(v, __shfl_xor(v, o)); return v; }
__device__ __forceinline__ float silu(float v) { return v / (1.f + __expf(-v)); }

__device__ void sincos_big(double a, double& s, double& c) {
    const double twopi = 6.283185307179586476925286766559;
    double k = rint(a / twopi); double r = a - k * twopi;
    double x2 = r * r, ts = r, tc = 1.0; s = r; c = 1.0;
#pragma unroll 1
    for (int n = 1; n <= 16; ++n) { tc *= -x2 / (double)((2 * n - 1) * (2 * n)); c += tc; ts *= -x2 / (double)((2 * n) * (2 * n + 1)); s += ts; }
}

struct Route { int* cnt; int *e0, *e1, *p0, *p1; float *w0, *w1; int* list; };
__device__ __forceinline__ Route get_route(const Params& p, int L) {
    Route r; r.cnt = (int*)(p.ws + OFF_CTRL) + L * 16;
    unsigned char* b = p.ws + OFF_ROUTE;
    r.e0 = (int*)b; r.e1 = r.e0 + T; r.p0 = r.e1 + T; r.p1 = r.p0 + T; r.w0 = (float*)(r.p1 + T); r.w1 = r.w0 + T; r.list = (int*)(b + 512 * 1024);
    return r;
}
__device__ __forceinline__ int expert_base(const int* cnt, int e) { int s = 0; for (int i = 0; i < e; ++i) s += (cnt[i] + 255) & ~255; return s; }

template <int MODE>
__device__ void norm_pass(const Params& p, int L) {
    const int wave = otid() >> 6, lane = otid() & 63;
    bf16_t* XN = (bf16_t*)(p.ws + OFF_XN);
    const bf16_t* YG = (const bf16_t*)(p.ws + OFF_BIG + B_YG);
    Route R = get_route(p, L);
    for (int t = obid() * 8 + wave; t < T; t += gridDim.x * 8) {
        const float* src = (MODE == 0 ? p.x : p.out) + (size_t)t * 1024;
        float4 v[4];
#pragma unroll
        for (int j = 0; j < 4; ++j) v[j] = *(const float4*)(src + j * 256 + lane * 4);
        if (MODE >= 2) {
            const int r0 = expert_base(R.cnt, R.e0[t]) + R.p0[t], r1 = expert_base(R.cnt, R.e1[t]) + R.p1[t];
#pragma unroll
            for (int j = 0; j < 4; ++j) {
                uint2 a = *(const uint2*)(YG + (size_t)r0 * 1024 + j * 256 + lane * 4), b = *(const uint2*)(YG + (size_t)r1 * 1024 + j * 256 + lane * 4);
                v[j].x += bflo(a.x) + bflo(b.x); v[j].y += bfhi(a.x) + bfhi(b.x); v[j].z += bflo(a.y) + bflo(b.y); v[j].w += bfhi(a.y) + bfhi(b.y);
            }
        }
        float ss = 0.f;
#pragma unroll
        for (int j = 0; j < 4; ++j) ss += v[j].x * v[j].x + v[j].y * v[j].y + v[j].z * v[j].z + v[j].w * v[j].w;
        ss = wsum(ss);
        const float rstd = 1.0f / sqrtf(ss * (1.0f / 1024.0f) + 1e-6f);
        if (MODE == 2) {
#pragma unroll
            for (int j = 0; j < 4; ++j) *(float4*)(p.out + (size_t)t * 1024 + j * 256 + lane * 4) = v[j];
        }
        if (MODE == 3) {
#pragma unroll
            for (int j = 0; j < 4; ++j) { float4 g = *(const float4*)(p.final_norm + j * 256 + lane * 4);
                float4 o; o.x = v[j].x * rstd * g.x; o.y = v[j].y * rstd * g.y; o.z = v[j].z * rstd * g.z; o.w = v[j].w * rstd * g.w;
                *(float4*)(p.out + (size_t)t * 1024 + j * 256 + lane * 4) = o; }
        } else {
#pragma unroll
            for (int j = 0; j < 4; ++j) { uint2 o; o.x = pack2(v[j].x * rstd, v[j].y * rstd); o.y = pack2(v[j].z * rstd, v[j].w * rstd);
                *(uint2*)(XN + (size_t)t * 1024 + j * 256 + lane * 4) = o; }
        }
        if (MODE == 1) {
            float acc[20];
#pragma unroll
            for (int i = 0; i < 20; ++i) acc[i] = 0.f;
#pragma unroll
            for (int j = 0; j < 4; ++j) {
                const float4 gn = *(const float4*)(p.ffn_norm + L * 1024 + j * 256 + lane * 4);
                const float tk[4] = {v[j].x * rstd * gn.x, v[j].y * rstd * gn.y, v[j].z * rstd * gn.z, v[j].w * rstd * gn.w};
#pragma unroll
                for (int c = 0; c < 4; ++c) {
                    const int k = j * 256 + lane * 4 + c;
                    const float4 w = *(const float4*)(p.rg_w + ((size_t)L * 1024 + k) * 4);
                    acc[0] += tk[c] * w.x; acc[1] += tk[c] * w.y; acc[2] += tk[c] * w.z; acc[3] += tk[c] * w.w;
#pragma unroll
                    for (int g = 0; g < 4; ++g) { const float4 we = *(const float4*)(p.re_w + (((size_t)L * 4 + g) * 1024 + k) * 4);
                        acc[4 + g * 4 + 0] += tk[c] * we.x; acc[4 + g * 4 + 1] += tk[c] * we.y; acc[4 + g * 4 + 2] += tk[c] * we.z; acc[4 + g * 4 + 3] += tk[c] * we.w; }
                }
            }
#pragma unroll
            for (int i = 0; i < 20; ++i) acc[i] = wsum(acc[i]);
            float lg[4];
#pragma unroll
            for (int g = 0; g < 4; ++g) lg[g] = acc[g] + p.rg_b[L * 4 + g];
            int gi = 0; float gm = lg[0];
#pragma unroll
            for (int g = 1; g < 4; ++g) if (lg[g] > gm) { gm = lg[g]; gi = g; }
            float den = 0.f;
#pragma unroll
            for (int g = 0; g < 4; ++g) den += expf(lg[g] - gm);
            const float gval = 1.0f / den;
            float el[4] = {0.f, 0.f, 0.f, 0.f};
#pragma unroll
            for (int g = 0; g < 4; ++g) if (g == gi) {
#pragma unroll
                for (int e = 0; e < 4; ++e) el[e] = acc[4 + g * 4 + e] + p.re_b[(L * 4 + g) * 4 + e]; }
            int i0 = 0; float v0 = el[0];
#pragma unroll
            for (int e = 1; e < 4; ++e) if (el[e] > v0) { v0 = el[e]; i0 = e; }
            int i1 = -1; float v1 = -INFINITY;
#pragma unroll
            for (int e = 0; e < 4; ++e) if (e != i0 && el[e] > v1) { v1 = el[e]; i1 = e; }
            const float ex = expf(v1 - v0); const float ew0 = 1.0f / (1.0f + ex), ew1 = ex / (1.0f + ex);
            if (lane == 0) {
                const int ea = gi * 4 + i0, eb = gi * 4 + i1;
                const int pa = atomicAdd(R.cnt + ea, 1), pb = atomicAdd(R.cnt + eb, 1);
                R.list[ea * T + pa] = t; R.list[eb * T + pb] = t;
                R.e0[t] = ea; R.e1[t] = eb; R.p0[t] = pa; R.p1[t] = pb; R.w0[t] = gval * ew0; R.w1[t] = gval * ew1;
            }
        }
    }
}

template <int NB, class AF, class BF, class EF>
__device__ __forceinline__ void gemm_tile_naive(int K, const AF& af, const BF& bf, const EF& ef, float* sm) {
    float (*As)[132] = (float (*)[132])sm;
    float (*Bs)[16][68] = (float (*)[16][68])(sm + 16 * 132);
    const int tid = otid(), ty = tid >> 4, tx = tid & 15;
    float acc[NB][4][4];
#pragma unroll
    for (int n = 0; n < NB; ++n)
#pragma unroll
        for (int i = 0; i < 4; ++i)
#pragma unroll
            for (int j = 0; j < 4; ++j) acc[n][i][j] = 0.f;
    const int ar = tid >> 2, ak = (tid & 3) * 4, bk = tid >> 5, bc = (tid & 31) * 2;
    for (int k0 = 0; k0 < K; k0 += 16) {
        const float4 a = af(ar, k0 + ak);
        float2 b[NB];
#pragma unroll
        for (int n = 0; n < NB; ++n) b[n] = bf(n, k0 + bk, bc);
        __syncthreads();
        As[ak + 0][ar] = a.x; As[ak + 1][ar] = a.y; As[ak + 2][ar] = a.z; As[ak + 3][ar] = a.w;
#pragma unroll
        for (int n = 0; n < NB; ++n) { Bs[n][bk][bc] = b[n].x; Bs[n][bk][bc + 1] = b[n].y; }
        __syncthreads();
#pragma unroll
        for (int kk = 0; kk < 16; ++kk) {
            const float4 av = *(const float4*)&As[kk][ty * 4];
            const float a4[4] = {av.x, av.y, av.z, av.w};
#pragma unroll
            for (int n = 0; n < NB; ++n) { const float4 bv = *(const float4*)&Bs[n][kk][tx * 4]; const float b4[4] = {bv.x, bv.y, bv.z, bv.w};
#pragma unroll
                for (int i = 0; i < 4; ++i)
#pragma unroll
                    for (int j = 0; j < 4; ++j) acc[n][i][j] += a4[i] * b4[j]; }
        }
    }
#pragma unroll
    for (int i = 0; i < 4; ++i)
#pragma unroll
        for (int j = 0; j < 4; ++j) ef(ty * 4 + i, tx * 4 + j, acc[0][i][j], NB == 2 ? acc[NB - 1][i][j] : 0.f);
}

__device__ __forceinline__ float4 ld_bf4(const bf16_t* p) { const uint2 u = *(const uint2*)p; return make_float4(bflo(u.x), bfhi(u.x), bflo(u.y), bfhi(u.y)); }

template <class EF>
__device__ void gemm_dense_naive(const bf16_t* A, int lda, int K, int N, const float* B0, int ldb0, const float* gain0, int nsplit, const float* B1, int ldb1, const float* gain1, const EF& ef, float* sm) {
    const int ntn = N / 64, ntm = T / 128;
    for (int tile = obid(); tile < ntn * ntm; tile += gridDim.x) {
        const int tm = tile / ntn, tn = tile % ntn, m0 = tm * 128, n0 = tn * 64;
        const float* B; int ldb; const float* gain; int nb0;
        if (n0 < nsplit) { B = B0; ldb = ldb0; gain = gain0; nb0 = n0; } else { B = B1; ldb = ldb1; gain = gain1; nb0 = n0 - nsplit; }
        auto af = [&](int r, int k) { return ld_bf4(A + (size_t)(m0 + r) * lda + k); };
        auto bf = [&](int, int k, int c) { float2 w = *(const float2*)(B + (size_t)k * ldb + nb0 + c); const float g = gain ? gain[k] : 1.f; w.x *= g; w.y *= g; return w; };
        auto e2 = [&](int r, int c, float v, float) { ef(m0 + r, n0 + c, v); };
        gemm_tile_naive<1>(K, af, bf, e2, sm);
    }
}

template <int STAGE>
__device__ void gemm_expert_naive(const Params& p, int L, float* sm) {
    Route R = get_route(p, L);
    const bf16_t* XN = (const bf16_t*)(p.ws + OFF_XN);
    bf16_t* HG = (bf16_t*)(p.ws + OFF_BIG + B_HG); bf16_t* YG = (bf16_t*)(p.ws + OFF_BIG + B_YG);
    const int ntn = STAGE == 1 ? 512 / 64 : 1024 / 64;
    int* tstart = (int*)(sm + 6000);
    __syncthreads();
    if (otid() == 0) { int s = 0; for (int e = 0; e < 16; ++e) { tstart[e] = s; s += ((R.cnt[e] + 127) >> 7) * ntn; } tstart[16] = s; }
    __syncthreads();
    for (int tile = obid(); tile < tstart[16]; tile += gridDim.x) {
        int e = 0;
#pragma unroll 1
        for (int i = 1; i < 16; ++i) if (tile >= tstart[i]) e = i;
        const int lt = tile - tstart[e], tm = lt / ntn, tn = lt % ntn, m0 = tm * 128, n0 = tn * 64, cnt = R.cnt[e], base = expert_base(R.cnt, e);
        const int* list = R.list + e * T;
        if (STAGE == 1) {
            const float* Wg = p.wg + ((size_t)(L * 16 + e)) * 1024 * 512; const float* Wu = p.wu + ((size_t)(L * 16 + e)) * 1024 * 512; const float* gain = p.ffn_norm + L * 1024;
            auto af = [&](int r, int k) { const int rr = m0 + r; if (rr >= cnt) return make_float4(0.f, 0.f, 0.f, 0.f); return ld_bf4(XN + (size_t)list[rr] * 1024 + k); };
            auto bf = [&](int n, int k, int c) { float2 w = *(const float2*)((n == 0 ? Wg : Wu) + (size_t)k * 512 + n0 + c); const float g = gain[k]; w.x *= g; w.y *= g; return w; };
            auto ef = [&](int r, int c, float g, float u) { const int rr = m0 + r; if (rr >= cnt) return; const int tok = list[rr]; const float cw = (R.e0[tok] == e) ? R.w0[tok] : R.w1[tok];
                HG[(size_t)(base + rr) * 512 + n0 + c] = f2bf(silu(g) * u * cw); };
            gemm_tile_naive<2>(1024, af, bf, ef, sm);
        } else {
            const float* Wd = p.wd + ((size_t)(L * 16 + e)) * 512 * 1024;
            auto af = [&](int r, int k) { const int rr = m0 + r; if (rr >= cnt) return make_float4(0.f, 0.f, 0.f, 0.f); return ld_bf4(HG + (size_t)(base + rr) * 512 + k); };
            auto bf = [&](int, int k, int c) { return *(const float2*)(Wd + (size_t)k * 1024 + n0 + c); };
            auto ef = [&](int r, int c, float v, float) { const int rr = m0 + r; if (rr >= cnt) return; YG[(size_t)(base + rr) * 1024 + n0 + c] = f2bf(v); };
            gemm_tile_naive<1>(512, af, bf, ef, sm);
        }
    }
}

__device__ void phase_prologue(const Params& p) {
    const int gtid = obid() * 512 + otid(), gsz = gridDim.x * 512;
    int* cnt = (int*)(p.ws + OFF_CTRL);
    if (gtid < 64) cnt[gtid] = 0;
    float* rc = (float*)(p.ws + OFF_TABRET); float* rs = rc + 8192 * 128;
    for (int i = gtid; i < 8192 * 128; i += gsz) { const int pos = i >> 7, f = i & 127;
        const float inv = (float)exp(-9.2103403719761836 * ((double)f / 128.0));
        const float ang = (float)pos * inv; double s, c; sincos_big((double)ang, s, c); rc[i] = (float)c; rs[i] = (float)s; }
    float* pc = (float*)(p.ws + OFF_TABROPE); float* ps = pc + 8192 * 16;
    for (int i = gtid; i < 8192 * 16; i += gsz) { const int pos = i >> 4, f = i & 15;
        const float inv = (float)exp(-13.122363377404328 * ((double)f / 16.0));
        const float ang = (float)pos * inv; double s, c; sincos_big((double)ang, s, c); pc[i] = (float)c; ps[i] = (float)s; }
    norm_pass<0>(p, 0);
}

__device__ void phase_ret_rotary(const Params& p) {
    bf16_t* QK = (bf16_t*)(p.ws + OFF_BIG + B_QK);
    const float* rc = (const float*)(p.ws + OFF_TABRET); const float* rs = rc + 8192 * 128;
    const size_t total = (size_t)T * 8 * 128;
    for (size_t i = (size_t)obid() * 512 + otid(); i < total; i += (size_t)gridDim.x * 512) {
        const int f = (int)(i & 127), slot = (int)((i >> 7) & 7), t = (int)(i >> 10), pos = t & 8191;
        bf16_t* px = QK + (size_t)t * 2048 + slot * 256 + f;
        const float x1 = bf2f(px[0]), x2 = bf2f(px[128]), c = rc[pos * 128 + f], s = rs[pos * 128 + f];
        const float sc = slot >= 4 ? 0.0625f : 1.f;
        px[0] = f2bf((x1 * c - x2 * s) * sc); px[128] = f2bf((x2 * c + x1 * s) * sc);
    }
}

__device__ void phase_ret_scan(const Params& p) {
    const bf16_t* QK = (const bf16_t*)(p.ws + OFF_BIG + B_QK); const bf16_t* V = (const bf16_t*)(p.ws + OFF_BIG + B_V); bf16_t* O = (bf16_t*)(p.ws + OFF_BIG + B_O);
    const int wave = otid() >> 6, lane = otid() & 63;
    for (int item = obid() * 8 + wave; item < 2048; item += gridDim.x * 8) {
        const int b = item >> 10, h = (item >> 8) & 3, ep = item & 255;
        const float gamma = 1.f - exp2f(-5.f - (float)h);
        float S[4][2];
#pragma unroll
        for (int d = 0; d < 4; ++d) { S[d][0] = 0.f; S[d][1] = 0.f; }
        const bf16_t* qp = QK + (size_t)b * SEQ * 2048 + h * 256 + lane * 4;
        const bf16_t* kp = qp + 1024;
        const bf16_t* vp = V + (size_t)b * SEQ * 2048 + h * 512 + ep * 2;
        bf16_t* op = O + (size_t)b * SEQ * 2048 + h * 512 + ep * 2;
#pragma unroll 4
        for (int t = 0; t < SEQ; ++t) {
            const uint2 qv = *(const uint2*)(qp + (size_t)t * 2048), kv = *(const uint2*)(kp + (size_t)t * 2048); const unsigned vv = *(const unsigned*)(vp + (size_t)t * 2048);
            const float q[4] = {bflo(qv.x), bfhi(qv.x), bflo(qv.y), bfhi(qv.y)}, k[4] = {bflo(kv.x), bfhi(kv.x), bflo(kv.y), bfhi(kv.y)};
            const float v0 = bflo(vv), v1 = bfhi(vv);
            float p0 = 0.f, p1 = 0.f;
#pragma unroll
            for (int d = 0; d < 4; ++d) { S[d][0] = gamma * S[d][0] + k[d] * v0; S[d][1] = gamma * S[d][1] + k[d] * v1; p0 += q[d] * S[d][0]; p1 += q[d] * S[d][1]; }
            p0 = wsum(p0); p1 = wsum(p1);
            if (lane == 0) *(unsigned*)(op + (size_t)t * 2048) = pack2(p0, p1);
        }
    }
}

__device__ void phase_ret_gnorm(const Params& p) {
    bf16_t* O = (bf16_t*)(p.ws + OFF_BIG + B_O);
    const int wave = otid() >> 6, lane = otid() & 63;
    for (int item = obid() * 8 + wave; item < T * 4; item += gridDim.x * 8) {
        bf16_t* po = O + (size_t)item * 512 + lane * 8;
        const uint4 u = *(const uint4*)po;
        float v[8] = {bflo(u.x), bfhi(u.x), bflo(u.y), bfhi(u.y), bflo(u.z), bfhi(u.z), bflo(u.w), bfhi(u.w)};
        float ss = 0.f;
#pragma unroll
        for (int i = 0; i < 8; ++i) ss += v[i] * v[i];
        ss = wsum(ss);
        const float rstd = 1.0f / sqrtf(ss * (1.0f / 512.0f) + 1e-6f);
        uint4 o; o.x = pack2(v[0] * rstd, v[1] * rstd); o.y = pack2(v[2] * rstd, v[3] * rstd); o.z = pack2(v[4] * rstd, v[5] * rstd); o.w = pack2(v[6] * rstd, v[7] * rstd);
        *(uint4*)po = o;
    }
}

__device__ void phase_rope(const Params& p) {
    bf16_t* Kb = (bf16_t*)(p.ws + OFF_BIG + B_K); bf16_t* Qb = (bf16_t*)(p.ws + OFF_BIG + B_Q);
    const float* pc = (const float*)(p.ws + OFF_TABROPE); const float* ps = pc + 8192 * 16;
    const size_t total = (size_t)T * 2 * 8 * 16;
    for (size_t i = (size_t)obid() * 512 + otid(); i < total; i += (size_t)gridDim.x * 512) {
        const int f = (int)(i & 15), h = (int)((i >> 4) & 7), which = (int)((i >> 7) & 1), t = (int)(i >> 8), pos = t & 8191;
        bf16_t* px = (which ? Qb : Kb) + (size_t)t * 1024 + h * 128 + f;
        const float x1 = bf2f(px[0]), x2 = bf2f(px[16]), c = pc[pos * 16 + f], s = ps[pos * 16 + f];
        px[0] = f2bf(x1 * c - x2 * s); px[16] = f2bf(x2 * c + x1 * s);
    }
}
__device__ void phase_qscale(const Params& p) {
    bf16_t* Qb = (bf16_t*)(p.ws + OFF_BIG + B_Q);
    const size_t total = (size_t)T * 1024;
    const float sc = 0.08838834764831845f;
    for (size_t i = (size_t)obid() * 512 + otid(); i < total; i += (size_t)gridDim.x * 512) Qb[i] = f2bf(bf2f(Qb[i]) * sc);
}

__device__ void phase_kmean(const Params& p) {
    const bf16_t* Kb = (const bf16_t*)(p.ws + OFF_BIG + B_K); float* km = (float*)(p.ws + OFF_KMEAN);
    for (int i = obid() * 512 + otid(); i < 2 * 32 * 1024; i += gridDim.x * 512) {
        const int col = i & 1023, n = (i >> 10) & 31, b = i >> 15, h = col >> 7, d = col & 127;
        const bf16_t* pk = Kb + ((size_t)b * SEQ + n * 256) * 1024 + col;
        float s = 0.f;
        for (int j = 0; j < 256; ++j) s += bf2f(pk[(size_t)j * 1024]);
        km[(((size_t)b * 8 + h) * 32 + n) * 128 + d] = s * (1.0f / 256.0f);
    }
}

__device__ void phase_moba_naive(const Params& p, float* sm) {
    const bf16_t* Kb = (const bf16_t*)(p.ws + OFF_BIG + B_K); const bf16_t* Vb = (const bf16_t*)(p.ws + OFF_BIG + B_VB); const bf16_t* Qb = (const bf16_t*)(p.ws + OFF_BIG + B_Q);
    const float* kmean = (const float*)(p.ws + OFF_KMEAN); bf16_t* AO = (bf16_t*)(p.ws + OFF_BIG + B_AO);
    const int wave = otid() >> 6, lane = otid() & 63;
    float* qs = sm + wave * 128;
    for (int item = obid() * 8 + wave; item < T * 8; item += gridDim.x * 8) {
        const int tg = item >> 3, h = item & 7, b = tg >> 13, s = tg & 8191, blk = s >> 8;
        const unsigned qq = *(const unsigned*)(Qb + (size_t)tg * 1024 + h * 128 + lane * 2);
        qs[lane * 2] = bflo(qq); qs[lane * 2 + 1] = bfhi(qq);
        __builtin_amdgcn_wave_barrier();
        float g = -INFINITY;
        if (lane < blk) { const float* km = kmean + (((size_t)b * 8 + h) * 32 + lane) * 128; float a = 0.f; for (int d = 0; d < 128; ++d) a += qs[d] * km[d]; g = a; }
        const int nsel = blk < 3 ? blk : 3;
        int sel[3];
#pragma unroll
        for (int j = 0; j < 3; ++j) {
            sel[j] = 0;
            if (j < nsel) { const float m = wmax(g); const unsigned long long bal = __ballot(g == m); const int idx = __ffsll((long long)bal) - 1; sel[j] = idx; if (lane == idx) g = -INFINITY; }
        }
        float sc[4][4];
#pragma unroll
        for (int seg = 0; seg < 4; ++seg) {
            const int bid = seg < 3 ? sel[seg] : blk; const bool valid = seg < 3 ? (seg < nsel) : true; const int nkeys = seg < 3 ? 256 : (s - blk * 256 + 1);
#pragma unroll
            for (int kk = 0; kk < 4; ++kk) {
                const int key = kk * 64 + lane; float v = -INFINITY;
                if (valid && key < nkeys) {
                    const bf16_t* kr = Kb + ((size_t)b * SEQ + bid * 256 + key) * 1024 + h * 128; float a = 0.f;
#pragma unroll 4
                    for (int d8 = 0; d8 < 16; ++d8) { const uint4 u = *(const uint4*)(kr + d8 * 8); const float* q8 = qs + d8 * 8;
                        a += q8[0] * bflo(u.x) + q8[1] * bfhi(u.x) + q8[2] * bflo(u.y) + q8[3] * bfhi(u.y) + q8[4] * bflo(u.z) + q8[5] * bfhi(u.z) + q8[6] * bflo(u.w) + q8[7] * bfhi(u.w); }
                    v = a;
                }
                sc[seg][kk] = v;
            }
        }
        float m = -INFINITY;
#pragma unroll
        for (int seg = 0; seg < 4; ++seg)
#pragma unroll
            for (int kk = 0; kk < 4; ++kk) m = fmaxf(m, sc[seg][kk]);
        m = wmax(m);
        float l = 0.f;
#pragma unroll
        for (int seg = 0; seg < 4; ++seg)
#pragma unroll
            for (int kk = 0; kk < 4; ++kk) { const float e = expf(sc[seg][kk] - m); sc[seg][kk] = e; l += e; }
        l = wsum(l);
        float o0 = 0.f, o1 = 0.f;
#pragma unroll
        for (int seg = 0; seg < 4; ++seg) {
            const int bid = seg < 3 ? sel[seg] : blk; const bool valid = seg < 3 ? (seg < nsel) : true; const int nkeys = seg < 3 ? 256 : (s - blk * 256 + 1);
            if (valid) {
#pragma unroll
                for (int kk = 0; kk < 4; ++kk) {
                    if (kk * 64 < nkeys) {
                        const bf16_t* vr = Vb + ((size_t)b * SEQ + bid * 256 + kk * 64) * 1024 + h * 128 + lane * 2;
                        for (int src = 0; src < 64; ++src) { const float pp = __shfl(sc[seg][kk], src); const unsigned vv = *(const unsigned*)(vr + (size_t)src * 1024); o0 += pp * bflo(vv); o1 += pp * bfhi(vv); }
                    }
                }
            }
        }
        const float il = 1.0f / l;
        *(unsigned*)(AO + (size_t)tg * 1024 + h * 128 + lane * 2) = pack2(o0 * il, o1 * il);
        __builtin_amdgcn_wave_barrier();
    }
}

constexpr int NPHASE = 22;
__device__ __forceinline__ void run_phase(const Params& p, int ph, float* sm) {
    unsigned char* big = p.ws + OFF_BIG;
    const bf16_t* XN = (const bf16_t*)(p.ws + OFF_XN);
    switch (ph) {
    case 0: phase_prologue(p); break;
    case 1: { bf16_t* QK = (bf16_t*)(big + B_QK); bf16_t* V = (bf16_t*)(big + B_V);
        auto ef = [=](int r, int c, float v) { if (c < 2048) QK[(size_t)r * 2048 + c] = f2bf(v); else V[(size_t)r * 2048 + c - 2048] = f2bf(v); };
        gemm_dense_naive(XN, 1024, 1024, 4096, p.ret_w_in, 6144, p.ret_norm, 1 << 30, nullptr, 0, nullptr, ef, sm); } break;
    case 2: phase_ret_rotary(p); break;
    case 3: phase_ret_scan(p); break;
    case 4: phase_ret_gnorm(p); break;
    case 5: { bf16_t* O = (bf16_t*)(big + B_O);
        auto ef = [=](int r, int c, float v) { bf16_t* po = O + (size_t)r * 2048 + c; *po = f2bf(silu(v) * bf2f(*po)); };
        gemm_dense_naive(XN, 1024, 1024, 2048, p.ret_w_in + 4096, 6144, p.ret_norm, 1 << 30, nullptr, 0, nullptr, ef, sm); } break;
    case 6: { const bf16_t* Y = (const bf16_t*)(big + B_O); const float* x = p.x; float* out = p.out;
        auto ef = [=](int r, int c, float v) { out[(size_t)r * 1024 + c] = x[(size_t)r * 1024 + c] + v; };
        gemm_dense_naive(Y, 2048, 2048, 1024, p.ret_w_out, 1024, nullptr, 1 << 30, nullptr, 0, nullptr, ef, sm); } break;
    case 7: norm_pass<1>(p, 0); break;
    case 8: gemm_expert_naive<1>(p, 0, sm); break;
    case 9: gemm_expert_naive<2>(p, 0, sm); break;
    case 10: norm_pass<2>(p, 0); break;
    case 11: { bf16_t* Kb = (bf16_t*)(big + B_K); bf16_t* Vb = (bf16_t*)(big + B_VB); bf16_t* Qb = (bf16_t*)(big + B_Q);
        auto ef = [=](int r, int c, float v) { if (c < 1024) Kb[(size_t)r * 1024 + c] = f2bf(v); else if (c < 2048) Vb[(size_t)r * 1024 + c - 1024] = f2bf(v); else Qb[(size_t)r * 1024 + c - 2048] = f2bf(v); };
        gemm_dense_naive(XN, 1024, 1024, 3072, p.w_kv, 2048, p.kv_norm, 2048, p.w_q, 1024, p.attn_norm, ef, sm); } break;
    case 12: phase_rope(p); break;
    case 13: phase_qscale(p); break;
    case 14: phase_kmean(p); break;
    case 15: phase_moba_naive(p, sm); break;
    case 16: { const bf16_t* AO = (const bf16_t*)(big + B_AO); float* out = p.out;
        auto ef = [=](int r, int c, float v) { out[(size_t)r * 1024 + c] += v; };
        gemm_dense_naive(AO, 1024, 1024, 1024, p.w_o, 1024, nullptr, 1 << 30, nullptr, 0, nullptr, ef, sm); } break;
    case 17: norm_pass<1>(p, 1); break;
    case 18: gemm_expert_naive<1>(p, 1, sm); break;
    case 19: gemm_expert_naive<2>(p, 1, sm); break;
    case 20: norm_pass<3>(p, 1); break;
    default: break;
    }
}

#if MK_SINGLE
template <int PH> __device__ __forceinline__ void run_all(const Params& p, float* sm, cg::grid_group& grid) {
    run_phase(p, PH, sm);
    if constexpr (PH + 1 < NPHASE - 1) { grid.sync(); run_all<PH + 1>(p, sm, grid); }
}
__global__ void __launch_bounds__(512) mega(Params p) {
    __shared__ __attribute__((aligned(16))) float sm[8192];
    cg::grid_group grid = cg::this_grid();
    run_all<0>(p, sm, grid);
}
#endif
template <int PH> __global__ void __launch_bounds__(512) phase_kernel(Params p) {
    __shared__ __attribute__((aligned(16))) float sm[8192];
    run_phase(p, PH, sm);
}
template <int PH> static void launch_phases(const Params& p, int grid, hipStream_t stream) {
    if constexpr (PH < NPHASE - 1) { phase_kernel<PH><<<grid, 512, 0, stream>>>(p); launch_phases<PH + 1>(p, grid, stream); }
}

extern "C" void kernel_launch(void* const* d_in, const int* in_sizes, int n_in, void* d_out, int out_size, void* d_ws, size_t ws_size, hipStream_t stream) {
    if (ws_size < WS_NEED) { fprintf(stderr, "workspace too small: %zu < %zu\n", ws_size, WS_NEED); return; }
    Params p{};
    p.x = (const float*)d_in[0]; p.ret_norm = (const float*)d_in[1]; p.ret_w_in = (const float*)d_in[2]; p.ret_w_out = (const float*)d_in[3]; p.kv_norm = (const float*)d_in[4];
    p.w_kv = (const float*)d_in[5]; p.attn_norm = (const float*)d_in[6]; p.w_q = (const float*)d_in[7]; p.w_o = (const float*)d_in[8]; p.ffn_norm = (const float*)d_in[9];
    p.rg_w = (const float*)d_in[10]; p.rg_b = (const float*)d_in[11]; p.re_w = (const float*)d_in[12]; p.re_b = (const float*)d_in[13]; p.wg = (const float*)d_in[14];
    p.wu = (const float*)d_in[15]; p.wd = (const float*)d_in[16]; p.final_norm = (const float*)d_in[17];
    p.out = (float*)d_out; p.ws = (unsigned char*)d_ws;
    static int grid_blocks = 0;
    if (!grid_blocks) {
        int dev = 0, cus = 0, per_cu = 0;
        hipGetDevice(&dev);
        hipDeviceGetAttribute(&cus, hipDeviceAttributeMultiprocessorCount, dev);
        per_cu = 1;
        grid_blocks = cus * per_cu;
    }
#if MK_SINGLE
    void* args[] = {&p};
    hipError_t e = hipLaunchCooperativeKernel((void*)mega, dim3(grid_blocks), dim3(512), args, 0, stream);
    if (e != hipSuccess) fprintf(stderr, "cooperative launch failed: %s (grid %d)\n", hipGetErrorString(e), grid_blocks);
#else
    launch_phases<0>(p, grid_blocks, stream);
#endif
}
```

```cpp
#include <hip/hip_runtime.h>
#include <hip/hip_cooperative_groups.h>
#include <cstdio>
#include <cstdint>
namespace cg = cooperative_groups;

#ifndef MK_SINGLE
#define MK_SINGLE 1
#endif

typedef unsigned short bf16_t;
#define LAS __attribute__((address_space(3)))
typedef float v4f __attribute__((ext_vector_type(4)));
constexpr int T = 16384, SEQ = 8192;
constexpr size_t MiB = (size_t)1 << 20;
constexpr size_t OFF_CTRL = 0, OFF_ROUTE = 1 * MiB, OFF_KMEAN = 3 * MiB + 512 * 1024, OFF_TABROPE = 4 * MiB,
                 OFF_WB = 8 * MiB, OFF_XN = 32 * MiB, OFF_BIG = 64 * MiB, OFF_EXTRA = 288 * MiB, OFF_TABRET = OFF_EXTRA, WS_NEED = 304 * MiB;
constexpr size_t W_IN = 0, W_OUT = 12 * MiB, W_KVQ = 16 * MiB, W_O = 22 * MiB;
constexpr int LDS_BYTES = 147456;
constexpr size_t B_QK = 0, B_V = 64 * MiB, B_O = 128 * MiB, B_ST = 192 * MiB;
constexpr size_t B_E = 0, B_HG = 48 * MiB, B_YG = 84 * MiB;
constexpr size_t B_K = 0, B_VB = 32 * MiB, B_Q = 64 * MiB, B_PART = 96 * MiB, B_AO = 192 * MiB;

struct Params {
    const float *x, *ret_norm, *ret_w_in, *ret_w_out, *kv_norm, *w_kv, *attn_norm, *w_q, *w_o, *ffn_norm, *rg_w, *rg_b, *re_w, *re_b, *wg, *wu, *wd, *final_norm;
    float* out; unsigned char* ws;
};

__device__ __forceinline__ int otid() { int t = threadIdx.x; asm volatile("" : "+v"(t)); return t; }
__device__ __forceinline__ int obid() { int b = blockIdx.x; asm volatile("" : "+s"(b)); return b; }
__device__ __forceinline__ bf16_t f2bf(float f) { unsigned u = __float_as_uint(f); u += 0x7fffu + ((u >> 16) & 1u); return (bf16_t)(u >> 16); }
__device__ __forceinline__ float bf2f(bf16_t h) { return __uint_as_float(((unsigned)h) << 16); }
__device__ __forceinline__ float bflo(unsigned u) { return __uint_as_float(u << 16); }
__device__ __forceinline__ float bfhi(unsigned u) { return __uint_as_float(u & 0xffff0000u); }
__device__ __forceinline__ unsigned pack2(float a, float b) { return (unsigned)f2bf(a) | ((unsigned)f2bf(b) << 16); }
__device__ __forceinline__ float wsum(float v) { for (int o = 32; o > 0; o >>= 1) v += __shfl_xor(v, o); return v; }
__device__ __forceinline__ float wmax(float v) { for (int o = 32; o > 0; o >>= 1) v = fmaxf(v, __shfl_xor(v, o)); return v; }
__device__ __forceinline__ float silu(float v) { return v / (1.f + __expf(-v)); }

__device__ void sincos_big(double a, double& s, double& c) {
    const double twopi = 6.283185307179586476925286766559;
    double k = rint(a / twopi); double r = a - k * twopi;
    double x2 = r * r, ts = r, tc = 1.0; s = r; c = 1.0;
#pragma unroll 1
    for (int n = 1; n <= 16; ++n) { tc *= -x2 / (double)((2 * n - 1) * (2 * n)); c += tc; ts *= -x2 / (double)((2 * n) * (2 * n + 1)); s += ts; }
}

struct Route { int* cnt; int *e0, *e1, *p0, *p1; float *w0, *w1; int* list; float* cwl; };
__device__ __forceinline__ Route get_route(const Params& p, int L) {
    Route r; r.cnt = (int*)(p.ws + OFF_CTRL) + L * 16;
    unsigned char* b = p.ws + OFF_ROUTE;
    r.e0 = (int*)b; r.e1 = r.e0 + T; r.p0 = r.e1 + T; r.p1 = r.p0 + T; r.w0 = (float*)(r.p1 + T); r.w1 = r.w0 + T; r.list = (int*)(b + 512 * 1024); r.cwl = (float*)(b + 1536 * 1024);
    return r;
}
__device__ __forceinline__ int expert_base(const int* cnt, int e) { int s = 0; for (int i = 0; i < e; ++i) s += (cnt[i] + 255) & ~255; return s; }

template <int MODE>
__device__ void norm_pass(const Params& p, int L, unsigned char* lds) {
    const int wave = otid() >> 6, lane = otid() & 63;
    LAS float* wr = (LAS float*)(LAS unsigned char*)lds;
    if (MODE == 1) {
        for (int i = otid(); i < 1024 * 5; i += 512) { const int k = i / 5, part = i % 5;
            float4 w = part == 0 ? *(const float4*)(p.rg_w + ((size_t)L * 1024 + k) * 4) : *(const float4*)(p.re_w + (((size_t)L * 4 + part - 1) * 1024 + k) * 4);
            const float g = p.ffn_norm[L * 1024 + k]; w.x *= g; w.y *= g; w.z *= g; w.w *= g;
            v4f w4 = {w.x, w.y, w.z, w.w}; *(LAS v4f*)(wr + k * 20 + part * 4) = w4; }
        __syncthreads();
    }
    bf16_t* XN = (bf16_t*)(p.ws + OFF_XN);
    const bf16_t* YG = (const bf16_t*)(p.ws + OFF_BIG + B_YG);
    Route R = get_route(p, L);
    for (int t = obid() * 8 + wave; t < T; t += gridDim.x * 8) {
        const float* src = (MODE == 0 ? p.x : p.out) + (size_t)t * 1024;
        float4 v[4];
#pragma unroll
        for (int j = 0; j < 4; ++j) v[j] = *(const float4*)(src + j * 256 + lane * 4);
        if (MODE >= 2) {
            const int r0 = expert_base(R.cnt, R.e0[t]) + R.p0[t], r1 = expert_base(R.cnt, R.e1[t]) + R.p1[t];
#pragma unroll
            for (int j = 0; j < 4; ++j) {
                uint2 a = *(const uint2*)(YG + (size_t)r0 * 1024 + j * 256 + lane * 4), b = *(const uint2*)(YG + (size_t)r1 * 1024 + j * 256 + lane * 4);
                v[j].x += bflo(a.x) + bflo(b.x); v[j].y += bfhi(a.x) + bfhi(b.x); v[j].z += bflo(a.y) + bflo(b.y); v[j].w += bfhi(a.y) + bfhi(b.y);
            }
        }
        float ss = 0.f;
#pragma unroll
        for (int j = 0; j < 4; ++j) ss += v[j].x * v[j].x + v[j].y * v[j].y + v[j].z * v[j].z + v[j].w * v[j].w;
        ss = wsum(ss);
        const float rstd = 1.0f / sqrtf(ss * (1.0f / 1024.0f) + 1e-6f);
        if (MODE == 2) {
#pragma unroll
            for (int j = 0; j < 4; ++j) *(float4*)(p.out + (size_t)t * 1024 + j * 256 + lane * 4) = v[j];
        }
        if (MODE == 3) {
#pragma unroll
            for (int j = 0; j < 4; ++j) { float4 g = *(const float4*)(p.final_norm + j * 256 + lane * 4);
                float4 o; o.x = v[j].x * rstd * g.x; o.y = v[j].y * rstd * g.y; o.z = v[j].z * rstd * g.z; o.w = v[j].w * rstd * g.w;
                *(float4*)(p.out + (size_t)t * 1024 + j * 256 + lane * 4) = o; }
        } else {
#pragma unroll
            for (int j = 0; j < 4; ++j) { uint2 o; o.x = pack2(v[j].x * rstd, v[j].y * rstd); o.y = pack2(v[j].z * rstd, v[j].w * rstd);
                *(uint2*)(XN + (size_t)t * 1024 + j * 256 + lane * 4) = o; }
        }
        if (MODE == 1) {
            float acc[20];
#pragma unroll
            for (int i = 0; i < 20; ++i) acc[i] = 0.f;
            const LAS float* wl = wr + lane * 80;
            const float tv[4][4] = {{v[0].x * rstd, v[0].y * rstd, v[0].z * rstd, v[0].w * rstd}, {v[1].x * rstd, v[1].y * rstd, v[1].z * rstd, v[1].w * rstd},
                                    {v[2].x * rstd, v[2].y * rstd, v[2].z * rstd, v[2].w * rstd}, {v[3].x * rstd, v[3].y * rstd, v[3].z * rstd, v[3].w * rstd}};
#pragma unroll
            for (int j = 0; j < 4; ++j) {
                asm volatile("" ::: "memory");
                const float tk[4] = {tv[j][0], tv[j][1], tv[j][2], tv[j][3]};
#pragma unroll
                for (int c = 0; c < 4; ++c) {
#pragma unroll
                    for (int q = 0; q < 5; ++q) { const v4f w = *(const LAS v4f*)(wl + j * 5120 + c * 20 + q * 4);
                        acc[q * 4 + 0] += tk[c] * w[0]; acc[q * 4 + 1] += tk[c] * w[1]; acc[q * 4 + 2] += tk[c] * w[2]; acc[q * 4 + 3] += tk[c] * w[3]; }
                }
            }
#pragma unroll
            for (int i = 0; i < 20; ++i) acc[i] = wsum(acc[i]);
            float lg[4];
#pragma unroll
            for (int g = 0; g < 4; ++g) lg[g] = acc[g] + p.rg_b[L * 4 + g];
            int gi = 0; float gm = lg[0];
#pragma unroll
            for (int g = 1; g < 4; ++g) if (lg[g] > gm) { gm = lg[g]; gi = g; }
            float den = 0.f;
#pragma unroll
            for (int g = 0; g < 4; ++g) den += expf(lg[g] - gm);
            const float gval = 1.0f / den;
            float el[4] = {0.f, 0.f, 0.f, 0.f};
#pragma unroll
            for (int g = 0; g < 4; ++g) if (g == gi) {
#pragma unroll
                for (int e = 0; e < 4; ++e) el[e] = acc[4 + g * 4 + e] + p.re_b[(L * 4 + g) * 4 + e]; }
            int i0 = 0; float v0 = el[0];
#pragma unroll
            for (int e = 1; e < 4; ++e) if (el[e] > v0) { v0 = el[e]; i0 = e; }
            int i1 = -1; float v1 = -INFINITY;
#pragma unroll
            for (int e = 0; e < 4; ++e) if (e != i0 && el[e] > v1) { v1 = el[e]; i1 = e; }
            const float ex = expf(v1 - v0); const float ew0 = 1.0f / (1.0f + ex), ew1 = ex / (1.0f + ex);
            if (lane == 0) {
                const int ea = gi * 4 + i0, eb = gi * 4 + i1;
                const int pa = atomicAdd(R.cnt + ea, 1), pb = atomicAdd(R.cnt + eb, 1);
                R.list[ea * T + pa] = t; R.list[eb * T + pb] = t; R.cwl[ea * T + pa] = gval * ew0; R.cwl[eb * T + pb] = gval * ew1;
                R.e0[t] = ea; R.e1[t] = eb; R.p0[t] = pa; R.p1[t] = pb; R.w0[t] = gval * ew0; R.w1[t] = gval * ew1;
            }
        }
    }
}

template <int NB, class AF, class BF, class EF>
__device__ __forceinline__ void gemm_tile_naive(int K, const AF& af, const BF& bf, const EF& ef, float* sm) {
    float (*As)[132] = (float (*)[132])sm;
    float (*Bs)[16][68] = (float (*)[16][68])(sm + 16 * 132);
    const int tid = otid(), ty = tid >> 4, tx = tid & 15;
    float acc[NB][4][4];
#pragma unroll
    for (int n = 0; n < NB; ++n)
#pragma unroll
        for (int i = 0; i < 4; ++i)
#pragma unroll
            for (int j = 0; j < 4; ++j) acc[n][i][j] = 0.f;
    const int ar = tid >> 2, ak = (tid & 3) * 4, bk = tid >> 5, bc = (tid & 31) * 2;
    for (int k0 = 0; k0 < K; k0 += 16) {
        const float4 a = af(ar, k0 + ak);
        float2 b[NB];
#pragma unroll
        for (int n = 0; n < NB; ++n) b[n] = bf(n, k0 + bk, bc);
        __syncthreads();
        As[ak + 0][ar] = a.x; As[ak + 1][ar] = a.y; As[ak + 2][ar] = a.z; As[ak + 3][ar] = a.w;
#pragma unroll
        for (int n = 0; n < NB; ++n) { Bs[n][bk][bc] = b[n].x; Bs[n][bk][bc + 1] = b[n].y; }
        __syncthreads();
#pragma unroll
        for (int kk = 0; kk < 16; ++kk) {
            const float4 av = *(const float4*)&As[kk][ty * 4];
            const float a4[4] = {av.x, av.y, av.z, av.w};
#pragma unroll
            for (int n = 0; n < NB; ++n) { const float4 bv = *(const float4*)&Bs[n][kk][tx * 4]; const float b4[4] = {bv.x, bv.y, bv.z, bv.w};
#pragma unroll
                for (int i = 0; i < 4; ++i)
#pragma unroll
                    for (int j = 0; j < 4; ++j) acc[n][i][j] += a4[i] * b4[j]; }
        }
    }
#pragma unroll
    for (int i = 0; i < 4; ++i)
#pragma unroll
        for (int j = 0; j < 4; ++j) ef(ty * 4 + i, tx * 4 + j, acc[0][i][j], NB == 2 ? acc[NB - 1][i][j] : 0.f);
}

__device__ __forceinline__ float4 ld_bf4(const bf16_t* p) { const uint2 u = *(const uint2*)p; return make_float4(bflo(u.x), bfhi(u.x), bflo(u.y), bfhi(u.y)); }

template <class EF>
__device__ void gemm_dense_naive(const bf16_t* A, int lda, int K, int N, const float* B0, int ldb0, const float* gain0, int nsplit, const float* B1, int ldb1, const float* gain1, const EF& ef, float* sm) {
    const int ntn = N / 64, ntm = T / 128;
    for (int tile = obid(); tile < ntn * ntm; tile += gridDim.x) {
        const int tm = tile / ntn, tn = tile % ntn, m0 = tm * 128, n0 = tn * 64;
        const float* B; int ldb; const float* gain; int nb0;
        if (n0 < nsplit) { B = B0; ldb = ldb0; gain = gain0; nb0 = n0; } else { B = B1; ldb = ldb1; gain = gain1; nb0 = n0 - nsplit; }
        auto af = [&](int r, int k) { return ld_bf4(A + (size_t)(m0 + r) * lda + k); };
        auto bf = [&](int, int k, int c) { float2 w = *(const float2*)(B + (size_t)k * ldb + nb0 + c); const float g = gain ? gain[k] : 1.f; w.x *= g; w.y *= g; return w; };
        auto e2 = [&](int r, int c, float v, float) { ef(m0 + r, n0 + c, v); };
        gemm_tile_naive<1>(K, af, bf, e2, sm);
    }
}

template <int STAGE>
__device__ void gemm_expert_naive(const Params& p, int L, float* sm) {
    Route R = get_route(p, L);
    const bf16_t* XN = (const bf16_t*)(p.ws + OFF_XN);
    bf16_t* HG = (bf16_t*)(p.ws + OFF_BIG + B_HG); bf16_t* YG = (bf16_t*)(p.ws + OFF_BIG + B_YG);
    const int ntn = STAGE == 1 ? 512 / 64 : 1024 / 64;
    int* tstart = (int*)(sm + 6000);
    __syncthreads();
    if (otid() == 0) { int s = 0; for (int e = 0; e < 16; ++e) { tstart[e] = s; s += ((R.cnt[e] + 127) >> 7) * ntn; } tstart[16] = s; }
    __syncthreads();
    for (int tile = obid(); tile < tstart[16]; tile += gridDim.x) {
        int e = 0;
#pragma unroll 1
        for (int i = 1; i < 16; ++i) if (tile >= tstart[i]) e = i;
        const int lt = tile - tstart[e], tm = lt / ntn, tn = lt % ntn, m0 = tm * 128, n0 = tn * 64, cnt = R.cnt[e], base = expert_base(R.cnt, e);
        const int* list = R.list + e * T;
        if (STAGE == 1) {
            const float* Wg = p.wg + ((size_t)(L * 16 + e)) * 1024 * 512; const float* Wu = p.wu + ((size_t)(L * 16 + e)) * 1024 * 512; const float* gain = p.ffn_norm + L * 1024;
            auto af = [&](int r, int k) { const int rr = m0 + r; if (rr >= cnt) return make_float4(0.f, 0.f, 0.f, 0.f); return ld_bf4(XN + (size_t)list[rr] * 1024 + k); };
            auto bf = [&](int n, int k, int c) { float2 w = *(const float2*)((n == 0 ? Wg : Wu) + (size_t)k * 512 + n0 + c); const float g = gain[k]; w.x *= g; w.y *= g; return w; };
            auto ef = [&](int r, int c, float g, float u) { const int rr = m0 + r; if (rr >= cnt) return; const int tok = list[rr]; const float cw = (R.e0[tok] == e) ? R.w0[tok] : R.w1[tok];
                HG[(size_t)(base + rr) * 512 + n0 + c] = f2bf(silu(g) * u * cw); };
            gemm_tile_naive<2>(1024, af, bf, ef, sm);
        } else {
            const float* Wd = p.wd + ((size_t)(L * 16 + e)) * 512 * 1024;
            auto af = [&](int r, int k) { const int rr = m0 + r; if (rr >= cnt) return make_float4(0.f, 0.f, 0.f, 0.f); return ld_bf4(HG + (size_t)(base + rr) * 512 + k); };
            auto bf = [&](int, int k, int c) { return *(const float2*)(Wd + (size_t)k * 1024 + n0 + c); };
            auto ef = [&](int r, int c, float v, float) { const int rr = m0 + r; if (rr >= cnt) return; YG[(size_t)(base + rr) * 1024 + n0 + c] = f2bf(v); };
            gemm_tile_naive<1>(512, af, bf, ef, sm);
        }
    }
}


namespace pg8 {
#define PG8_LAS __attribute__((address_space(3)))
typedef unsigned short bf16_t;
typedef short bf16x8 __attribute__((ext_vector_type(8)));
typedef float f32x4 __attribute__((ext_vector_type(4)));
typedef unsigned u32x4 __attribute__((ext_vector_type(4)));
constexpr int BM = 256, BK = 64, HALF = 128, HTB = HALF * BK * 2  , STAGE_BYTES = 8 * HTB, NXCD = 8, WGM = 8;

__host__ __device__ __forceinline__ int lds_byte(int r, int c) { const int st = (r >> 4) * 2 + (c >> 5), rr = r & 15, cc = c & 31, ob = rr * 64 + cc * 2; return st * 1024 + (ob ^ (((ob >> 9) & 1) << 5)); }
__host__ __device__ __forceinline__ void stage_rc(int b, int& R, int& C) { const int st = b / 1024, sb = b % 1024, swz = sb ^ (((sb >> 9) & 1) << 5); R = (st >> 1) * 16 + swz / 64; C = (st & 1) * 32 + (swz % 64) / 2; }
__host__ __device__ __forceinline__ int perm32(int rho) { const int n = rho >> 4, i = rho & 15; return 8 * (i >> 2) + 4 * n + (i & 3); }

struct Unit { int pm, pn; };
struct Gemm { const bf16_t* A; const bf16_t* Bt; int M, N, K; };

struct StaticOrder {
    int nM, nN, nwg, G, c;
    __host__ __device__ void init(int M, int N, int G_, int c_) { nM = M / BM; nN = N / BM; nwg = nM * nN; G = G_; c = c_; }
    __host__ __device__ bool next(int i, Unit& u) const {
        const long L = (long)i * G + c; if (L >= nwg) return false;
        int wgid = (int)L; { const int q = nwg / NXCD, r = nwg % NXCD, xcd = wgid % NXCD, off = wgid / NXCD; wgid = (xcd < r ? xcd * (q + 1) : r * (q + 1) + (xcd - r) * q) + off; }
        const int nig = WGM * nN, gid = wgid / nig, fm = gid * WGM, gsz = (nM - fm) < WGM ? (nM - fm) : WGM;
        u.pm = fm + ((wgid % nig) % gsz); u.pn = (wgid % nig) / gsz; return true;
    }
    __device__ __forceinline__ void a_ready(const Unit&) const {}
    __device__ __forceinline__ void done(const Unit&) const {}
};


__device__ __forceinline__ unsigned cvt_pk_bf16(float lo, float hi) { unsigned r; asm volatile("v_cvt_pk_bf16_f32 %0, %1, %2" : "=v"(r) : "v"(lo), "v"(hi)); return r; }
__device__ __forceinline__ u32x4 pk8(const f32x4& a, const f32x4& b) { u32x4 w; w.x = cvt_pk_bf16(a[0], a[1]); w.y = cvt_pk_bf16(a[2], a[3]); w.z = cvt_pk_bf16(b[0], b[1]); w.w = cvt_pk_bf16(b[2], b[3]); return w; }
typedef unsigned u32x2 __attribute__((ext_vector_type(2)));
__device__ __forceinline__ u32x2 pk4(const f32x4& a) { u32x2 w; w.x = cvt_pk_bf16(a[0], a[1]); w.y = cvt_pk_bf16(a[2], a[3]); return w; }
__device__ __forceinline__ float fsilu(float v) { return v * __builtin_amdgcn_rcpf(1.f + __expf(-v)); }

struct EpiInproj {
    static constexpr bool PERM = true, AFTER_DRAIN = false;
    bf16_t* QK; bf16_t* V; const float* rc; const float* rs;
    __device__ __forceinline__ void operator()(const f32x4 (&acc)[2][2][4][2], const Unit& u, int wr, int wc, int fr, int fq) const {
        const int row0 = u.pm * BM + wr * 64 + fr;
        if (u.pn < 8) {
            const int f0 = wc * 32 + 8 * fq;
#pragma unroll
            for (int ai = 0; ai < 2; ++ai)
#pragma unroll
                for (int m = 0; m < 4; ++m) { const int r = row0 + ai * HALF + m * 16, pos = r & 8191;
                    const f32x4 c0 = *(const f32x4*)(rc + pos * 128 + f0), c1 = *(const f32x4*)(rc + pos * 128 + f0 + 4), s0 = *(const f32x4*)(rs + pos * 128 + f0), s1 = *(const f32x4*)(rs + pos * 128 + f0 + 4);
                    const f32x4 x1a = acc[ai][0][m][0], x1b = acc[ai][0][m][1], x2a = acc[ai][1][m][0], x2b = acc[ai][1][m][1];
                    bf16_t* p = QK + (size_t)r * 2048 + u.pn * 256 + f0;
                    *(u32x4*)p = pk8(x1a * c0 - x2a * s0, x1b * c1 - x2b * s1);
                    *(u32x4*)(p + 128) = pk8(x2a * c0 + x1a * s0, x2b * c1 + x1b * s1); }
        } else {
#pragma unroll
            for (int ai = 0; ai < 2; ++ai)
#pragma unroll
                for (int m = 0; m < 4; ++m) { const int r = row0 + ai * HALF + m * 16; bf16_t* p = V + (size_t)r * 2048 + (u.pn - 8) * 256 + wc * 32 + 8 * fq;
#pragma unroll
                    for (int bj = 0; bj < 2; ++bj) *(u32x4*)(p + bj * HALF) = pk8(acc[ai][bj][m][0], acc[ai][bj][m][1]); }
        }
    }
};
struct EpiG {
    static constexpr bool PERM = true, AFTER_DRAIN = false;
    bf16_t* O;
    __device__ __forceinline__ void operator()(const f32x4 (&acc)[2][2][4][2], const Unit& u, int wr, int wc, int fr, int fq) const {
        const int row0 = u.pm * BM + wr * 64 + fr;
#pragma unroll
        for (int ai = 0; ai < 2; ++ai)
#pragma unroll
            for (int m = 0; m < 4; ++m) { const int r = row0 + ai * HALF + m * 16; bf16_t* p = O + (size_t)r * 2048 + u.pn * 256 + wc * 32 + 8 * fq;
#pragma unroll
                for (int bj = 0; bj < 2; ++bj) { const u32x4 o = *(const u32x4*)(p + bj * HALF); const f32x4 g0 = acc[ai][bj][m][0], g1 = acc[ai][bj][m][1];
                    f32x4 y0, y1; y0[0] = fsilu(g0[0]) * bflo(o.x); y0[1] = fsilu(g0[1]) * bfhi(o.x); y0[2] = fsilu(g0[2]) * bflo(o.y); y0[3] = fsilu(g0[3]) * bfhi(o.y);
                    y1[0] = fsilu(g1[0]) * bflo(o.z); y1[1] = fsilu(g1[1]) * bfhi(o.z); y1[2] = fsilu(g1[2]) * bflo(o.w); y1[3] = fsilu(g1[3]) * bfhi(o.w);
                    *(u32x4*)(p + bj * HALF) = pk8(y0, y1); } }
    }
};
struct EpiResid {
    static constexpr bool PERM = false, AFTER_DRAIN = false;
    const float* base; float* out;
    __device__ __forceinline__ void operator()(const f32x4 (&acc)[2][2][4][2], const Unit& u, int wr, int wc, int fr, int fq) const {
        const int row0 = u.pm * BM + wr * 64 + fr, col0 = u.pn * BM + wc * 32 + 4 * fq;
#pragma unroll
        for (int ai = 0; ai < 2; ++ai)
#pragma unroll
            for (int m = 0; m < 4; ++m) { const size_t off = (size_t)(row0 + ai * HALF + m * 16) * 1024 + col0;
#pragma unroll
                for (int bj = 0; bj < 2; ++bj)
#pragma unroll
                    for (int n = 0; n < 2; ++n) { const f32x4 b = *(const f32x4*)(base + off + bj * HALF + n * 16); *(f32x4*)(out + off + bj * HALF + n * 16) = b + acc[ai][bj][m][n]; } }
    }
};
struct EpiKVQ {
    static constexpr bool PERM = false, AFTER_DRAIN = false;
    bf16_t *K, *Vb, *Q; const float* pc; const float* ps;
    __device__ __forceinline__ void operator()(const f32x4 (&acc)[2][2][4][2], const Unit& u, int wr, int wc, int fr, int fq) const {
        const int which = u.pn >> 2; bf16_t* dst = K + (size_t)which * (16u << 20);
        const int row0 = u.pm * BM + wr * 64 + fr, col0 = (u.pn & 3) * BM + wc * 32 + 4 * fq;
        const bool rot = (which != 1) && (wc == 0);
#pragma unroll
        for (int ai = 0; ai < 2; ++ai)
#pragma unroll
            for (int m = 0; m < 4; ++m) { const int r = row0 + ai * HALF + m * 16, pos = r & 8191;
                f32x4 c = {1.f, 1.f, 1.f, 1.f}, s = {0.f, 0.f, 0.f, 0.f};
                if (rot) { c = *(const f32x4*)(pc + pos * 16 + 4 * fq); s = *(const f32x4*)(ps + pos * 16 + 4 * fq); }
#pragma unroll
                for (int bj = 0; bj < 2; ++bj) { f32x4 v0 = acc[ai][bj][m][0], v1 = acc[ai][bj][m][1];
                    if (rot) { const f32x4 y0 = v0 * c - v1 * s, y1 = v1 * c + v0 * s; v0 = y0; v1 = y1; }
                    bf16_t* p = dst + (size_t)r * 1024 + col0 + bj * HALF;
                    *(u32x2*)p = pk4(v0); *(u32x2*)(p + 16) = pk4(v1); } }
    }
};
template <class Epi, class Sched, bool ALIGN_EPI = false, bool SP2 = false>
__device__ __forceinline__ void gemm_phase(PG8_LAS unsigned char* lds, const Gemm g, const Sched& S, const Epi& E) {
    const int tid = otid(), wid = __builtin_amdgcn_readfirstlane(tid >> 6), lane = tid & 63, wr = wid >> 2, wc = wid & 3, fr = lane & 15, fq = lane >> 4;
    const int K = g.K, nt = K / BK;
    unsigned voffA[2], voffB[2];
#pragma unroll
    for (int i = 0; i < 2; ++i) { int R, C; stage_rc(tid * 16 + i * 8192, R, C); const int Rb = Epi::PERM ? ((R & ~31) + perm32(R & 31)) : R;
        voffA[i] = (unsigned)(R * K + C) * 2u; voffB[i] = (unsigned)(Rb * K + C) * 2u; }
    const size_t kstep = (size_t)(BK * 2);
    const size_t hstep = (size_t)HALF * K * 2;
    const size_t tstep = 2 * hstep;
    const unsigned ldsw = (unsigned)wid * 1024u;
    const int aoff = lds_byte(wr * 64 + fr, fq * 8), boff = lds_byte(wc * 32 + fr, fq * 8);
#define PG8_SA(b, h) (((b) * 2 + (h)) * HTB)
#define PG8_SB(b, h) ((4 + (b) * 2 + (h)) * HTB)
#define PG8_STAGE(bufoff, gbase, voff) do { _Pragma("unroll") for (int _i = 0; _i < 2; ++_i) \
        __builtin_amdgcn_global_load_lds((const unsigned*)((const char*)(gbase) + (voff)[_i]), (PG8_LAS unsigned*)(lds + (bufoff) + ldsw + _i * 8192), 16, 0, 0); } while (0)
#define PG8_LDA(dst, b, h) do { _Pragma("unroll") for (int m = 0; m < 4; ++m) _Pragma("unroll") for (int k = 0; k < 2; ++k) dst[m][k] = *(const PG8_LAS bf16x8*)(lds + PG8_SA(b, h) + aoff + m * 2048 + k * 1024); } while (0)
#define PG8_LDB(dst, b, h) do { _Pragma("unroll") for (int n = 0; n < 2; ++n) _Pragma("unroll") for (int k = 0; k < 2; ++k) dst[n][k] = *(const PG8_LAS bf16x8*)(lds + PG8_SB(b, h) + boff + n * 2048 + k * 1024); } while (0)
#define PG8_MMA(ai, bj, At, Bt) do { __builtin_amdgcn_s_setprio(1); _Pragma("unroll") for (int m = 0; m < 4; ++m) _Pragma("unroll") for (int n = 0; n < 2; ++n) _Pragma("unroll") for (int k = 0; k < 2; ++k) \
        acc[ai][bj][m][n] = __builtin_amdgcn_mfma_f32_16x16x32_bf16(Bt[n][k], At[m][k], acc[ai][bj][m][n], 0, 0, 0); __builtin_amdgcn_s_setprio(0); } while (0)
#define PG8_WAIT_V(n) asm volatile("s_waitcnt vmcnt(" #n ")" ::: "memory")
#define PG8_WAIT_L(n) asm volatile("s_waitcnt lgkmcnt(" #n ")" ::: "memory")
#define PG8_BAR __builtin_amdgcn_s_barrier()
#define PG8_SCHED __builtin_amdgcn_sched_barrier(0)
    Unit cur, nxt; int ui = 0;
    if (!S.next(0, cur)) return;
    f32x4 acc[2][2][4][2];
#pragma unroll
    for (int a = 0; a < 2; ++a)
#pragma unroll
        for (int b = 0; b < 2; ++b)
#pragma unroll
            for (int m = 0; m < 4; ++m)
#pragma unroll
                for (int n = 0; n < 2; ++n) acc[a][b][m][n] = (f32x4){0.f, 0.f, 0.f, 0.f};
    bf16x8 At[4][2], B0[2][2], B1[2][2];
    const char* cA = (const char*)g.A + (size_t)cur.pm * tstep; const char* cB = (const char*)g.Bt + (size_t)cur.pn * tstep;
    S.a_ready(cur);
    if constexpr (SP2) {
        PG8_STAGE(PG8_SB(0, 0), cB, voffB); PG8_STAGE(PG8_SB(0, 1), cB + hstep, voffB); PG8_STAGE(PG8_SA(0, 0), cA, voffA); PG8_STAGE(PG8_SA(0, 1), cA + hstep, voffA);
        if (wr == 1) PG8_BAR;
        PG8_WAIT_V(2); PG8_BAR;
        PG8_STAGE(PG8_SB(1, 0), cB + kstep, voffB); PG8_STAGE(PG8_SA(1, 0), cA + kstep, voffA); PG8_STAGE(PG8_SB(1, 1), cB + hstep + kstep, voffB);
        PG8_WAIT_V(6); PG8_BAR;
    } else {
        PG8_STAGE(PG8_SB(0, 0), cB, voffB); PG8_STAGE(PG8_SA(0, 0), cA, voffA); PG8_STAGE(PG8_SB(0, 1), cB + hstep, voffB); PG8_STAGE(PG8_SA(0, 1), cA + hstep, voffA);
        if (wr == 1) PG8_BAR;
        PG8_WAIT_V(4); PG8_BAR;
        PG8_STAGE(PG8_SB(1, 0), cB + kstep, voffB); PG8_STAGE(PG8_SA(1, 0), cA + kstep, voffA); PG8_STAGE(PG8_SB(1, 1), cB + hstep + kstep, voffB);
        PG8_WAIT_V(6); PG8_BAR;
    }
    for (;;) {
        const bool has_next = S.next(ui + 1, nxt);
        const char* nA = has_next ? (const char*)g.A + (size_t)nxt.pm * tstep : cA; const char* nB = has_next ? (const char*)g.Bt + (size_t)nxt.pn * tstep : cB;
        for (int t = 0; t < nt; t += 2) {
            const bool last = (t == nt - 2);
            const char* a1 = cA + (size_t)(t + 1) * kstep;
            const char* a2 = last ? nA : cA + (size_t)(t + 2) * kstep; const char* b2 = last ? nB : cB + (size_t)(t + 2) * kstep;
            const char* a3 = a2 + kstep; const char* b3 = b2 + kstep;
            if (last && has_next) S.a_ready(nxt);
            if constexpr (SP2) {
            PG8_LDB(B0, 0, 0); PG8_LDB(B1, 0, 1); PG8_SCHED; PG8_LDA(At, 0, 0); PG8_STAGE(PG8_SA(1, 1), a1 + hstep, voffA);
            PG8_WAIT_V(8); PG8_WAIT_L(0); PG8_BAR; PG8_MMA(0, 0, At, B0); PG8_MMA(0, 1, At, B1); PG8_BAR; PG8_SCHED;
            PG8_LDA(At, 0, 1); PG8_STAGE(PG8_SB(0, 0), b2, voffB); PG8_STAGE(PG8_SB(0, 1), b2 + hstep, voffB); PG8_STAGE(PG8_SA(0, 0), a2, voffA);
            PG8_WAIT_V(8); PG8_WAIT_L(0); PG8_BAR; PG8_MMA(1, 0, At, B0); PG8_MMA(1, 1, At, B1); PG8_BAR; PG8_SCHED;
            PG8_LDB(B0, 1, 0); PG8_LDB(B1, 1, 1); PG8_SCHED; PG8_LDA(At, 1, 0); PG8_STAGE(PG8_SA(0, 1), a2 + hstep, voffA);
            PG8_WAIT_V(8); PG8_WAIT_L(0); PG8_BAR; PG8_MMA(0, 0, At, B0); PG8_MMA(0, 1, At, B1); PG8_BAR; PG8_SCHED;
            PG8_LDA(At, 1, 1); PG8_STAGE(PG8_SB(1, 0), b3, voffB); PG8_STAGE(PG8_SB(1, 1), b3 + hstep, voffB); PG8_STAGE(PG8_SA(1, 0), a3, voffA);
            PG8_WAIT_V(8); PG8_WAIT_L(0); PG8_BAR; PG8_MMA(1, 0, At, B0); PG8_MMA(1, 1, At, B1); PG8_BAR; PG8_SCHED;
            } else {
            PG8_LDB(B0, 0, 0); PG8_SCHED; PG8_LDA(At, 0, 0); PG8_STAGE(PG8_SA(1, 1), a1 + hstep, voffA);
            PG8_WAIT_L(8); PG8_BAR; PG8_WAIT_L(0); PG8_MMA(0, 0, At, B0); PG8_BAR; PG8_SCHED;
            PG8_LDB(B1, 0, 1); PG8_STAGE(PG8_SB(0, 0), b2, voffB);
            PG8_BAR; PG8_WAIT_L(0); PG8_MMA(0, 1, At, B1); PG8_BAR;
            PG8_LDA(At, 0, 1); PG8_STAGE(PG8_SA(0, 0), a2, voffA);
            PG8_BAR; PG8_WAIT_L(0); PG8_MMA(1, 0, At, B0); PG8_BAR; PG8_SCHED;
            PG8_STAGE(PG8_SB(0, 1), b2 + hstep, voffB);
            PG8_WAIT_V(6); PG8_BAR; PG8_MMA(1, 1, At, B1); PG8_BAR;
            PG8_LDB(B0, 1, 0); PG8_SCHED; PG8_LDA(At, 1, 0); PG8_STAGE(PG8_SA(0, 1), a2 + hstep, voffA);
            PG8_WAIT_L(8); PG8_BAR; PG8_WAIT_L(0); PG8_MMA(0, 0, At, B0); PG8_BAR; PG8_SCHED;
            PG8_LDB(B1, 1, 1); PG8_STAGE(PG8_SB(1, 0), b3, voffB);
            PG8_BAR; PG8_WAIT_L(0); PG8_MMA(0, 1, At, B1); PG8_BAR;
            PG8_LDA(At, 1, 1); PG8_STAGE(PG8_SA(1, 0), a3, voffA);
            PG8_BAR; PG8_WAIT_L(0); PG8_MMA(1, 0, At, B0); PG8_BAR; PG8_SCHED;
            PG8_STAGE(PG8_SB(1, 1), b3 + hstep, voffB);
            PG8_WAIT_V(6); PG8_BAR; PG8_MMA(1, 1, At, B1); PG8_BAR;
            }
        }
        if constexpr (ALIGN_EPI) { if (wr == 0) PG8_BAR; }
        if constexpr (!Epi::AFTER_DRAIN) { E(acc, cur, wr, wc, fr, fq); S.done(cur); }
        if (!has_next) break;
#pragma unroll
        for (int a = 0; a < 2; ++a)
#pragma unroll
            for (int b = 0; b < 2; ++b)
#pragma unroll
                for (int m = 0; m < 4; ++m)
#pragma unroll
                    for (int n = 0; n < 2; ++n) acc[a][b][m][n] = (f32x4){0.f, 0.f, 0.f, 0.f};
        cur = nxt; cA = nA; cB = nB; ++ui;
        if constexpr (ALIGN_EPI) { if (wr == 1) PG8_BAR; }
    }
    PG8_WAIT_V(0);
    if constexpr (!ALIGN_EPI) { if (wr == 0) PG8_BAR; }
    PG8_BAR;
    if constexpr (Epi::AFTER_DRAIN) { E.fused(acc, cur, wr, wc, fr, fq, lds, wid, lane); S.done(cur); }
#undef PG8_SA
#undef PG8_SB
#undef PG8_STAGE
#undef PG8_LDA
#undef PG8_LDB
#undef PG8_MMA
#undef PG8_WAIT_V
#undef PG8_WAIT_L
#undef PG8_BAR
#undef PG8_SCHED
}

struct GUnit { int pm, pn, e, row0; };
template <int STAGE> struct GroupedOrder {
    typedef GUnit UnitT;
    const PG8_LAS int* tab; int G, c; const int* list; const char* Bt;
    __device__ __forceinline__ bool next(int i, GUnit& u) const {
        const int L = i * G + c; if (L >= tab[16]) return false;
        int e = 0;
#pragma unroll
        for (int j = 1; j < 16; ++j) e = (L >= tab[j]) ? j : e;
        const int lt = L - tab[e]; u.e = e; u.pm = lt >> 2; u.pn = lt & 3; u.row0 = tab[48 + e] + u.pm * 256; return true;
    }
    __device__ __forceinline__ unsigned rowoff(const GUnit& u, int r) const {
        if (STAGE == 1) { const int idx = u.pm * 256 + r; const int tok = idx < tab[32 + u.e] ? list[u.e * T + idx] : 0; return (unsigned)tok * 2048u; }
        return (unsigned)(u.row0 + r) * 1024u;
    }
    __device__ __forceinline__ const char* bbase(const GUnit& u) const { return Bt + (size_t)u.e * (3u << 20) + (size_t)u.pn * (STAGE == 1 ? 256 * 1024 * 2 : 256 * 512 * 2); }
    __device__ __forceinline__ void a_ready(const GUnit&) const {}
    __device__ __forceinline__ void done(const GUnit&) const {}
};
struct EpiExp1 {
    static constexpr bool PERM = true, AFTER_DRAIN = false;
    bf16_t* HG; const float* cwl; const PG8_LAS int* tab;
    __device__ __forceinline__ void operator()(const f32x4 (&acc)[2][2][4][2], const GUnit& u, int wr, int wc, int fr, int fq) const {
        const int cnt = tab[32 + u.e];
#pragma unroll
        for (int ai = 0; ai < 2; ++ai)
#pragma unroll
            for (int m = 0; m < 4; ++m) { const int rl = wr * 64 + fr + ai * HALF + m * 16, idx = u.pm * 256 + rl;
                const float cw = idx < cnt ? cwl[u.e * T + idx] : 0.f;
                const f32x4 g0 = acc[ai][0][m][0], g1 = acc[ai][0][m][1], u0 = acc[ai][1][m][0], u1 = acc[ai][1][m][1];
                f32x4 h0, h1;
#pragma unroll
                for (int j = 0; j < 4; ++j) { h0[j] = fsilu(g0[j]) * u0[j] * cw; h1[j] = fsilu(g1[j]) * u1[j] * cw; }
                *(u32x4*)(HG + (size_t)(u.row0 + rl) * 512 + u.pn * 128 + wc * 32 + 8 * fq) = pk8(h0, h1); }
    }
};
struct EpiExp2 {
    static constexpr bool PERM = true, AFTER_DRAIN = false;
    bf16_t* YG;
    __device__ __forceinline__ void operator()(const f32x4 (&acc)[2][2][4][2], const GUnit& u, int wr, int wc, int fr, int fq) const {
#pragma unroll
        for (int ai = 0; ai < 2; ++ai)
#pragma unroll
            for (int m = 0; m < 4; ++m) { const int rl = wr * 64 + fr + ai * HALF + m * 16; bf16_t* p = YG + (size_t)(u.row0 + rl) * 1024 + u.pn * 256 + wc * 32 + 8 * fq;
#pragma unroll
                for (int bj = 0; bj < 2; ++bj) *(u32x4*)(p + bj * HALF) = pk8(acc[ai][bj][m][0], acc[ai][bj][m][1]); }
    }
};
template <class Epi, class Sched, bool ALIGN_EPI = false>
__device__ __forceinline__ void gemm_phase_g(PG8_LAS unsigned char* lds, const char* Abase, const int K, const Sched& S, const Epi& E) {
    constexpr bool SP2 = true;
    const int tid = otid(), wid = __builtin_amdgcn_readfirstlane(tid >> 6), lane = tid & 63, wr = wid >> 2, wc = wid & 3, fr = lane & 15, fq = lane >> 4;
    const int nt = K / BK;
    unsigned voffB[2]; int RA[2], CA2[2];
#pragma unroll
    for (int i = 0; i < 2; ++i) { int R, C; stage_rc(tid * 16 + i * 8192, R, C); const int Rb = Epi::PERM ? ((R & ~31) + perm32(R & 31)) : R;
        RA[i] = R; CA2[i] = C * 2; voffB[i] = (unsigned)(Rb * K + C) * 2u; }
    const size_t kstep = (size_t)(BK * 2);
    const size_t hstep = (size_t)HALF * K * 2;
    const size_t tstep = 2 * hstep;
    const unsigned ldsw = (unsigned)wid * 1024u;
    const int aoff = lds_byte(wr * 64 + fr, fq * 8), boff = lds_byte(wc * 32 + fr, fq * 8);
#define PG8_SA(b, h) (((b) * 2 + (h)) * HTB)
#define PG8_SB(b, h) ((4 + (b) * 2 + (h)) * HTB)
#define PG8_STAGE_A(bufoff, h, kb, nx) do { _Pragma("unroll") for (int _i = 0; _i < 2; ++_i) \
        __builtin_amdgcn_global_load_lds((const unsigned*)(Abase + ((nx) ? vAn[h][_i] : vAc[h][_i]) + (kb)), (PG8_LAS unsigned*)(lds + (bufoff) + ldsw + _i * 8192), 16, 0, 0); } while (0)
#define PG8_STAGE(bufoff, gbase, voff) do { _Pragma("unroll") for (int _i = 0; _i < 2; ++_i) \
        __builtin_amdgcn_global_load_lds((const unsigned*)((const char*)(gbase) + (voff)[_i]), (PG8_LAS unsigned*)(lds + (bufoff) + ldsw + _i * 8192), 16, 0, 0); } while (0)
#define PG8_LDA(dst, b, h) do { _Pragma("unroll") for (int m = 0; m < 4; ++m) _Pragma("unroll") for (int k = 0; k < 2; ++k) dst[m][k] = *(const PG8_LAS bf16x8*)(lds + PG8_SA(b, h) + aoff + m * 2048 + k * 1024); } while (0)
#define PG8_LDB(dst, b, h) do { _Pragma("unroll") for (int n = 0; n < 2; ++n) _Pragma("unroll") for (int k = 0; k < 2; ++k) dst[n][k] = *(const PG8_LAS bf16x8*)(lds + PG8_SB(b, h) + boff + n * 2048 + k * 1024); } while (0)
#define PG8_MMA(ai, bj, At, Bt) do { __builtin_amdgcn_s_setprio(1); _Pragma("unroll") for (int m = 0; m < 4; ++m) _Pragma("unroll") for (int n = 0; n < 2; ++n) _Pragma("unroll") for (int k = 0; k < 2; ++k) \
        acc[ai][bj][m][n] = __builtin_amdgcn_mfma_f32_16x16x32_bf16(Bt[n][k], At[m][k], acc[ai][bj][m][n], 0, 0, 0); __builtin_amdgcn_s_setprio(0); } while (0)
#define PG8_WAIT_V(n) asm volatile("s_waitcnt vmcnt(" #n ")" ::: "memory")
#define PG8_WAIT_L(n) asm volatile("s_waitcnt lgkmcnt(" #n ")" ::: "memory")
#define PG8_BAR __builtin_amdgcn_s_barrier()
#define PG8_SCHED __builtin_amdgcn_sched_barrier(0)
    typename Sched::UnitT cur, nxt; int ui = 0;
    if (!S.next(0, cur)) return;
    unsigned vAc[2][2], vAn[2][2];
#pragma unroll
    for (int h = 0; h < 2; ++h)
#pragma unroll
        for (int i = 0; i < 2; ++i) { vAc[h][i] = S.rowoff(cur, h * HALF + RA[i]) + (unsigned)CA2[i]; vAn[h][i] = vAc[h][i]; }
    f32x4 acc[2][2][4][2];
#pragma unroll
    for (int a = 0; a < 2; ++a)
#pragma unroll
        for (int b = 0; b < 2; ++b)
#pragma unroll
            for (int m = 0; m < 4; ++m)
#pragma unroll
                for (int n = 0; n < 2; ++n) acc[a][b][m][n] = (f32x4){0.f, 0.f, 0.f, 0.f};
    bf16x8 At[4][2], B0[2][2], B1[2][2];
    const char* cB = S.bbase(cur);
    S.a_ready(cur);
    if constexpr (SP2) {
        PG8_STAGE(PG8_SB(0, 0), cB, voffB); PG8_STAGE(PG8_SB(0, 1), cB + hstep, voffB); PG8_STAGE_A(PG8_SA(0, 0), 0, 0, false); PG8_STAGE_A(PG8_SA(0, 1), 1, 0, false);
        if (wr == 1) PG8_BAR;
        PG8_WAIT_V(2); PG8_BAR;
        PG8_STAGE(PG8_SB(1, 0), cB + kstep, voffB); PG8_STAGE_A(PG8_SA(1, 0), 0, (unsigned)kstep, false); PG8_STAGE(PG8_SB(1, 1), cB + hstep + kstep, voffB);
        PG8_WAIT_V(6); PG8_BAR;
    }
    for (;;) {
        const bool has_next = S.next(ui + 1, nxt);
        const char* nB = has_next ? S.bbase(nxt) : cB;
        if (has_next) {
#pragma unroll
            for (int h = 0; h < 2; ++h)
#pragma unroll
                for (int i = 0; i < 2; ++i) vAn[h][i] = S.rowoff(nxt, h * HALF + RA[i]) + (unsigned)CA2[i];
        }
        for (int t = 0; t < nt; t += 2) {
            const bool last = (t == nt - 2);
            const unsigned kb1 = (unsigned)(t + 1) * (unsigned)kstep;
            const unsigned kb2 = last ? 0u : (unsigned)(t + 2) * (unsigned)kstep; const char* b2 = last ? nB : cB + (size_t)(t + 2) * kstep;
            const unsigned kb3 = kb2 + (unsigned)kstep; const char* b3 = b2 + kstep;
            if (last && has_next) S.a_ready(nxt);
            if constexpr (SP2) {
            PG8_LDB(B0, 0, 0); PG8_LDB(B1, 0, 1); PG8_SCHED; PG8_LDA(At, 0, 0); PG8_STAGE_A(PG8_SA(1, 1), 1, kb1, false);
            PG8_WAIT_V(8); PG8_WAIT_L(0); PG8_BAR; PG8_MMA(0, 0, At, B0); PG8_MMA(0, 1, At, B1); PG8_BAR; PG8_SCHED;
            PG8_LDA(At, 0, 1); PG8_STAGE(PG8_SB(0, 0), b2, voffB); PG8_STAGE(PG8_SB(0, 1), b2 + hstep, voffB); PG8_STAGE_A(PG8_SA(0, 0), 0, kb2, last);
            PG8_WAIT_V(8); PG8_WAIT_L(0); PG8_BAR; PG8_MMA(1, 0, At, B0); PG8_MMA(1, 1, At, B1); PG8_BAR; PG8_SCHED;
            PG8_LDB(B0, 1, 0); PG8_LDB(B1, 1, 1); PG8_SCHED; PG8_LDA(At, 1, 0); PG8_STAGE_A(PG8_SA(0, 1), 1, kb2, last);
            PG8_WAIT_V(8); PG8_WAIT_L(0); PG8_BAR; PG8_MMA(0, 0, At, B0); PG8_MMA(0, 1, At, B1); PG8_BAR; PG8_SCHED;
            PG8_LDA(At, 1, 1); PG8_STAGE(PG8_SB(1, 0), b3, voffB); PG8_STAGE(PG8_SB(1, 1), b3 + hstep, voffB); PG8_STAGE_A(PG8_SA(1, 0), 0, kb3, last);
            PG8_WAIT_V(8); PG8_WAIT_L(0); PG8_BAR; PG8_MMA(1, 0, At, B0); PG8_MMA(1, 1, At, B1); PG8_BAR; PG8_SCHED;
            }
        }
        if constexpr (ALIGN_EPI) { if (wr == 0) PG8_BAR; }
        if constexpr (!Epi::AFTER_DRAIN) { E(acc, cur, wr, wc, fr, fq); S.done(cur); }
        if (!has_next) break;
#pragma unroll
        for (int a = 0; a < 2; ++a)
#pragma unroll
            for (int b = 0; b < 2; ++b)
#pragma unroll
                for (int m = 0; m < 4; ++m)
#pragma unroll
                    for (int n = 0; n < 2; ++n) acc[a][b][m][n] = (f32x4){0.f, 0.f, 0.f, 0.f};
        cur = nxt; cB = nB; ++ui;
#pragma unroll
        for (int h = 0; h < 2; ++h)
#pragma unroll
            for (int i = 0; i < 2; ++i) vAc[h][i] = vAn[h][i];
        if constexpr (ALIGN_EPI) { if (wr == 1) PG8_BAR; }
    }
    PG8_WAIT_V(0);
    if constexpr (!ALIGN_EPI) { if (wr == 0) PG8_BAR; }
    PG8_BAR;
    if constexpr (Epi::AFTER_DRAIN) { E.fused(acc, cur, wr, wc, fr, fq, lds, wid, lane); S.done(cur); }
#undef PG8_SA
#undef PG8_SB
#undef PG8_STAGE
#undef PG8_STAGE_A
#undef PG8_LDA
#undef PG8_LDB
#undef PG8_MMA
#undef PG8_WAIT_V
#undef PG8_WAIT_L
#undef PG8_BAR
#undef PG8_SCHED
}
}


__device__ __forceinline__ void tr_item(const float* W, int ldw, int k0, int n0, bf16_t* WT, int K, int drow0, const float* gain, float scale, LAS float* scr, int lane) {
#pragma unroll 8
    for (int i = 0; i < 32; ++i) { const int kk = 2 * i + (lane >> 5); const float g = gain ? gain[k0 + kk] * scale : scale;
        scr[kk * 33 + (lane & 31)] = W[(size_t)(k0 + kk) * ldw + n0 + (lane & 31)] * g; }
    asm volatile("s_waitcnt lgkmcnt(0)" ::: "memory");
    const int c = lane & 7;
#pragma unroll
    for (int j = 0; j < 4; ++j) { const int n = (lane >> 3) + 8 * j; const LAS float* s = scr + (8 * c) * 33 + n;
        uint4 o; o.x = pack2(s[0 * 33], s[1 * 33]); o.y = pack2(s[2 * 33], s[3 * 33]); o.z = pack2(s[4 * 33], s[5 * 33]); o.w = pack2(s[6 * 33], s[7 * 33]);
        *(uint4*)(WT + (size_t)(drow0 + n) * K + k0 + 8 * c) = o; }
    asm volatile("s_waitcnt lgkmcnt(0)" ::: "memory");
}
__device__ __forceinline__ void tr_job(int it, const float* W, int ldw, int K, int N, bf16_t* WT, int drow_base, const float* gain, float scale, LAS float* scr, int lane) {
    const int nblk = N / 32, kb = it / nblk, nb = it % nblk;
    tr_item(W, ldw, kb * 64, nb * 32, WT, K, drow_base + nb * 32, gain, scale, scr, lane);
}
__device__ void convert_dense_weights(const Params& p, unsigned char* lds) {
    const int wave = otid() >> 6, lane = otid() & 63;
    LAS float* scr = (LAS float*)(LAS unsigned char*)lds + wave * 2176;
    bf16_t* WB = (bf16_t*)(p.ws + OFF_WB);
    bf16_t* Win = WB + W_IN / 2; bf16_t* Wout = WB + W_OUT / 2; bf16_t* Wkvq = WB + W_KVQ / 2; bf16_t* Wo = WB + W_O / 2;
    constexpr int I0 = 16 * 192, I1 = 32 * 32, I2 = 16 * 64, I3 = 16 * 32, I4 = 16 * 32, NIT = I0 + I1 + I2 + I3 + I4;
    for (int it = obid() * 8 + wave; it < NIT; it += gridDim.x * 8) {
        int r = it;
        if (r < I0) { const int nb = r % 192; const float sc = (nb >= 32 && nb < 64) ? 0.0625f : 1.f;
            tr_job(r, p.ret_w_in, 6144, 1024, 6144, Win, 0, p.ret_norm, sc, scr, lane); continue; } r -= I0;
        if (r < I1) { tr_job(r, p.ret_w_out, 1024, 2048, 1024, Wout, 0, nullptr, 1.f, scr, lane); continue; } r -= I1;
        if (r < I2) { tr_job(r, p.w_kv, 2048, 1024, 2048, Wkvq, 0, p.kv_norm, 1.f, scr, lane); continue; } r -= I2;
        if (r < I3) { tr_job(r, p.w_q, 1024, 1024, 1024, Wkvq, 2048, p.attn_norm, 0.08838834764831845f, scr, lane); continue; } r -= I3;
        tr_job(r, p.w_o, 1024, 1024, 1024, Wo, 0, nullptr, 1.f, scr, lane);
    }
}
__device__ void convert_expert_weights(const Params& p, int L, unsigned char* lds) {
    const int wave = otid() >> 6, lane = otid() & 63;
    LAS float* scr = (LAS float*)(LAS unsigned char*)lds + wave * 2176;
    bf16_t* E = (bf16_t*)(p.ws + OFF_BIG + B_E);
    const float* gain = p.ffn_norm + L * 1024;
    for (int it = obid() * 8 + wave; it < 16 * 768; it += gridDim.x * 8) {
        const int e = it / 768; int r = it % 768;
        bf16_t* W1 = E + (size_t)e * 3 * 512 * 1024; bf16_t* W2 = W1 + 1024 * 1024;
        if (r < 512) { const int up = r >= 256; r &= 255; const int kb = r / 16, nb = r % 16, f0 = nb * 32;
            const float* W = (up ? p.wu : p.wg) + (size_t)(L * 16 + e) * 1024 * 512;
            tr_item(W, 512, kb * 64, f0, W1, 1024, (f0 >> 7) * 256 + up * 128 + (f0 & 127), gain, 1.f, scr, lane);
        } else { r -= 512; tr_job(r, p.wd + (size_t)(L * 16 + e) * 512 * 1024, 1024, 512, 1024, W2, 0, nullptr, 1.f, scr, lane); }
    }
}

__device__ void phase_prologue(const Params& p, unsigned char* lds) {
    const int gtid = obid() * 512 + otid(), gsz = gridDim.x * 512;
    int* cnt = (int*)(p.ws + OFF_CTRL);
    if (gtid < 64) cnt[gtid] = 0;
    float* rc = (float*)(p.ws + OFF_TABRET); float* rs = rc + 8192 * 128;
    for (int i = gtid; i < 8192 * 128; i += gsz) { const int pos = i >> 7, f = i & 127;
        const float inv = (float)exp(-9.2103403719761836 * ((double)f / 128.0));
        const float ang = (float)pos * inv; double s, c; sincos_big((double)ang, s, c); rc[i] = (float)c; rs[i] = (float)s; }
    float* pc = (float*)(p.ws + OFF_TABROPE); float* ps = pc + 8192 * 16;
    for (int i = gtid; i < 8192 * 16; i += gsz) { const int pos = i >> 4, f = i & 15;
        const float inv = (float)exp(-13.122363377404328 * ((double)f / 16.0));
        const float ang = (float)pos * inv; double s, c; sincos_big((double)ang, s, c); pc[i] = (float)c; ps[i] = (float)s; }
    convert_dense_weights(p, lds);
    norm_pass<0>(p, 0, lds);
}

__device__ void phase_ret_rotary(const Params& p) {
    bf16_t* QK = (bf16_t*)(p.ws + OFF_BIG + B_QK);
    const float* rc = (const float*)(p.ws + OFF_TABRET); const float* rs = rc + 8192 * 128;
    const size_t total = (size_t)T * 8 * 128;
    for (size_t i = (size_t)obid() * 512 + otid(); i < total; i += (size_t)gridDim.x * 512) {
        const int f = (int)(i & 127), slot = (int)((i >> 7) & 7), t = (int)(i >> 10), pos = t & 8191;
        bf16_t* px = QK + (size_t)t * 2048 + slot * 256 + f;
        const float x1 = bf2f(px[0]), x2 = bf2f(px[128]), c = rc[pos * 128 + f], s = rs[pos * 128 + f];
        const float sc = slot >= 4 ? 0.0625f : 1.f;
        px[0] = f2bf((x1 * c - x2 * s) * sc); px[128] = f2bf((x2 * c + x1 * s) * sc);
    }
}

__device__ void phase_ret_scan(const Params& p) {
    const bf16_t* QK = (const bf16_t*)(p.ws + OFF_BIG + B_QK); const bf16_t* V = (const bf16_t*)(p.ws + OFF_BIG + B_V); bf16_t* O = (bf16_t*)(p.ws + OFF_BIG + B_O);
    const int wave = otid() >> 6, lane = otid() & 63;
    for (int item = obid() * 8 + wave; item < 2048; item += gridDim.x * 8) {
        const int b = item >> 10, h = (item >> 8) & 3, ep = item & 255;
        const float gamma = 1.f - exp2f(-5.f - (float)h);
        float S[4][2];
#pragma unroll
        for (int d = 0; d < 4; ++d) { S[d][0] = 0.f; S[d][1] = 0.f; }
        const bf16_t* qp = QK + (size_t)b * SEQ * 2048 + h * 256 + lane * 4;
        const bf16_t* kp = qp + 1024;
        const bf16_t* vp = V + (size_t)b * SEQ * 2048 + h * 512 + ep * 2;
        bf16_t* op = O + (size_t)b * SEQ * 2048 + h * 512 + ep * 2;
#pragma unroll 4
        for (int t = 0; t < SEQ; ++t) {
            const uint2 qv = *(const uint2*)(qp + (size_t)t * 2048), kv = *(const uint2*)(kp + (size_t)t * 2048); const unsigned vv = *(const unsigned*)(vp + (size_t)t * 2048);
            const float q[4] = {bflo(qv.x), bfhi(qv.x), bflo(qv.y), bfhi(qv.y)}, k[4] = {bflo(kv.x), bfhi(kv.x), bflo(kv.y), bfhi(kv.y)};
            const float v0 = bflo(vv), v1 = bfhi(vv);
            float p0 = 0.f, p1 = 0.f;
#pragma unroll
            for (int d = 0; d < 4; ++d) { S[d][0] = gamma * S[d][0] + k[d] * v0; S[d][1] = gamma * S[d][1] + k[d] * v1; p0 += q[d] * S[d][0]; p1 += q[d] * S[d][1]; }
            p0 = wsum(p0); p1 = wsum(p1);
            if (lane == 0) *(unsigned*)(op + (size_t)t * 2048) = pack2(p0, p1);
        }
    }
}

__device__ void phase_ret_gnorm(const Params& p) {
    bf16_t* O = (bf16_t*)(p.ws + OFF_BIG + B_O);
    const int wave = otid() >> 6, lane = otid() & 63;
    for (int item = obid() * 8 + wave; item < T * 4; item += gridDim.x * 8) {
        bf16_t* po = O + (size_t)item * 512 + lane * 8;
        const uint4 u = *(const uint4*)po;
        float v[8] = {bflo(u.x), bfhi(u.x), bflo(u.y), bfhi(u.y), bflo(u.z), bfhi(u.z), bflo(u.w), bfhi(u.w)};
        float ss = 0.f;
#pragma unroll
        for (int i = 0; i < 8; ++i) ss += v[i] * v[i];
        ss = wsum(ss);
        const float rstd = 1.0f / sqrtf(ss * (1.0f / 512.0f) + 1e-6f);
        uint4 o; o.x = pack2(v[0] * rstd, v[1] * rstd); o.y = pack2(v[2] * rstd, v[3] * rstd); o.z = pack2(v[4] * rstd, v[5] * rstd); o.w = pack2(v[6] * rstd, v[7] * rstd);
        *(uint4*)po = o;
    }
}

__device__ void phase_rope(const Params& p) {
    bf16_t* Kb = (bf16_t*)(p.ws + OFF_BIG + B_K); bf16_t* Qb = (bf16_t*)(p.ws + OFF_BIG + B_Q);
    const float* pc = (const float*)(p.ws + OFF_TABROPE); const float* ps = pc + 8192 * 16;
    const size_t total = (size_t)T * 2 * 8 * 16;
    for (size_t i = (size_t)obid() * 512 + otid(); i < total; i += (size_t)gridDim.x * 512) {
        const int f = (int)(i & 15), h = (int)((i >> 4) & 7), which = (int)((i >> 7) & 1), t = (int)(i >> 8), pos = t & 8191;
        bf16_t* px = (which ? Qb : Kb) + (size_t)t * 1024 + h * 128 + f;
        const float x1 = bf2f(px[0]), x2 = bf2f(px[16]), c = pc[pos * 16 + f], s = ps[pos * 16 + f];
        px[0] = f2bf(x1 * c - x2 * s); px[16] = f2bf(x2 * c + x1 * s);
    }
}
__device__ void phase_qscale(const Params& p) {
    bf16_t* Qb = (bf16_t*)(p.ws + OFF_BIG + B_Q);
    const size_t total = (size_t)T * 1024;
    const float sc = 0.08838834764831845f;
    for (size_t i = (size_t)obid() * 512 + otid(); i < total; i += (size_t)gridDim.x * 512) Qb[i] = f2bf(bf2f(Qb[i]) * sc);
}

__device__ void phase_kmean(const Params& p) {
    const bf16_t* Kb = (const bf16_t*)(p.ws + OFF_BIG + B_K); float* km = (float*)(p.ws + OFF_KMEAN);
    for (int i = obid() * 512 + otid(); i < 2 * 32 * 1024; i += gridDim.x * 512) {
        const int col = i & 1023, n = (i >> 10) & 31, b = i >> 15, h = col >> 7, d = col & 127;
        const bf16_t* pk = Kb + ((size_t)b * SEQ + n * 256) * 1024 + col;
        float s = 0.f;
        for (int j = 0; j < 256; ++j) s += bf2f(pk[(size_t)j * 1024]);
        km[(((size_t)b * 8 + h) * 32 + n) * 128 + d] = s * (1.0f / 256.0f);
    }
}

__device__ void phase_moba_naive(const Params& p, float* sm) {
    const bf16_t* Kb = (const bf16_t*)(p.ws + OFF_BIG + B_K); const bf16_t* Vb = (const bf16_t*)(p.ws + OFF_BIG + B_VB); const bf16_t* Qb = (const bf16_t*)(p.ws + OFF_BIG + B_Q);
    const float* kmean = (const float*)(p.ws + OFF_KMEAN); bf16_t* AO = (bf16_t*)(p.ws + OFF_BIG + B_AO);
    const int wave = otid() >> 6, lane = otid() & 63;
    float* qs = sm + wave * 128;
    for (int item = obid() * 8 + wave; item < T * 8; item += gridDim.x * 8) {
        const int tg = item >> 3, h = item & 7, b = tg >> 13, s = tg & 8191, blk = s >> 8;
        const unsigned qq = *(const unsigned*)(Qb + (size_t)tg * 1024 + h * 128 + lane * 2);
        qs[lane * 2] = bflo(qq); qs[lane * 2 + 1] = bfhi(qq);
        __builtin_amdgcn_wave_barrier();
        float g = -INFINITY;
        if (lane < blk) { const float* km = kmean + (((size_t)b * 8 + h) * 32 + lane) * 128; float a = 0.f; for (int d = 0; d < 128; ++d) a += qs[d] * km[d]; g = a; }
        const int nsel = blk < 3 ? blk : 3;
        int sel[3];
#pragma unroll
        for (int j = 0; j < 3; ++j) {
            sel[j] = 0;
            if (j < nsel) { const float m = wmax(g); const unsigned long long bal = __ballot(g == m); const int idx = __ffsll((long long)bal) - 1; sel[j] = idx; if (lane == idx) g = -INFINITY; }
        }
        float sc[4][4];
#pragma unroll
        for (int seg = 0; seg < 4; ++seg) {
            const int bid = seg < 3 ? sel[seg] : blk; const bool valid = seg < 3 ? (seg < nsel) : true; const int nkeys = seg < 3 ? 256 : (s - blk * 256 + 1);
#pragma unroll
            for (int kk = 0; kk < 4; ++kk) {
                const int key = kk * 64 + lane; float v = -INFINITY;
                if (valid && key < nkeys) {
                    const bf16_t* kr = Kb + ((size_t)b * SEQ + bid * 256 + key) * 1024 + h * 128; float a = 0.f;
#pragma unroll 4
                    for (int d8 = 0; d8 < 16; ++d8) { const uint4 u = *(const uint4*)(kr + d8 * 8); const float* q8 = qs + d8 * 8;
                        a += q8[0] * bflo(u.x) + q8[1] * bfhi(u.x) + q8[2] * bflo(u.y) + q8[3] * bfhi(u.y) + q8[4] * bflo(u.z) + q8[5] * bfhi(u.z) + q8[6] * bflo(u.w) + q8[7] * bfhi(u.w); }
                    v = a;
                }
                sc[seg][kk] = v;
            }
        }
        float m = -INFINITY;
#pragma unroll
        for (int seg = 0; seg < 4; ++seg)
#pragma unroll
            for (int kk = 0; kk < 4; ++kk) m = fmaxf(m, sc[seg][kk]);
        m = wmax(m);
        float l = 0.f;
#pragma unroll
        for (int seg = 0; seg < 4; ++seg)
#pragma unroll
            for (int kk = 0; kk < 4; ++kk) { const float e = expf(sc[seg][kk] - m); sc[seg][kk] = e; l += e; }
        l = wsum(l);
        float o0 = 0.f, o1 = 0.f;
#pragma unroll
        for (int seg = 0; seg < 4; ++seg) {
            const int bid = seg < 3 ? sel[seg] : blk; const bool valid = seg < 3 ? (seg < nsel) : true; const int nkeys = seg < 3 ? 256 : (s - blk * 256 + 1);
            if (valid) {
#pragma unroll
                for (int kk = 0; kk < 4; ++kk) {
                    if (kk * 64 < nkeys) {
                        const bf16_t* vr = Vb + ((size_t)b * SEQ + bid * 256 + kk * 64) * 1024 + h * 128 + lane * 2;
                        for (int src = 0; src < 64; ++src) { const float pp = __shfl(sc[seg][kk], src); const unsigned vv = *(const unsigned*)(vr + (size_t)src * 1024); o0 += pp * bflo(vv); o1 += pp * bfhi(vv); }
                    }
                }
            }
        }
        const float il = 1.0f / l;
        *(unsigned*)(AO + (size_t)tg * 1024 + h * 128 + lane * 2) = pack2(o0 * il, o1 * il);
        __builtin_amdgcn_wave_barrier();
    }
}

template <class Epi>
__device__ __forceinline__ void dense_gemm(unsigned char* lds, const bf16_t* A, const bf16_t* Bt, int N, int K, const Epi& E) {
    pg8::Gemm g{A, Bt, T, N, K}; pg8::StaticOrder S; S.init(T, N, (int)gridDim.x, obid());
    pg8::gemm_phase<Epi, pg8::StaticOrder, true, true>((LAS unsigned char*)lds, g, S, E);
}

template <int STAGE>
__device__ __forceinline__ void expert_gemm(const Params& p, int L, unsigned char* lds) {
    Route R = get_route(p, L);
    LAS int* tab = (LAS int*)((LAS unsigned char*)lds + 131072);
    __syncthreads();
    if (otid() == 0) { int s = 0, b = 0; for (int e = 0; e < 16; ++e) { const int c = R.cnt[e]; tab[e] = s; tab[32 + e] = c; tab[48 + e] = b; s += ((c + 255) >> 8) * 4; b += (c + 255) & ~255; } tab[16] = s; }
    __syncthreads();
    const bf16_t* E = (const bf16_t*)(p.ws + OFF_BIG + B_E);
    bf16_t* HG = (bf16_t*)(p.ws + OFF_BIG + B_HG); bf16_t* YG = (bf16_t*)(p.ws + OFF_BIG + B_YG);
    if (STAGE == 1) {
        pg8::GroupedOrder<1> S{tab, (int)gridDim.x, obid(), R.list, (const char*)E};
        pg8::EpiExp1 Ep{HG, R.cwl, tab};
        pg8::gemm_phase_g<pg8::EpiExp1, pg8::GroupedOrder<1>, true>((LAS unsigned char*)lds, (const char*)(p.ws + OFF_XN), 1024, S, Ep);
    } else {
        pg8::GroupedOrder<2> S{tab, (int)gridDim.x, obid(), nullptr, (const char*)E + (2u << 20)};
        pg8::EpiExp2 Ep{YG};
        pg8::gemm_phase_g<pg8::EpiExp2, pg8::GroupedOrder<2>, true>((LAS unsigned char*)lds, (const char*)HG, 512, S, Ep);
    }
}

constexpr int NPHASE = 20;
__device__ __forceinline__ void run_phase(const Params& p, int ph, unsigned char* lds) {
    float* sm = (float*)lds;
    unsigned char* big = p.ws + OFF_BIG;
    const bf16_t* XN = (const bf16_t*)(p.ws + OFF_XN);
    const bf16_t* WB = (const bf16_t*)(p.ws + OFF_WB);
    switch (ph) {
    case 0: phase_prologue(p, lds); break;
    case 1: { pg8::EpiInproj E{(bf16_t*)(big + B_QK), (bf16_t*)(big + B_V), (const float*)(p.ws + OFF_TABRET), (const float*)(p.ws + OFF_TABRET) + 8192 * 128};
        dense_gemm(lds, XN, WB + W_IN / 2, 4096, 1024, E); } break;
    case 2: phase_ret_scan(p); break;
    case 3: phase_ret_gnorm(p); break;
    case 4: { pg8::EpiG E{(bf16_t*)(big + B_O)}; dense_gemm(lds, XN, WB + W_IN / 2 + (size_t)4096 * 1024, 2048, 1024, E); } break;
    case 5: { pg8::EpiResid E{p.x, p.out}; dense_gemm(lds, (const bf16_t*)(big + B_O), WB + W_OUT / 2, 1024, 2048, E); } break;
    case 6: convert_expert_weights(p, 0, lds); __syncthreads(); norm_pass<1>(p, 0, lds); break;
    case 7: expert_gemm<1>(p, 0, lds); break;
    case 8: expert_gemm<2>(p, 0, lds); break;
    case 9: norm_pass<2>(p, 0, lds); break;
    case 10: { pg8::EpiKVQ E{(bf16_t*)(big + B_K), (bf16_t*)(big + B_VB), (bf16_t*)(big + B_Q), (const float*)(p.ws + OFF_TABROPE), (const float*)(p.ws + OFF_TABROPE) + 8192 * 16};
        dense_gemm(lds, XN, WB + W_KVQ / 2, 3072, 1024, E); } break;
    case 11: phase_kmean(p); break;
    case 12: phase_moba_naive(p, sm); break;
    case 13: { pg8::EpiResid E{p.out, p.out}; dense_gemm(lds, (const bf16_t*)(big + B_AO), WB + W_O / 2, 1024, 1024, E); } break;
    case 14: convert_expert_weights(p, 1, lds); __syncthreads(); norm_pass<1>(p, 1, lds); break;
    case 15: expert_gemm<1>(p, 1, lds); break;
    case 16: expert_gemm<2>(p, 1, lds); break;
    case 17: norm_pass<3>(p, 1, lds); break;
    default: break;
    }
}
constexpr int LAST_PHASE = 17;

#if MK_SINGLE
template <int PH> __device__ __forceinline__ void run_all(const Params& p, unsigned char* lds, cg::grid_group& grid) {
    run_phase(p, PH, lds);
    if constexpr (PH < LAST_PHASE) { grid.sync(); run_all<PH + 1>(p, lds, grid); }
}
__global__ void __launch_bounds__(512) mega(Params p) {
    extern __shared__ __attribute__((aligned(16))) unsigned char lds[];
    cg::grid_group grid = cg::this_grid();
    run_all<0>(p, lds, grid);
}
#else
template <int PH> __global__ void __launch_bounds__(512) phase_kernel(Params p) {
    extern __shared__ __attribute__((aligned(16))) unsigned char lds[];
    run_phase(p, PH, lds);
}
template <int PH> static void launch_phases(const Params& p, int grid, hipStream_t stream) {
    if constexpr (PH <= LAST_PHASE) {
        static bool attr = false;
        if (!attr) { (void)hipFuncSetAttribute((const void*)phase_kernel<PH>, hipFuncAttributeMaxDynamicSharedMemorySize, LDS_BYTES); attr = true; }
        phase_kernel<PH><<<grid, 512, LDS_BYTES, stream>>>(p); launch_phases<PH + 1>(p, grid, stream); }
}
#endif

extern "C" void kernel_launch(void* const* d_in, const int* in_sizes, int n_in, void* d_out, int out_size, void* d_ws, size_t ws_size, hipStream_t stream) {
    if (ws_size < WS_NEED) { fprintf(stderr, "workspace too small: %zu < %zu\n", ws_size, WS_NEED); return; }
    Params p{};
    p.x = (const float*)d_in[0]; p.ret_norm = (const float*)d_in[1]; p.ret_w_in = (const float*)d_in[2]; p.ret_w_out = (const float*)d_in[3]; p.kv_norm = (const float*)d_in[4];
    p.w_kv = (const float*)d_in[5]; p.attn_norm = (const float*)d_in[6]; p.w_q = (const float*)d_in[7]; p.w_o = (const float*)d_in[8]; p.ffn_norm = (const float*)d_in[9];
    p.rg_w = (const float*)d_in[10]; p.rg_b = (const float*)d_in[11]; p.re_w = (const float*)d_in[12]; p.re_b = (const float*)d_in[13]; p.wg = (const float*)d_in[14];
    p.wu = (const float*)d_in[15]; p.wd = (const float*)d_in[16]; p.final_norm = (const float*)d_in[17];
    p.out = (float*)d_out; p.ws = (unsigned char*)d_ws;
    static int grid_blocks = 0;
    if (!grid_blocks) {
        int dev = 0, cus = 0, per_cu = 0;
        (void)hipGetDevice(&dev);
        (void)hipDeviceGetAttribute(&cus, hipDeviceAttributeMultiprocessorCount, dev);
#if MK_SINGLE
        if (hipFuncSetAttribute((const void*)mega, hipFuncAttributeMaxDynamicSharedMemorySize, LDS_BYTES) != hipSuccess) fprintf(stderr, "hipFuncSetAttribute failed\n");
        if (hipOccupancyMaxActiveBlocksPerMultiprocessor(&per_cu, (const void*)mega, 512, LDS_BYTES) != hipSuccess || per_cu < 1) fprintf(stderr, "occupancy query: %d blocks per CU\n", per_cu);
#endif
        grid_blocks = cus;
    }
#if MK_SINGLE
    void* args[] = {&p};
    hipError_t e = hipLaunchCooperativeKernel((void*)mega, dim3(grid_blocks), dim3(512), args, LDS_BYTES, stream);
    if (e != hipSuccess) fprintf(stderr, "cooperative launch failed: %s (grid %d)\n", hipGetErrorString(e), grid_blocks);
#else
    launch_phases<0>(p, grid_blocks, stream);
#endif
}
```

```cpp
#include <hip/hip_runtime.h>
#include <hip/hip_cooperative_groups.h>
#include <cstdio>
#include <cstdint>
namespace cg = cooperative_groups;

#ifndef MK_SINGLE
#define MK_SINGLE 1
#endif

typedef unsigned short bf16_t;
#define LAS __attribute__((address_space(3)))
typedef float v4f __attribute__((ext_vector_type(4)));
typedef unsigned v4u __attribute__((ext_vector_type(4)));
constexpr int T = 16384, SEQ = 8192;
constexpr size_t MiB = (size_t)1 << 20;
constexpr size_t OFF_CTRL = 0, OFF_ROUTE = 1 * MiB, OFF_KMEAN = 3 * MiB + 512 * 1024, OFF_TABROPE = 4 * MiB,
                 OFF_WB = 8 * MiB, OFF_XN = 32 * MiB, OFF_BIG = 64 * MiB, OFF_EXTRA = 288 * MiB, OFF_TABRET = OFF_EXTRA, WS_NEED = 304 * MiB;
constexpr size_t W_IN = 0, W_OUT = 12 * MiB, W_KVQ = 16 * MiB, W_O = 22 * MiB;
constexpr int LDS_BYTES = 147456;
constexpr size_t B_QK = 0, B_V = 64 * MiB, B_O = 128 * MiB, B_ST = 192 * MiB;
constexpr size_t B_E = 0, B_HG = 48 * MiB, B_YG = 84 * MiB;
constexpr size_t B_K = 0, B_VB = 32 * MiB, B_Q = 64 * MiB, B_PART = 96 * MiB, B_AO = 192 * MiB;

struct Params {
    const float *x, *ret_norm, *ret_w_in, *ret_w_out, *kv_norm, *w_kv, *attn_norm, *w_q, *w_o, *ffn_norm, *rg_w, *rg_b, *re_w, *re_b, *wg, *wu, *wd, *final_norm;
    float* out; unsigned char* ws;
};

__device__ __forceinline__ int otid() { int t = threadIdx.x; asm volatile("" : "+v"(t)); return t; }
__device__ __forceinline__ int obid() { int b = blockIdx.x; asm volatile("" : "+s"(b)); return b; }
__device__ __forceinline__ bf16_t f2bf(float f) { unsigned u = __float_as_uint(f); u += 0x7fffu + ((u >> 16) & 1u); return (bf16_t)(u >> 16); }
__device__ __forceinline__ float bf2f(bf16_t h) { return __uint_as_float(((unsigned)h) << 16); }
__device__ __forceinline__ float bflo(unsigned u) { return __uint_as_float(u << 16); }
__device__ __forceinline__ float bfhi(unsigned u) { return __uint_as_float(u & 0xffff0000u); }
__device__ __forceinline__ unsigned pack2(float a, float b) { return (unsigned)f2bf(a) | ((unsigned)f2bf(b) << 16); }
__device__ __forceinline__ float wsum(float v) { for (int o = 32; o > 0; o >>= 1) v += __shfl_xor(v, o); return v; }
__device__ __forceinline__ float wmax(float v) { for (int o = 32; o > 0; o >>= 1) v = fmaxf(v, __shfl_xor(v, o)); return v; }
__device__ __forceinline__ float silu(float v) { return v / (1.f + __expf(-v)); }

__device__ void sincos_big(double a, double& s, double& c) {
    const double twopi = 6.283185307179586476925286766559;
    double k = rint(a / twopi); double r = a - k * twopi;
    double x2 = r * r, ts = r, tc = 1.0; s = r; c = 1.0;
#pragma unroll 1
    for (int n = 1; n <= 16; ++n) { tc *= -x2 / (double)((2 * n - 1) * (2 * n)); c += tc; ts *= -x2 / (double)((2 * n) * (2 * n + 1)); s += ts; }
}

struct Route { int* cnt; int *e0, *e1, *p0, *p1; float *w0, *w1; int* list; float* cwl; };
__device__ __forceinline__ Route get_route(const Params& p, int L) {
    Route r; r.cnt = (int*)(p.ws + OFF_CTRL) + L * 16;
    unsigned char* b = p.ws + OFF_ROUTE;
    r.e0 = (int*)b; r.e1 = r.e0 + T; r.p0 = r.e1 + T; r.p1 = r.p0 + T; r.w0 = (float*)(r.p1 + T); r.w1 = r.w0 + T; r.list = (int*)(b + 512 * 1024); r.cwl = (float*)(b + 1536 * 1024);
    return r;
}
__device__ __forceinline__ int expert_base(const int* cnt, int e) { int s = 0; for (int i = 0; i < e; ++i) s += (cnt[i] + 255) & ~255; return s; }

template <int MODE>
__device__ void norm_pass(const Params& p, int L, unsigned char* lds) {
    const int wave = otid() >> 6, lane = otid() & 63;
    LAS float* wr = (LAS float*)(LAS unsigned char*)lds;
    if (MODE == 1) {
        for (int i = otid(); i < 1024 * 5; i += 512) { const int k = i / 5, part = i % 5;
            float4 w = part == 0 ? *(const float4*)(p.rg_w + ((size_t)L * 1024 + k) * 4) : *(const float4*)(p.re_w + (((size_t)L * 4 + part - 1) * 1024 + k) * 4);
            const float g = p.ffn_norm[L * 1024 + k]; w.x *= g; w.y *= g; w.z *= g; w.w *= g;
            v4f w4 = {w.x, w.y, w.z, w.w}; *(LAS v4f*)(wr + k * 20 + part * 4) = w4; }
        __syncthreads();
    }
    bf16_t* XN = (bf16_t*)(p.ws + OFF_XN);
    const bf16_t* YG = (const bf16_t*)(p.ws + OFF_BIG + B_YG);
    Route R = get_route(p, L);
    for (int t = obid() * 8 + wave; t < T; t += gridDim.x * 8) {
        const float* src = (MODE == 0 ? p.x : p.out) + (size_t)t * 1024;
        float4 v[4];
#pragma unroll
        for (int j = 0; j < 4; ++j) v[j] = *(const float4*)(src + j * 256 + lane * 4);
        if (MODE >= 2) {
            const int r0 = expert_base(R.cnt, R.e0[t]) + R.p0[t], r1 = expert_base(R.cnt, R.e1[t]) + R.p1[t];
#pragma unroll
            for (int j = 0; j < 4; ++j) {
                uint2 a = *(const uint2*)(YG + (size_t)r0 * 1024 + j * 256 + lane * 4), b = *(const uint2*)(YG + (size_t)r1 * 1024 + j * 256 + lane * 4);
                v[j].x += bflo(a.x) + bflo(b.x); v[j].y += bfhi(a.x) + bfhi(b.x); v[j].z += bflo(a.y) + bflo(b.y); v[j].w += bfhi(a.y) + bfhi(b.y);
            }
        }
        float ss = 0.f;
#pragma unroll
        for (int j = 0; j < 4; ++j) ss += v[j].x * v[j].x + v[j].y * v[j].y + v[j].z * v[j].z + v[j].w * v[j].w;
        ss = wsum(ss);
        const float rstd = 1.0f / sqrtf(ss * (1.0f / 1024.0f) + 1e-6f);
        if (MODE == 2) {
#pragma unroll
            for (int j = 0; j < 4; ++j) *(float4*)(p.out + (size_t)t * 1024 + j * 256 + lane * 4) = v[j];
        }
        if (MODE == 3) {
#pragma unroll
            for (int j = 0; j < 4; ++j) { float4 g = *(const float4*)(p.final_norm + j * 256 + lane * 4);
                float4 o; o.x = v[j].x * rstd * g.x; o.y = v[j].y * rstd * g.y; o.z = v[j].z * rstd * g.z; o.w = v[j].w * rstd * g.w;
                *(float4*)(p.out + (size_t)t * 1024 + j * 256 + lane * 4) = o; }
        } else {
#pragma unroll
            for (int j = 0; j < 4; ++j) { uint2 o; o.x = pack2(v[j].x * rstd, v[j].y * rstd); o.y = pack2(v[j].z * rstd, v[j].w * rstd);
                *(uint2*)(XN + (size_t)t * 1024 + j * 256 + lane * 4) = o; }
        }
        if (MODE == 1) {
            float acc[20];
#pragma unroll
            for (int i = 0; i < 20; ++i) acc[i] = 0.f;
            const LAS float* wl = wr + lane * 80;
            const float tv[4][4] = {{v[0].x * rstd, v[0].y * rstd, v[0].z * rstd, v[0].w * rstd}, {v[1].x * rstd, v[1].y * rstd, v[1].z * rstd, v[1].w * rstd},
                                    {v[2].x * rstd, v[2].y * rstd, v[2].z * rstd, v[2].w * rstd}, {v[3].x * rstd, v[3].y * rstd, v[3].z * rstd, v[3].w * rstd}};
#pragma unroll
            for (int j = 0; j < 4; ++j) {
                asm volatile("" ::: "memory");
                const float tk[4] = {tv[j][0], tv[j][1], tv[j][2], tv[j][3]};
#pragma unroll
                for (int c = 0; c < 4; ++c) {
#pragma unroll
                    for (int q = 0; q < 5; ++q) { const v4f w = *(const LAS v4f*)(wl + j * 5120 + c * 20 + q * 4);
                        acc[q * 4 + 0] += tk[c] * w[0]; acc[q * 4 + 1] += tk[c] * w[1]; acc[q * 4 + 2] += tk[c] * w[2]; acc[q * 4 + 3] += tk[c] * w[3]; }
                }
            }
#pragma unroll
            for (int i = 0; i < 20; ++i) acc[i] = wsum(acc[i]);
            float lg[4];
#pragma unroll
            for (int g = 0; g < 4; ++g) lg[g] = acc[g] + p.rg_b[L * 4 + g];
            int gi = 0; float gm = lg[0];
#pragma unroll
            for (int g = 1; g < 4; ++g) if (lg[g] > gm) { gm = lg[g]; gi = g; }
            float den = 0.f;
#pragma unroll
            for (int g = 0; g < 4; ++g) den += expf(lg[g] - gm);
            const float gval = 1.0f / den;
            float el[4] = {0.f, 0.f, 0.f, 0.f};
#pragma unroll
            for (int g = 0; g < 4; ++g) if (g == gi) {
#pragma unroll
                for (int e = 0; e < 4; ++e) el[e] = acc[4 + g * 4 + e] + p.re_b[(L * 4 + g) * 4 + e]; }
            int i0 = 0; float v0 = el[0];
#pragma unroll
            for (int e = 1; e < 4; ++e) if (el[e] > v0) { v0 = el[e]; i0 = e; }
            int i1 = -1; float v1 = -INFINITY;
#pragma unroll
            for (int e = 0; e < 4; ++e) if (e != i0 && el[e] > v1) { v1 = el[e]; i1 = e; }
            const float ex = expf(v1 - v0); const float ew0 = 1.0f / (1.0f + ex), ew1 = ex / (1.0f + ex);
            if (lane == 0) {
                const int ea = gi * 4 + i0, eb = gi * 4 + i1;
                const int pa = atomicAdd(R.cnt + ea, 1), pb = atomicAdd(R.cnt + eb, 1);
                R.list[ea * T + pa] = t; R.list[eb * T + pb] = t; R.cwl[ea * T + pa] = gval * ew0; R.cwl[eb * T + pb] = gval * ew1;
                R.e0[t] = ea; R.e1[t] = eb; R.p0[t] = pa; R.p1[t] = pb; R.w0[t] = gval * ew0; R.w1[t] = gval * ew1;
            }
        }
    }
}

template <int NB, class AF, class BF, class EF>
__device__ __forceinline__ void gemm_tile_naive(int K, const AF& af, const BF& bf, const EF& ef, float* sm) {
    float (*As)[132] = (float (*)[132])sm;
    float (*Bs)[16][68] = (float (*)[16][68])(sm + 16 * 132);
    const int tid = otid(), ty = tid >> 4, tx = tid & 15;
    float acc[NB][4][4];
#pragma unroll
    for (int n = 0; n < NB; ++n)
#pragma unroll
        for (int i = 0; i < 4; ++i)
#pragma unroll
            for (int j = 0; j < 4; ++j) acc[n][i][j] = 0.f;
    const int ar = tid >> 2, ak = (tid & 3) * 4, bk = tid >> 5, bc = (tid & 31) * 2;
    for (int k0 = 0; k0 < K; k0 += 16) {
        const float4 a = af(ar, k0 + ak);
        float2 b[NB];
#pragma unroll
        for (int n = 0; n < NB; ++n) b[n] = bf(n, k0 + bk, bc);
        __syncthreads();
        As[ak + 0][ar] = a.x; As[ak + 1][ar] = a.y; As[ak + 2][ar] = a.z; As[ak + 3][ar] = a.w;
#pragma unroll
        for (int n = 0; n < NB; ++n) { Bs[n][bk][bc] = b[n].x; Bs[n][bk][bc + 1] = b[n].y; }
        __syncthreads();
#pragma unroll
        for (int kk = 0; kk < 16; ++kk) {
            const float4 av = *(const float4*)&As[kk][ty * 4];
            const float a4[4] = {av.x, av.y, av.z, av.w};
#pragma unroll
            for (int n = 0; n < NB; ++n) { const float4 bv = *(const float4*)&Bs[n][kk][tx * 4]; const float b4[4] = {bv.x, bv.y, bv.z, bv.w};
#pragma unroll
                for (int i = 0; i < 4; ++i)
#pragma unroll
                    for (int j = 0; j < 4; ++j) acc[n][i][j] += a4[i] * b4[j]; }
        }
    }
#pragma unroll
    for (int i = 0; i < 4; ++i)
#pragma unroll
        for (int j = 0; j < 4; ++j) ef(ty * 4 + i, tx * 4 + j, acc[0][i][j], NB == 2 ? acc[NB - 1][i][j] : 0.f);
}

__device__ __forceinline__ float4 ld_bf4(const bf16_t* p) { const uint2 u = *(const uint2*)p; return make_float4(bflo(u.x), bfhi(u.x), bflo(u.y), bfhi(u.y)); }

template <class EF>
__device__ void gemm_dense_naive(const bf16_t* A, int lda, int K, int N, const float* B0, int ldb0, const float* gain0, int nsplit, const float* B1, int ldb1, const float* gain1, const EF& ef, float* sm) {
    const int ntn = N / 64, ntm = T / 128;
    for (int tile = obid(); tile < ntn * ntm; tile += gridDim.x) {
        const int tm = tile / ntn, tn = tile % ntn, m0 = tm * 128, n0 = tn * 64;
        const float* B; int ldb; const float* gain; int nb0;
        if (n0 < nsplit) { B = B0; ldb = ldb0; gain = gain0; nb0 = n0; } else { B = B1; ldb = ldb1; gain = gain1; nb0 = n0 - nsplit; }
        auto af = [&](int r, int k) { return ld_bf4(A + (size_t)(m0 + r) * lda + k); };
        auto bf = [&](int, int k, int c) { float2 w = *(const float2*)(B + (size_t)k * ldb + nb0 + c); const float g = gain ? gain[k] : 1.f; w.x *= g; w.y *= g; return w; };
        auto e2 = [&](int r, int c, float v, float) { ef(m0 + r, n0 + c, v); };
        gemm_tile_naive<1>(K, af, bf, e2, sm);
    }
}

template <int STAGE>
__device__ void gemm_expert_naive(const Params& p, int L, float* sm) {
    Route R = get_route(p, L);
    const bf16_t* XN = (const bf16_t*)(p.ws + OFF_XN);
    bf16_t* HG = (bf16_t*)(p.ws + OFF_BIG + B_HG); bf16_t* YG = (bf16_t*)(p.ws + OFF_BIG + B_YG);
    const int ntn = STAGE == 1 ? 512 / 64 : 1024 / 64;
    int* tstart = (int*)(sm + 6000);
    __syncthreads();
    if (otid() == 0) { int s = 0; for (int e = 0; e < 16; ++e) { tstart[e] = s; s += ((R.cnt[e] + 127) >> 7) * ntn; } tstart[16] = s; }
    __syncthreads();
    for (int tile = obid(); tile < tstart[16]; tile += gridDim.x) {
        int e = 0;
#pragma unroll 1
        for (int i = 1; i < 16; ++i) if (tile >= tstart[i]) e = i;
        const int lt = tile - tstart[e], tm = lt / ntn, tn = lt % ntn, m0 = tm * 128, n0 = tn * 64, cnt = R.cnt[e], base = expert_base(R.cnt, e);
        const int* list = R.list + e * T;
        if (STAGE == 1) {
            const float* Wg = p.wg + ((size_t)(L * 16 + e)) * 1024 * 512; const float* Wu = p.wu + ((size_t)(L * 16 + e)) * 1024 * 512; const float* gain = p.ffn_norm + L * 1024;
            auto af = [&](int r, int k) { const int rr = m0 + r; if (rr >= cnt) return make_float4(0.f, 0.f, 0.f, 0.f); return ld_bf4(XN + (size_t)list[rr] * 1024 + k); };
            auto bf = [&](int n, int k, int c) { float2 w = *(const float2*)((n == 0 ? Wg : Wu) + (size_t)k * 512 + n0 + c); const float g = gain[k]; w.x *= g; w.y *= g; return w; };
            auto ef = [&](int r, int c, float g, float u) { const int rr = m0 + r; if (rr >= cnt) return; const int tok = list[rr]; const float cw = (R.e0[tok] == e) ? R.w0[tok] : R.w1[tok];
                HG[(size_t)(base + rr) * 512 + n0 + c] = f2bf(silu(g) * u * cw); };
            gemm_tile_naive<2>(1024, af, bf, ef, sm);
        } else {
            const float* Wd = p.wd + ((size_t)(L * 16 + e)) * 512 * 1024;
            auto af = [&](int r, int k) { const int rr = m0 + r; if (rr >= cnt) return make_float4(0.f, 0.f, 0.f, 0.f); return ld_bf4(HG + (size_t)(base + rr) * 512 + k); };
            auto bf = [&](int, int k, int c) { return *(const float2*)(Wd + (size_t)k * 1024 + n0 + c); };
            auto ef = [&](int r, int c, float v, float) { const int rr = m0 + r; if (rr >= cnt) return; YG[(size_t)(base + rr) * 1024 + n0 + c] = f2bf(v); };
            gemm_tile_naive<1>(512, af, bf, ef, sm);
        }
    }
}


namespace pg8 {
#define PG8_LAS __attribute__((address_space(3)))
typedef unsigned short bf16_t;
typedef short bf16x8 __attribute__((ext_vector_type(8)));
typedef float f32x4 __attribute__((ext_vector_type(4)));
typedef unsigned u32x4 __attribute__((ext_vector_type(4)));
constexpr int BM = 256, BK = 64, HALF = 128, HTB = HALF * BK * 2  , STAGE_BYTES = 8 * HTB, NXCD = 8, WGM = 8;

__host__ __device__ __forceinline__ int lds_byte(int r, int c) { const int st = (r >> 4) * 2 + (c >> 5), rr = r & 15, cc = c & 31, ob = rr * 64 + cc * 2; return st * 1024 + (ob ^ (((ob >> 9) & 1) << 5)); }
__host__ __device__ __forceinline__ void stage_rc(int b, int& R, int& C) { const int st = b / 1024, sb = b % 1024, swz = sb ^ (((sb >> 9) & 1) << 5); R = (st >> 1) * 16 + swz / 64; C = (st & 1) * 32 + (swz % 64) / 2; }
__host__ __device__ __forceinline__ int perm32(int rho) { const int n = rho >> 4, i = rho & 15; return 8 * (i >> 2) + 4 * n + (i & 3); }

struct Unit { int pm, pn; };
struct Gemm { const bf16_t* A; const bf16_t* Bt; int M, N, K; };

struct StaticOrder {
    int nM, nN, nwg, G, c;
    __host__ __device__ void init(int M, int N, int G_, int c_) { nM = M / BM; nN = N / BM; nwg = nM * nN; G = G_; c = c_; }
    __host__ __device__ bool next(int i, Unit& u) const {
        const long L = (long)i * G + c; if (L >= nwg) return false;
        int wgid = (int)L; { const int q = nwg / NXCD, r = nwg % NXCD, xcd = wgid % NXCD, off = wgid / NXCD; wgid = (xcd < r ? xcd * (q + 1) : r * (q + 1) + (xcd - r) * q) + off; }
        const int nig = WGM * nN, gid = wgid / nig, fm = gid * WGM, gsz = (nM - fm) < WGM ? (nM - fm) : WGM;
        u.pm = fm + ((wgid % nig) % gsz); u.pn = (wgid % nig) / gsz; return true;
    }
    __device__ __forceinline__ void a_ready(const Unit&) const {}
    __device__ __forceinline__ void done(const Unit&) const {}
};


__device__ __forceinline__ unsigned cvt_pk_bf16(float lo, float hi) { unsigned r; asm volatile("v_cvt_pk_bf16_f32 %0, %1, %2" : "=v"(r) : "v"(lo), "v"(hi)); return r; }
__device__ __forceinline__ u32x4 pk8(const f32x4& a, const f32x4& b) { u32x4 w; w.x = cvt_pk_bf16(a[0], a[1]); w.y = cvt_pk_bf16(a[2], a[3]); w.z = cvt_pk_bf16(b[0], b[1]); w.w = cvt_pk_bf16(b[2], b[3]); return w; }
typedef unsigned u32x2 __attribute__((ext_vector_type(2)));
__device__ __forceinline__ u32x2 pk4(const f32x4& a) { u32x2 w; w.x = cvt_pk_bf16(a[0], a[1]); w.y = cvt_pk_bf16(a[2], a[3]); return w; }
__device__ __forceinline__ float fsilu(float v) { return v * __builtin_amdgcn_rcpf(1.f + __expf(-v)); }

struct EpiInproj {
    static constexpr bool PERM = true, AFTER_DRAIN = false;
    bf16_t* QK; const float* rc; const float* rs;
    __device__ __forceinline__ void operator()(const f32x4 (&acc)[2][2][4][2], const Unit& u, int wr, int wc, int fr, int fq) const {
        const int row0 = u.pm * BM + wr * 64 + fr;
        {
            const int f0 = wc * 32 + 8 * fq;
#pragma unroll
            for (int ai = 0; ai < 2; ++ai)
#pragma unroll
                for (int m = 0; m < 4; ++m) { const int r = row0 + ai * HALF + m * 16, pos = r & 8191;
                    const f32x4 c0 = *(const f32x4*)(rc + pos * 128 + f0), c1 = *(const f32x4*)(rc + pos * 128 + f0 + 4), s0 = *(const f32x4*)(rs + pos * 128 + f0), s1 = *(const f32x4*)(rs + pos * 128 + f0 + 4);
                    const f32x4 x1a = acc[ai][0][m][0], x1b = acc[ai][0][m][1], x2a = acc[ai][1][m][0], x2b = acc[ai][1][m][1];
                    bf16_t* p = QK + (size_t)r * 2048 + u.pn * 256 + f0;
                    *(u32x4*)p = pk8(x1a * c0 - x2a * s0, x1b * c1 - x2b * s1);
                    *(u32x4*)(p + 128) = pk8(x2a * c0 + x1a * s0, x2b * c1 + x1b * s1); }
        }
    }
};
struct EpiVt {
    static constexpr bool PERM = true, AFTER_DRAIN = false;
    bf16_t* Vt;
    __device__ __forceinline__ void operator()(const f32x4 (&acc)[2][2][4][2], const Unit& u, int wr, int wc, int fr, int fq) const {
        const int row0 = u.pm * BM + wr * 64 + fr;
#pragma unroll
        for (int ai = 0; ai < 2; ++ai)
#pragma unroll
            for (int m = 0; m < 4; ++m) { bf16_t* p = Vt + (size_t)(row0 + ai * HALF + m * 16) * 16384 + u.pn * BM + wc * 32 + 8 * fq;
#pragma unroll
                for (int bj = 0; bj < 2; ++bj) *(u32x4*)(p + bj * HALF) = pk8(acc[ai][bj][m][0], acc[ai][bj][m][1]); }
    }
};
struct EpiG {
    static constexpr bool PERM = true, AFTER_DRAIN = false;
    bf16_t* O;
    __device__ __forceinline__ void operator()(const f32x4 (&acc)[2][2][4][2], const Unit& u, int wr, int wc, int fr, int fq) const {
        const int row0 = u.pm * BM + wr * 64 + fr;
#pragma unroll
        for (int ai = 0; ai < 2; ++ai)
#pragma unroll
            for (int m = 0; m < 4; ++m) { const int r = row0 + ai * HALF + m * 16; bf16_t* p = O + (size_t)r * 2048 + u.pn * 256 + wc * 32 + 8 * fq;
#pragma unroll
                for (int bj = 0; bj < 2; ++bj) { const u32x4 o = *(const u32x4*)(p + bj * HALF); const f32x4 g0 = acc[ai][bj][m][0], g1 = acc[ai][bj][m][1];
                    f32x4 y0, y1; y0[0] = fsilu(g0[0]) * bflo(o.x); y0[1] = fsilu(g0[1]) * bfhi(o.x); y0[2] = fsilu(g0[2]) * bflo(o.y); y0[3] = fsilu(g0[3]) * bfhi(o.y);
                    y1[0] = fsilu(g1[0]) * bflo(o.z); y1[1] = fsilu(g1[1]) * bfhi(o.z); y1[2] = fsilu(g1[2]) * bflo(o.w); y1[3] = fsilu(g1[3]) * bfhi(o.w);
                    *(u32x4*)(p + bj * HALF) = pk8(y0, y1); } }
    }
};
struct EpiResid {
    static constexpr bool PERM = false, AFTER_DRAIN = false;
    const float* base; float* out;
    __device__ __forceinline__ void operator()(const f32x4 (&acc)[2][2][4][2], const Unit& u, int wr, int wc, int fr, int fq) const {
        const int row0 = u.pm * BM + wr * 64 + fr, col0 = u.pn * BM + wc * 32 + 4 * fq;
#pragma unroll
        for (int ai = 0; ai < 2; ++ai)
#pragma unroll
            for (int m = 0; m < 4; ++m) { const size_t off = (size_t)(row0 + ai * HALF + m * 16) * 1024 + col0;
#pragma unroll
                for (int bj = 0; bj < 2; ++bj)
#pragma unroll
                    for (int n = 0; n < 2; ++n) { const f32x4 b = *(const f32x4*)(base + off + bj * HALF + n * 16); *(f32x4*)(out + off + bj * HALF + n * 16) = b + acc[ai][bj][m][n]; } }
    }
};
struct EpiKVQ {
    static constexpr bool PERM = false, AFTER_DRAIN = false;
    bf16_t *K, *Vb, *Q; const float* pc; const float* ps;
    __device__ __forceinline__ void operator()(const f32x4 (&acc)[2][2][4][2], const Unit& u, int wr, int wc, int fr, int fq) const {
        const int which = u.pn >> 2; bf16_t* dst = K + (size_t)which * (16u << 20);
        const int row0 = u.pm * BM + wr * 64 + fr, col0 = (u.pn & 3) * BM + wc * 32 + 4 * fq;
        const bool rot = (which != 1) && (wc == 0);
#pragma unroll
        for (int ai = 0; ai < 2; ++ai)
#pragma unroll
            for (int m = 0; m < 4; ++m) { const int r = row0 + ai * HALF + m * 16, pos = r & 8191;
                f32x4 c = {1.f, 1.f, 1.f, 1.f}, s = {0.f, 0.f, 0.f, 0.f};
                if (rot) { c = *(const f32x4*)(pc + pos * 16 + 4 * fq); s = *(const f32x4*)(ps + pos * 16 + 4 * fq); }
#pragma unroll
                for (int bj = 0; bj < 2; ++bj) { f32x4 v0 = acc[ai][bj][m][0], v1 = acc[ai][bj][m][1];
                    if (rot) { const f32x4 y0 = v0 * c - v1 * s, y1 = v1 * c + v0 * s; v0 = y0; v1 = y1; }
                    bf16_t* p = dst + (size_t)r * 1024 + col0 + bj * HALF;
                    *(u32x2*)p = pk4(v0); *(u32x2*)(p + 16) = pk4(v1); } }
    }
};
template <class Epi, class Sched, bool ALIGN_EPI = false, bool SP2 = false>
__device__ __forceinline__ void gemm_phase(PG8_LAS unsigned char* lds, const Gemm g, const Sched& S, const Epi& E) {
    const int tid = otid(), wid = __builtin_amdgcn_readfirstlane(tid >> 6), lane = tid & 63, wr = wid >> 2, wc = wid & 3, fr = lane & 15, fq = lane >> 4;
    const int K = g.K, nt = K / BK;
    unsigned voffA[2], voffB[2];
#pragma unroll
    for (int i = 0; i < 2; ++i) { int R, C; stage_rc(tid * 16 + i * 8192, R, C); const int Rb = Epi::PERM ? ((R & ~31) + perm32(R & 31)) : R;
        voffA[i] = (unsigned)(R * K + C) * 2u; voffB[i] = (unsigned)(Rb * K + C) * 2u; }
    const size_t kstep = (size_t)(BK * 2);
    const size_t hstep = (size_t)HALF * K * 2;
    const size_t tstep = 2 * hstep;
    const unsigned ldsw = (unsigned)wid * 1024u;
    const int aoff = lds_byte(wr * 64 + fr, fq * 8), boff = lds_byte(wc * 32 + fr, fq * 8);
#define PG8_SA(b, h) (((b) * 2 + (h)) * HTB)
#define PG8_SB(b, h) ((4 + (b) * 2 + (h)) * HTB)
#define PG8_STAGE(bufoff, gbase, voff) do { _Pragma("unroll") for (int _i = 0; _i < 2; ++_i) \
        __builtin_amdgcn_global_load_lds((const unsigned*)((const char*)(gbase) + (voff)[_i]), (PG8_LAS unsigned*)(lds + (bufoff) + ldsw + _i * 8192), 16, 0, 0); } while (0)
#define PG8_LDA(dst, b, h) do { _Pragma("unroll") for (int m = 0; m < 4; ++m) _Pragma("unroll") for (int k = 0; k < 2; ++k) dst[m][k] = *(const PG8_LAS bf16x8*)(lds + PG8_SA(b, h) + aoff + m * 2048 + k * 1024); } while (0)
#define PG8_LDB(dst, b, h) do { _Pragma("unroll") for (int n = 0; n < 2; ++n) _Pragma("unroll") for (int k = 0; k < 2; ++k) dst[n][k] = *(const PG8_LAS bf16x8*)(lds + PG8_SB(b, h) + boff + n * 2048 + k * 1024); } while (0)
#define PG8_MMA(ai, bj, At, Bt) do { __builtin_amdgcn_s_setprio(1); _Pragma("unroll") for (int m = 0; m < 4; ++m) _Pragma("unroll") for (int n = 0; n < 2; ++n) _Pragma("unroll") for (int k = 0; k < 2; ++k) \
        acc[ai][bj][m][n] = __builtin_amdgcn_mfma_f32_16x16x32_bf16(Bt[n][k], At[m][k], acc[ai][bj][m][n], 0, 0, 0); __builtin_amdgcn_s_setprio(0); } while (0)
#define PG8_WAIT_V(n) asm volatile("s_waitcnt vmcnt(" #n ")" ::: "memory")
#define PG8_WAIT_L(n) asm volatile("s_waitcnt lgkmcnt(" #n ")" ::: "memory")
#define PG8_BAR __builtin_amdgcn_s_barrier()
#define PG8_SCHED __builtin_amdgcn_sched_barrier(0)
    Unit cur, nxt; int ui = 0;
    if (!S.next(0, cur)) return;
    f32x4 acc[2][2][4][2];
#pragma unroll
    for (int a = 0; a < 2; ++a)
#pragma unroll
        for (int b = 0; b < 2; ++b)
#pragma unroll
            for (int m = 0; m < 4; ++m)
#pragma unroll
                for (int n = 0; n < 2; ++n) acc[a][b][m][n] = (f32x4){0.f, 0.f, 0.f, 0.f};
    bf16x8 At[4][2], B0[2][2], B1[2][2];
    const char* cA = (const char*)g.A + (size_t)cur.pm * tstep; const char* cB = (const char*)g.Bt + (size_t)cur.pn * tstep;
    S.a_ready(cur);
    if constexpr (SP2) {
        PG8_STAGE(PG8_SB(0, 0), cB, voffB); PG8_STAGE(PG8_SB(0, 1), cB + hstep, voffB); PG8_STAGE(PG8_SA(0, 0), cA, voffA); PG8_STAGE(PG8_SA(0, 1), cA + hstep, voffA);
        if (wr == 1) PG8_BAR;
        PG8_WAIT_V(2); PG8_BAR;
        PG8_STAGE(PG8_SB(1, 0), cB + kstep, voffB); PG8_STAGE(PG8_SA(1, 0), cA + kstep, voffA); PG8_STAGE(PG8_SB(1, 1), cB + hstep + kstep, voffB);
        PG8_WAIT_V(6); PG8_BAR;
    } else {
        PG8_STAGE(PG8_SB(0, 0), cB, voffB); PG8_STAGE(PG8_SA(0, 0), cA, voffA); PG8_STAGE(PG8_SB(0, 1), cB + hstep, voffB); PG8_STAGE(PG8_SA(0, 1), cA + hstep, voffA);
        if (wr == 1) PG8_BAR;
        PG8_WAIT_V(4); PG8_BAR;
        PG8_STAGE(PG8_SB(1, 0), cB + kstep, voffB); PG8_STAGE(PG8_SA(1, 0), cA + kstep, voffA); PG8_STAGE(PG8_SB(1, 1), cB + hstep + kstep, voffB);
        PG8_WAIT_V(6); PG8_BAR;
    }
    for (;;) {
        const bool has_next = S.next(ui + 1, nxt);
        const char* nA = has_next ? (const char*)g.A + (size_t)nxt.pm * tstep : cA; const char* nB = has_next ? (const char*)g.Bt + (size_t)nxt.pn * tstep : cB;
        for (int t = 0; t < nt; t += 2) {
            const bool last = (t == nt - 2);
            const char* a1 = cA + (size_t)(t + 1) * kstep;
            const char* a2 = last ? nA : cA + (size_t)(t + 2) * kstep; const char* b2 = last ? nB : cB + (size_t)(t + 2) * kstep;
            const char* a3 = a2 + kstep; const char* b3 = b2 + kstep;
            if (last && has_next) S.a_ready(nxt);
            if constexpr (SP2) {
            PG8_LDB(B0, 0, 0); PG8_LDB(B1, 0, 1); PG8_SCHED; PG8_LDA(At, 0, 0); PG8_STAGE(PG8_SA(1, 1), a1 + hstep, voffA);
            PG8_WAIT_V(8); PG8_WAIT_L(0); PG8_BAR; PG8_MMA(0, 0, At, B0); PG8_MMA(0, 1, At, B1); PG8_BAR; PG8_SCHED;
            PG8_LDA(At, 0, 1); PG8_STAGE(PG8_SB(0, 0), b2, voffB); PG8_STAGE(PG8_SB(0, 1), b2 + hstep, voffB); PG8_STAGE(PG8_SA(0, 0), a2, voffA);
            PG8_WAIT_V(8); PG8_WAIT_L(0); PG8_BAR; PG8_MMA(1, 0, At, B0); PG8_MMA(1, 1, At, B1); PG8_BAR; PG8_SCHED;
            PG8_LDB(B0, 1, 0); PG8_LDB(B1, 1, 1); PG8_SCHED; PG8_LDA(At, 1, 0); PG8_STAGE(PG8_SA(0, 1), a2 + hstep, voffA);
            PG8_WAIT_V(8); PG8_WAIT_L(0); PG8_BAR; PG8_MMA(0, 0, At, B0); PG8_MMA(0, 1, At, B1); PG8_BAR; PG8_SCHED;
            PG8_LDA(At, 1, 1); PG8_STAGE(PG8_SB(1, 0), b3, voffB); PG8_STAGE(PG8_SB(1, 1), b3 + hstep, voffB); PG8_STAGE(PG8_SA(1, 0), a3, voffA);
            PG8_WAIT_V(8); PG8_WAIT_L(0); PG8_BAR; PG8_MMA(1, 0, At, B0); PG8_MMA(1, 1, At, B1); PG8_BAR; PG8_SCHED;
            } else {
            PG8_LDB(B0, 0, 0); PG8_SCHED; PG8_LDA(At, 0, 0); PG8_STAGE(PG8_SA(1, 1), a1 + hstep, voffA);
            PG8_WAIT_L(8); PG8_BAR; PG8_WAIT_L(0); PG8_MMA(0, 0, At, B0); PG8_BAR; PG8_SCHED;
            PG8_LDB(B1, 0, 1); PG8_STAGE(PG8_SB(0, 0), b2, voffB);
            PG8_BAR; PG8_WAIT_L(0); PG8_MMA(0, 1, At, B1); PG8_BAR;
            PG8_LDA(At, 0, 1); PG8_STAGE(PG8_SA(0, 0), a2, voffA);
            PG8_BAR; PG8_WAIT_L(0); PG8_MMA(1, 0, At, B0); PG8_BAR; PG8_SCHED;
            PG8_STAGE(PG8_SB(0, 1), b2 + hstep, voffB);
            PG8_WAIT_V(6); PG8_BAR; PG8_MMA(1, 1, At, B1); PG8_BAR;
            PG8_LDB(B0, 1, 0); PG8_SCHED; PG8_LDA(At, 1, 0); PG8_STAGE(PG8_SA(0, 1), a2 + hstep, voffA);
            PG8_WAIT_L(8); PG8_BAR; PG8_WAIT_L(0); PG8_MMA(0, 0, At, B0); PG8_BAR; PG8_SCHED;
            PG8_LDB(B1, 1, 1); PG8_STAGE(PG8_SB(1, 0), b3, voffB);
            PG8_BAR; PG8_WAIT_L(0); PG8_MMA(0, 1, At, B1); PG8_BAR;
            PG8_LDA(At, 1, 1); PG8_STAGE(PG8_SA(1, 0), a3, voffA);
            PG8_BAR; PG8_WAIT_L(0); PG8_MMA(1, 0, At, B0); PG8_BAR; PG8_SCHED;
            PG8_STAGE(PG8_SB(1, 1), b3 + hstep, voffB);
            PG8_WAIT_V(6); PG8_BAR; PG8_MMA(1, 1, At, B1); PG8_BAR;
            }
        }
        if constexpr (ALIGN_EPI) { if (wr == 0) PG8_BAR; }
        if constexpr (!Epi::AFTER_DRAIN) { E(acc, cur, wr, wc, fr, fq); S.done(cur); }
        if (!has_next) break;
#pragma unroll
        for (int a = 0; a < 2; ++a)
#pragma unroll
            for (int b = 0; b < 2; ++b)
#pragma unroll
                for (int m = 0; m < 4; ++m)
#pragma unroll
                    for (int n = 0; n < 2; ++n) acc[a][b][m][n] = (f32x4){0.f, 0.f, 0.f, 0.f};
        cur = nxt; cA = nA; cB = nB; ++ui;
        if constexpr (ALIGN_EPI) { if (wr == 1) PG8_BAR; }
    }
    PG8_WAIT_V(0);
    if constexpr (!ALIGN_EPI) { if (wr == 0) PG8_BAR; }
    PG8_BAR;
    if constexpr (Epi::AFTER_DRAIN) { E.fused(acc, cur, wr, wc, fr, fq, lds, wid, lane); S.done(cur); }
#undef PG8_SA
#undef PG8_SB
#undef PG8_STAGE
#undef PG8_LDA
#undef PG8_LDB
#undef PG8_MMA
#undef PG8_WAIT_V
#undef PG8_WAIT_L
#undef PG8_BAR
#undef PG8_SCHED
}

struct GUnit { int pm, pn, e, row0; };
template <int STAGE> struct GroupedOrder {
    typedef GUnit UnitT;
    const PG8_LAS int* tab; int G, c; const int* list; const char* Bt;
    __device__ __forceinline__ bool next(int i, GUnit& u) const {
        const int L = i * G + c; if (L >= tab[16]) return false;
        int e = 0;
#pragma unroll
        for (int j = 1; j < 16; ++j) e = (L >= tab[j]) ? j : e;
        const int lt = L - tab[e]; u.e = e; u.pm = lt >> 2; u.pn = lt & 3; u.row0 = tab[48 + e] + u.pm * 256; return true;
    }
    __device__ __forceinline__ unsigned rowoff(const GUnit& u, int r) const {
        if (STAGE == 1) { const int idx = u.pm * 256 + r; const int tok = idx < tab[32 + u.e] ? list[u.e * T + idx] : 0; return (unsigned)tok * 2048u; }
        return (unsigned)(u.row0 + r) * 1024u;
    }
    __device__ __forceinline__ const char* bbase(const GUnit& u) const { return Bt + (size_t)u.e * (3u << 20) + (size_t)u.pn * (STAGE == 1 ? 256 * 1024 * 2 : 256 * 512 * 2); }
    __device__ __forceinline__ void a_ready(const GUnit&) const {}
    __device__ __forceinline__ void done(const GUnit&) const {}
};
struct EpiExp1 {
    static constexpr bool PERM = true, AFTER_DRAIN = false;
    bf16_t* HG; const float* cwl; const PG8_LAS int* tab;
    __device__ __forceinline__ void operator()(const f32x4 (&acc)[2][2][4][2], const GUnit& u, int wr, int wc, int fr, int fq) const {
        const int cnt = tab[32 + u.e];
#pragma unroll
        for (int ai = 0; ai < 2; ++ai)
#pragma unroll
            for (int m = 0; m < 4; ++m) { const int rl = wr * 64 + fr + ai * HALF + m * 16, idx = u.pm * 256 + rl;
                const float cw = idx < cnt ? cwl[u.e * T + idx] : 0.f;
                const f32x4 g0 = acc[ai][0][m][0], g1 = acc[ai][0][m][1], u0 = acc[ai][1][m][0], u1 = acc[ai][1][m][1];
                f32x4 h0, h1;
#pragma unroll
                for (int j = 0; j < 4; ++j) { h0[j] = fsilu(g0[j]) * u0[j] * cw; h1[j] = fsilu(g1[j]) * u1[j] * cw; }
                *(u32x4*)(HG + (size_t)(u.row0 + rl) * 512 + u.pn * 128 + wc * 32 + 8 * fq) = pk8(h0, h1); }
    }
};
struct EpiExp2 {
    static constexpr bool PERM = true, AFTER_DRAIN = false;
    bf16_t* YG;
    __device__ __forceinline__ void operator()(const f32x4 (&acc)[2][2][4][2], const GUnit& u, int wr, int wc, int fr, int fq) const {
#pragma unroll
        for (int ai = 0; ai < 2; ++ai)
#pragma unroll
            for (int m = 0; m < 4; ++m) { const int rl = wr * 64 + fr + ai * HALF + m * 16; bf16_t* p = YG + (size_t)(u.row0 + rl) * 1024 + u.pn * 256 + wc * 32 + 8 * fq;
#pragma unroll
                for (int bj = 0; bj < 2; ++bj) *(u32x4*)(p + bj * HALF) = pk8(acc[ai][bj][m][0], acc[ai][bj][m][1]); }
    }
};
template <class Epi, class Sched, bool ALIGN_EPI = false>
__device__ __forceinline__ void gemm_phase_g(PG8_LAS unsigned char* lds, const char* Abase, const int K, const Sched& S, const Epi& E) {
    constexpr bool SP2 = true;
    const int tid = otid(), wid = __builtin_amdgcn_readfirstlane(tid >> 6), lane = tid & 63, wr = wid >> 2, wc = wid & 3, fr = lane & 15, fq = lane >> 4;
    const int nt = K / BK;
    unsigned voffB[2]; int RA[2], CA2[2];
#pragma unroll
    for (int i = 0; i < 2; ++i) { int R, C; stage_rc(tid * 16 + i * 8192, R, C); const int Rb = Epi::PERM ? ((R & ~31) + perm32(R & 31)) : R;
        RA[i] = R; CA2[i] = C * 2; voffB[i] = (unsigned)(Rb * K + C) * 2u; }
    const size_t kstep = (size_t)(BK * 2);
    const size_t hstep = (size_t)HALF * K * 2;
    const size_t tstep = 2 * hstep;
    const unsigned ldsw = (unsigned)wid * 1024u;
    const int aoff = lds_byte(wr * 64 + fr, fq * 8), boff = lds_byte(wc * 32 + fr, fq * 8);
#define PG8_SA(b, h) (((b) * 2 + (h)) * HTB)
#define PG8_SB(b, h) ((4 + (b) * 2 + (h)) * HTB)
#define PG8_STAGE_A(bufoff, h, kb, nx) do { _Pragma("unroll") for (int _i = 0; _i < 2; ++_i) \
        __builtin_amdgcn_global_load_lds((const unsigned*)(Abase + ((nx) ? vAn[h][_i] : vAc[h][_i]) + (kb)), (PG8_LAS unsigned*)(lds + (bufoff) + ldsw + _i * 8192), 16, 0, 0); } while (0)
#define PG8_STAGE(bufoff, gbase, voff) do { _Pragma("unroll") for (int _i = 0; _i < 2; ++_i) \
        __builtin_amdgcn_global_load_lds((const unsigned*)((const char*)(gbase) + (voff)[_i]), (PG8_LAS unsigned*)(lds + (bufoff) + ldsw + _i * 8192), 16, 0, 0); } while (0)
#define PG8_LDA(dst, b, h) do { _Pragma("unroll") for (int m = 0; m < 4; ++m) _Pragma("unroll") for (int k = 0; k < 2; ++k) dst[m][k] = *(const PG8_LAS bf16x8*)(lds + PG8_SA(b, h) + aoff + m * 2048 + k * 1024); } while (0)
#define PG8_LDB(dst, b, h) do { _Pragma("unroll") for (int n = 0; n < 2; ++n) _Pragma("unroll") for (int k = 0; k < 2; ++k) dst[n][k] = *(const PG8_LAS bf16x8*)(lds + PG8_SB(b, h) + boff + n * 2048 + k * 1024); } while (0)
#define PG8_MMA(ai, bj, At, Bt) do { __builtin_amdgcn_s_setprio(1); _Pragma("unroll") for (int m = 0; m < 4; ++m) _Pragma("unroll") for (int n = 0; n < 2; ++n) _Pragma("unroll") for (int k = 0; k < 2; ++k) \
        acc[ai][bj][m][n] = __builtin_amdgcn_mfma_f32_16x16x32_bf16(Bt[n][k], At[m][k], acc[ai][bj][m][n], 0, 0, 0); __builtin_amdgcn_s_setprio(0); } while (0)
#define PG8_WAIT_V(n) asm volatile("s_waitcnt vmcnt(" #n ")" ::: "memory")
#define PG8_WAIT_L(n) asm volatile("s_waitcnt lgkmcnt(" #n ")" ::: "memory")
#define PG8_BAR __builtin_amdgcn_s_barrier()
#define PG8_SCHED __builtin_amdgcn_sched_barrier(0)
    typename Sched::UnitT cur, nxt; int ui = 0;
    if (!S.next(0, cur)) return;
    unsigned vAc[2][2], vAn[2][2];
#pragma unroll
    for (int h = 0; h < 2; ++h)
#pragma unroll
        for (int i = 0; i < 2; ++i) { vAc[h][i] = S.rowoff(cur, h * HALF + RA[i]) + (unsigned)CA2[i]; vAn[h][i] = vAc[h][i]; }
    f32x4 acc[2][2][4][2];
#pragma unroll
    for (int a = 0; a < 2; ++a)
#pragma unroll
        for (int b = 0; b < 2; ++b)
#pragma unroll
            for (int m = 0; m < 4; ++m)
#pragma unroll
                for (int n = 0; n < 2; ++n) acc[a][b][m][n] = (f32x4){0.f, 0.f, 0.f, 0.f};
    bf16x8 At[4][2], B0[2][2], B1[2][2];
    const char* cB = S.bbase(cur);
    S.a_ready(cur);
    if constexpr (SP2) {
        PG8_STAGE(PG8_SB(0, 0), cB, voffB); PG8_STAGE(PG8_SB(0, 1), cB + hstep, voffB); PG8_STAGE_A(PG8_SA(0, 0), 0, 0, false); PG8_STAGE_A(PG8_SA(0, 1), 1, 0, false);
        if (wr == 1) PG8_BAR;
        PG8_WAIT_V(2); PG8_BAR;
        PG8_STAGE(PG8_SB(1, 0), cB + kstep, voffB); PG8_STAGE_A(PG8_SA(1, 0), 0, (unsigned)kstep, false); PG8_STAGE(PG8_SB(1, 1), cB + hstep + kstep, voffB);
        PG8_WAIT_V(6); PG8_BAR;
    }
    for (;;) {
        const bool has_next = S.next(ui + 1, nxt);
        const char* nB = has_next ? S.bbase(nxt) : cB;
        if (has_next) {
#pragma unroll
            for (int h = 0; h < 2; ++h)
#pragma unroll
                for (int i = 0; i < 2; ++i) vAn[h][i] = S.rowoff(nxt, h * HALF + RA[i]) + (unsigned)CA2[i];
        }
        for (int t = 0; t < nt; t += 2) {
            const bool last = (t == nt - 2);
            const unsigned kb1 = (unsigned)(t + 1) * (unsigned)kstep;
            const unsigned kb2 = last ? 0u : (unsigned)(t + 2) * (unsigned)kstep; const char* b2 = last ? nB : cB + (size_t)(t + 2) * kstep;
            const unsigned kb3 = kb2 + (unsigned)kstep; const char* b3 = b2 + kstep;
            if (last && has_next) S.a_ready(nxt);
            if constexpr (SP2) {
            PG8_LDB(B0, 0, 0); PG8_LDB(B1, 0, 1); PG8_SCHED; PG8_LDA(At, 0, 0); PG8_STAGE_A(PG8_SA(1, 1), 1, kb1, false);
            PG8_WAIT_V(8); PG8_WAIT_L(0); PG8_BAR; PG8_MMA(0, 0, At, B0); PG8_MMA(0, 1, At, B1); PG8_BAR; PG8_SCHED;
            PG8_LDA(At, 0, 1); PG8_STAGE(PG8_SB(0, 0), b2, voffB); PG8_STAGE(PG8_SB(0, 1), b2 + hstep, voffB); PG8_STAGE_A(PG8_SA(0, 0), 0, kb2, last);
            PG8_WAIT_V(8); PG8_WAIT_L(0); PG8_BAR; PG8_MMA(1, 0, At, B0); PG8_MMA(1, 1, At, B1); PG8_BAR; PG8_SCHED;
            PG8_LDB(B0, 1, 0); PG8_LDB(B1, 1, 1); PG8_SCHED; PG8_LDA(At, 1, 0); PG8_STAGE_A(PG8_SA(0, 1), 1, kb2, last);
            PG8_WAIT_V(8); PG8_WAIT_L(0); PG8_BAR; PG8_MMA(0, 0, At, B0); PG8_MMA(0, 1, At, B1); PG8_BAR; PG8_SCHED;
            PG8_LDA(At, 1, 1); PG8_STAGE(PG8_SB(1, 0), b3, voffB); PG8_STAGE(PG8_SB(1, 1), b3 + hstep, voffB); PG8_STAGE_A(PG8_SA(1, 0), 0, kb3, last);
            PG8_WAIT_V(8); PG8_WAIT_L(0); PG8_BAR; PG8_MMA(1, 0, At, B0); PG8_MMA(1, 1, At, B1); PG8_BAR; PG8_SCHED;
            }
        }
        if constexpr (ALIGN_EPI) { if (wr == 0) PG8_BAR; }
        if constexpr (!Epi::AFTER_DRAIN) { E(acc, cur, wr, wc, fr, fq); S.done(cur); }
        if (!has_next) break;
#pragma unroll
        for (int a = 0; a < 2; ++a)
#pragma unroll
            for (int b = 0; b < 2; ++b)
#pragma unroll
                for (int m = 0; m < 4; ++m)
#pragma unroll
                    for (int n = 0; n < 2; ++n) acc[a][b][m][n] = (f32x4){0.f, 0.f, 0.f, 0.f};
        cur = nxt; cB = nB; ++ui;
#pragma unroll
        for (int h = 0; h < 2; ++h)
#pragma unroll
            for (int i = 0; i < 2; ++i) vAc[h][i] = vAn[h][i];
        if constexpr (ALIGN_EPI) { if (wr == 1) PG8_BAR; }
    }
    PG8_WAIT_V(0);
    if constexpr (!ALIGN_EPI) { if (wr == 0) PG8_BAR; }
    PG8_BAR;
    if constexpr (Epi::AFTER_DRAIN) { E.fused(acc, cur, wr, wc, fr, fq, lds, wid, lane); S.done(cur); }
#undef PG8_SA
#undef PG8_SB
#undef PG8_STAGE
#undef PG8_STAGE_A
#undef PG8_LDA
#undef PG8_LDB
#undef PG8_MMA
#undef PG8_WAIT_V
#undef PG8_WAIT_L
#undef PG8_BAR
#undef PG8_SCHED
}
}


__device__ __forceinline__ void tr_item(const float* W, int ldw, int k0, int n0, bf16_t* WT, int K, int drow0, const float* gain, float scale, LAS float* scr, int lane) {
#pragma unroll 8
    for (int i = 0; i < 32; ++i) { const int kk = 2 * i + (lane >> 5); const float g = gain ? gain[k0 + kk] * scale : scale;
        scr[kk * 33 + (lane & 31)] = W[(size_t)(k0 + kk) * ldw + n0 + (lane & 31)] * g; }
    asm volatile("s_waitcnt lgkmcnt(0)" ::: "memory");
    const int c = lane & 7;
#pragma unroll
    for (int j = 0; j < 4; ++j) { const int n = (lane >> 3) + 8 * j; const LAS float* s = scr + (8 * c) * 33 + n;
        uint4 o; o.x = pack2(s[0 * 33], s[1 * 33]); o.y = pack2(s[2 * 33], s[3 * 33]); o.z = pack2(s[4 * 33], s[5 * 33]); o.w = pack2(s[6 * 33], s[7 * 33]);
        *(uint4*)(WT + (size_t)(drow0 + n) * K + k0 + 8 * c) = o; }
    asm volatile("s_waitcnt lgkmcnt(0)" ::: "memory");
}
__device__ __forceinline__ void tr_job(int it, const float* W, int ldw, int K, int N, bf16_t* WT, int drow_base, const float* gain, float scale, LAS float* scr, int lane) {
    const int nblk = N / 32, kb = it / nblk, nb = it % nblk;
    tr_item(W, ldw, kb * 64, nb * 32, WT, K, drow_base + nb * 32, gain, scale, scr, lane);
}
__device__ void convert_dense_weights(const Params& p, unsigned char* lds) {
    const int wave = otid() >> 6, lane = otid() & 63;
    LAS float* scr = (LAS float*)(LAS unsigned char*)lds + wave * 2176;
    bf16_t* WB = (bf16_t*)(p.ws + OFF_WB);
    bf16_t* Win = WB + W_IN / 2; bf16_t* Wout = WB + W_OUT / 2; bf16_t* Wkvq = WB + W_KVQ / 2; bf16_t* Wo = WB + W_O / 2;
    constexpr int I0 = 16 * 192, I1 = 32 * 32, I2 = 16 * 64, I3 = 16 * 32, I4 = 16 * 32, NIT = I0 + I1 + I2 + I3 + I4;
    for (int it = obid() * 8 + wave; it < NIT; it += gridDim.x * 8) {
        int r = it;
        if (r < I0) { const int nb = r % 192; const float sc = (nb >= 32 && nb < 64) ? 0.0625f : 1.f;
            tr_job(r, p.ret_w_in, 6144, 1024, 6144, Win, 0, p.ret_norm, sc, scr, lane); continue; } r -= I0;
        if (r < I1) { tr_job(r, p.ret_w_out, 1024, 2048, 1024, Wout, 0, nullptr, 1.f, scr, lane); continue; } r -= I1;
        if (r < I2) { tr_job(r, p.w_kv, 2048, 1024, 2048, Wkvq, 0, p.kv_norm, 1.f, scr, lane); continue; } r -= I2;
        if (r < I3) { tr_job(r, p.w_q, 1024, 1024, 1024, Wkvq, 2048, p.attn_norm, 0.08838834764831845f, scr, lane); continue; } r -= I3;
        tr_job(r, p.w_o, 1024, 1024, 1024, Wo, 0, nullptr, 1.f, scr, lane);
    }
}
__device__ void convert_expert_weights(const Params& p, int L, unsigned char* lds) {
    const int wave = otid() >> 6, lane = otid() & 63;
    LAS float* scr = (LAS float*)(LAS unsigned char*)lds + wave * 2176;
    bf16_t* E = (bf16_t*)(p.ws + OFF_BIG + B_E);
    const float* gain = p.ffn_norm + L * 1024;
    for (int it = obid() * 8 + wave; it < 16 * 768; it += gridDim.x * 8) {
        const int e = it / 768; int r = it % 768;
        bf16_t* W1 = E + (size_t)e * 3 * 512 * 1024; bf16_t* W2 = W1 + 1024 * 1024;
        if (r < 512) { const int up = r >= 256; r &= 255; const int kb = r / 16, nb = r % 16, f0 = nb * 32;
            const float* W = (up ? p.wu : p.wg) + (size_t)(L * 16 + e) * 1024 * 512;
            tr_item(W, 512, kb * 64, f0, W1, 1024, (f0 >> 7) * 256 + up * 128 + (f0 & 127), gain, 1.f, scr, lane);
        } else { r -= 512; tr_job(r, p.wd + (size_t)(L * 16 + e) * 512 * 1024, 1024, 512, 1024, W2, 0, nullptr, 1.f, scr, lane); }
    }
}

__device__ void phase_prologue(const Params& p, unsigned char* lds) {
    const int gtid = obid() * 512 + otid(), gsz = gridDim.x * 512;
    int* cnt = (int*)(p.ws + OFF_CTRL);
    if (gtid < 64 + 512) cnt[gtid] = 0;
    float* rc = (float*)(p.ws + OFF_TABRET); float* rs = rc + 8192 * 128;
    for (int i = gtid; i < 8192 * 128; i += gsz) { const int pos = i >> 7, f = i & 127;
        const float inv = (float)exp(-9.2103403719761836 * ((double)f / 128.0));
        const float ang = (float)pos * inv; double s, c; sincos_big((double)ang, s, c); rc[i] = (float)c; rs[i] = (float)s; }
    float* pc = (float*)(p.ws + OFF_TABROPE); float* ps = pc + 8192 * 16;
    for (int i = gtid; i < 8192 * 16; i += gsz) { const int pos = i >> 4, f = i & 15;
        const float inv = (float)exp(-13.122363377404328 * ((double)f / 16.0));
        const float ang = (float)pos * inv; double s, c; sincos_big((double)ang, s, c); pc[i] = (float)c; ps[i] = (float)s; }
    convert_dense_weights(p, lds);
    norm_pass<0>(p, 0, lds);
}

__device__ void phase_ret_rotary(const Params& p) {
    bf16_t* QK = (bf16_t*)(p.ws + OFF_BIG + B_QK);
    const float* rc = (const float*)(p.ws + OFF_TABRET); const float* rs = rc + 8192 * 128;
    const size_t total = (size_t)T * 8 * 128;
    for (size_t i = (size_t)obid() * 512 + otid(); i < total; i += (size_t)gridDim.x * 512) {
        const int f = (int)(i & 127), slot = (int)((i >> 7) & 7), t = (int)(i >> 10), pos = t & 8191;
        bf16_t* px = QK + (size_t)t * 2048 + slot * 256 + f;
        const float x1 = bf2f(px[0]), x2 = bf2f(px[128]), c = rc[pos * 128 + f], s = rs[pos * 128 + f];
        const float sc = slot >= 4 ? 0.0625f : 1.f;
        px[0] = f2bf((x1 * c - x2 * s) * sc); px[128] = f2bf((x2 * c + x1 * s) * sc);
    }
}

__device__ void phase_ret_scan(const Params& p) {
    const bf16_t* QK = (const bf16_t*)(p.ws + OFF_BIG + B_QK); const bf16_t* V = (const bf16_t*)(p.ws + OFF_BIG + B_V); bf16_t* O = (bf16_t*)(p.ws + OFF_BIG + B_O);
    const int wave = otid() >> 6, lane = otid() & 63;
    for (int item = obid() * 8 + wave; item < 2048; item += gridDim.x * 8) {
        const int b = item >> 10, h = (item >> 8) & 3, ep = item & 255;
        const float gamma = 1.f - exp2f(-5.f - (float)h);
        float S[4][2];
#pragma unroll
        for (int d = 0; d < 4; ++d) { S[d][0] = 0.f; S[d][1] = 0.f; }
        const bf16_t* qp = QK + (size_t)b * SEQ * 2048 + h * 256 + lane * 4;
        const bf16_t* kp = qp + 1024;
        const bf16_t* vp = V + (size_t)(h * 512 + ep * 2) * 16384 + (size_t)b * SEQ;
        bf16_t* op = O + (size_t)b * SEQ * 2048 + h * 512 + ep * 2;
#pragma unroll 4
        for (int t = 0; t < SEQ; ++t) {
            const uint2 qv = *(const uint2*)(qp + (size_t)t * 2048), kv = *(const uint2*)(kp + (size_t)t * 2048);
            const float q[4] = {bflo(qv.x), bfhi(qv.x), bflo(qv.y), bfhi(qv.y)}, k[4] = {bflo(kv.x), bfhi(kv.x), bflo(kv.y), bfhi(kv.y)};
            const float v0 = bf2f(vp[t]), v1 = bf2f(vp[16384 + t]);
            float p0 = 0.f, p1 = 0.f;
#pragma unroll
            for (int d = 0; d < 4; ++d) { S[d][0] = gamma * S[d][0] + k[d] * v0; S[d][1] = gamma * S[d][1] + k[d] * v1; p0 += q[d] * S[d][0]; p1 += q[d] * S[d][1]; }
            p0 = wsum(p0); p1 = wsum(p1);
            if (lane == 0) *(unsigned*)(op + (size_t)t * 2048) = pack2(p0, p1);
        }
    }
}

__device__ void phase_ret_gnorm(const Params& p) {
    bf16_t* O = (bf16_t*)(p.ws + OFF_BIG + B_O);
    const int wave = otid() >> 6, lane = otid() & 63;
    for (int item = obid() * 8 + wave; item < T * 4; item += gridDim.x * 8) {
        bf16_t* po = O + (size_t)item * 512 + lane * 8;
        const uint4 u = *(const uint4*)po;
        float v[8] = {bflo(u.x), bfhi(u.x), bflo(u.y), bfhi(u.y), bflo(u.z), bfhi(u.z), bflo(u.w), bfhi(u.w)};
        float ss = 0.f;
#pragma unroll
        for (int i = 0; i < 8; ++i) ss += v[i] * v[i];
        ss = wsum(ss);
        const float rstd = 1.0f / sqrtf(ss * (1.0f / 512.0f) + 1e-6f);
        uint4 o; o.x = pack2(v[0] * rstd, v[1] * rstd); o.y = pack2(v[2] * rstd, v[3] * rstd); o.z = pack2(v[4] * rstd, v[5] * rstd); o.w = pack2(v[6] * rstd, v[7] * rstd);
        *(uint4*)po = o;
    }
}

__device__ void phase_rope(const Params& p) {
    bf16_t* Kb = (bf16_t*)(p.ws + OFF_BIG + B_K); bf16_t* Qb = (bf16_t*)(p.ws + OFF_BIG + B_Q);
    const float* pc = (const float*)(p.ws + OFF_TABROPE); const float* ps = pc + 8192 * 16;
    const size_t total = (size_t)T * 2 * 8 * 16;
    for (size_t i = (size_t)obid() * 512 + otid(); i < total; i += (size_t)gridDim.x * 512) {
        const int f = (int)(i & 15), h = (int)((i >> 4) & 7), which = (int)((i >> 7) & 1), t = (int)(i >> 8), pos = t & 8191;
        bf16_t* px = (which ? Qb : Kb) + (size_t)t * 1024 + h * 128 + f;
        const float x1 = bf2f(px[0]), x2 = bf2f(px[16]), c = pc[pos * 16 + f], s = ps[pos * 16 + f];
        px[0] = f2bf(x1 * c - x2 * s); px[16] = f2bf(x2 * c + x1 * s);
    }
}
__device__ void phase_qscale(const Params& p) {
    bf16_t* Qb = (bf16_t*)(p.ws + OFF_BIG + B_Q);
    const size_t total = (size_t)T * 1024;
    const float sc = 0.08838834764831845f;
    for (size_t i = (size_t)obid() * 512 + otid(); i < total; i += (size_t)gridDim.x * 512) Qb[i] = f2bf(bf2f(Qb[i]) * sc);
}

__device__ void phase_kmean(const Params& p) {
    const bf16_t* Kb = (const bf16_t*)(p.ws + OFF_BIG + B_K); float* km = (float*)(p.ws + OFF_KMEAN);
    for (int i = obid() * 512 + otid(); i < 2 * 32 * 1024; i += gridDim.x * 512) {
        const int col = i & 1023, n = (i >> 10) & 31, b = i >> 15, h = col >> 7, d = col & 127;
        const bf16_t* pk = Kb + ((size_t)b * SEQ + n * 256) * 1024 + col;
        float s = 0.f;
        for (int j = 0; j < 256; ++j) s += bf2f(pk[(size_t)j * 1024]);
        km[(((size_t)b * 8 + h) * 32 + n) * 128 + d] = s * (1.0f / 256.0f);
    }
}

__device__ void phase_moba_naive(const Params& p, float* sm) {
    const bf16_t* Kb = (const bf16_t*)(p.ws + OFF_BIG + B_K); const bf16_t* Vb = (const bf16_t*)(p.ws + OFF_BIG + B_VB); const bf16_t* Qb = (const bf16_t*)(p.ws + OFF_BIG + B_Q);
    const float* kmean = (const float*)(p.ws + OFF_KMEAN); bf16_t* AO = (bf16_t*)(p.ws + OFF_BIG + B_AO);
    const int wave = otid() >> 6, lane = otid() & 63;
    float* qs = sm + wave * 128;
    for (int item = obid() * 8 + wave; item < T * 8; item += gridDim.x * 8) {
        const int tg = item >> 3, h = item & 7, b = tg >> 13, s = tg & 8191, blk = s >> 8;
        const unsigned qq = *(const unsigned*)(Qb + (size_t)tg * 1024 + h * 128 + lane * 2);
        qs[lane * 2] = bflo(qq); qs[lane * 2 + 1] = bfhi(qq);
        __builtin_amdgcn_wave_barrier();
        float g = -INFINITY;
        if (lane < blk) { const float* km = kmean + (((size_t)b * 8 + h) * 32 + lane) * 128; float a = 0.f; for (int d = 0; d < 128; ++d) a += qs[d] * km[d]; g = a; }
        const int nsel = blk < 3 ? blk : 3;
        int sel[3];
#pragma unroll
        for (int j = 0; j < 3; ++j) {
            sel[j] = 0;
            if (j < nsel) { const float m = wmax(g); const unsigned long long bal = __ballot(g == m); const int idx = __ffsll((long long)bal) - 1; sel[j] = idx; if (lane == idx) g = -INFINITY; }
        }
        float sc[4][4];
#pragma unroll
        for (int seg = 0; seg < 4; ++seg) {
            const int bid = seg < 3 ? sel[seg] : blk; const bool valid = seg < 3 ? (seg < nsel) : true; const int nkeys = seg < 3 ? 256 : (s - blk * 256 + 1);
#pragma unroll
            for (int kk = 0; kk < 4; ++kk) {
                const int key = kk * 64 + lane; float v = -INFINITY;
                if (valid && key < nkeys) {
                    const bf16_t* kr = Kb + ((size_t)b * SEQ + bid * 256 + key) * 1024 + h * 128; float a = 0.f;
#pragma unroll 4
                    for (int d8 = 0; d8 < 16; ++d8) { const uint4 u = *(const uint4*)(kr + d8 * 8); const float* q8 = qs + d8 * 8;
                        a += q8[0] * bflo(u.x) + q8[1] * bfhi(u.x) + q8[2] * bflo(u.y) + q8[3] * bfhi(u.y) + q8[4] * bflo(u.z) + q8[5] * bfhi(u.z) + q8[6] * bflo(u.w) + q8[7] * bfhi(u.w); }
                    v = a;
                }
                sc[seg][kk] = v;
            }
        }
        float m = -INFINITY;
#pragma unroll
        for (int seg = 0; seg < 4; ++seg)
#pragma unroll
            for (int kk = 0; kk < 4; ++kk) m = fmaxf(m, sc[seg][kk]);
        m = wmax(m);
        float l = 0.f;
#pragma unroll
        for (int seg = 0; seg < 4; ++seg)
#pragma unroll
            for (int kk = 0; kk < 4; ++kk) { const float e = expf(sc[seg][kk] - m); sc[seg][kk] = e; l += e; }
        l = wsum(l);
        float o0 = 0.f, o1 = 0.f;
#pragma unroll
        for (int seg = 0; seg < 4; ++seg) {
            const int bid = seg < 3 ? sel[seg] : blk; const bool valid = seg < 3 ? (seg < nsel) : true; const int nkeys = seg < 3 ? 256 : (s - blk * 256 + 1);
            if (valid) {
#pragma unroll
                for (int kk = 0; kk < 4; ++kk) {
                    if (kk * 64 < nkeys) {
                        const bf16_t* vr = Vb + ((size_t)b * SEQ + bid * 256 + kk * 64) * 1024 + h * 128 + lane * 2;
                        for (int src = 0; src < 64; ++src) { const float pp = __shfl(sc[seg][kk], src); const unsigned vv = *(const unsigned*)(vr + (size_t)src * 1024); o0 += pp * bflo(vv); o1 += pp * bfhi(vv); }
                    }
                }
            }
        }
        const float il = 1.0f / l;
        *(unsigned*)(AO + (size_t)tg * 1024 + h * 128 + lane * 2) = pack2(o0 * il, o1 * il);
        __builtin_amdgcn_wave_barrier();
    }
}

typedef short bf16x8_t __attribute__((ext_vector_type(8)));
typedef short s16x4_t __attribute__((ext_vector_type(4)));
constexpr int QCAP = 8192;
constexpr size_t X_QLIST = 0, X_ML = 16 * MiB;
constexpr int CT_QCNT = 64;

__device__ void phase_kmean2(const Params& p) {
    const bf16_t* Kb = (const bf16_t*)(p.ws + OFF_BIG + B_K); bf16_t* kh = (bf16_t*)(p.ws + OFF_KMEAN); bf16_t* kl = kh + 2 * 8 * 32 * 128;
    for (int i = obid() * 512 + otid(); i < 2 * 32 * 1024; i += gridDim.x * 512) {
        const int col = i & 1023, n = (i >> 10) & 31, b = i >> 15, h = col >> 7, d = col & 127;
        const bf16_t* pk = Kb + ((size_t)b * SEQ + n * 256) * 1024 + col;
        float s = 0.f;
#pragma unroll 8
        for (int j = 0; j < 256; ++j) s += bf2f(pk[(size_t)j * 1024]);
        s *= (1.0f / 256.0f);
        const bf16_t hi = f2bf(s); const size_t o = (((size_t)b * 8 + h) * 32 + n) * 128 + d;
        kh[o] = hi; kl[o] = f2bf(s - bf2f(hi));
    }
}

__device__ void phase_moba_gate(const Params& p, unsigned char* lds) {
    const int tid = otid(), wave = tid >> 6, lane = tid & 63, g = lane >> 4, i = lane & 15;
    LAS int* lcnt = (LAS int*)(LAS unsigned char*)lds; LAS int* lbase = lcnt + 32; LAS unsigned* lsel = (LAS unsigned*)(lcnt + 64);
    const bf16_t* Qb = (const bf16_t*)(p.ws + OFF_BIG + B_Q); const bf16_t* kh = (const bf16_t*)(p.ws + OFF_KMEAN); const bf16_t* kl = kh + 2 * 8 * 32 * 128;
    int* qcnt = (int*)(p.ws + OFF_CTRL) + CT_QCNT; unsigned* qlist = (unsigned*)(p.ws + OFF_XN + X_QLIST);
    for (int unit = obid(); unit < 256; unit += gridDim.x) {
        const int b = unit >> 7, h = (unit >> 4) & 7, s0 = (unit & 15) * 512;
        if (tid < 32) lcnt[tid] = 0;
        __syncthreads();
        bf16x8_t ah[2][4], al[2][4];
#pragma unroll
        for (int nt = 0; nt < 2; ++nt)
#pragma unroll
            for (int ks = 0; ks < 4; ++ks) { const size_t o = (((size_t)b * 8 + h) * 32 + nt * 16 + i) * 128 + ks * 32 + 8 * g; ah[nt][ks] = *(const bf16x8_t*)(kh + o); al[nt][ks] = *(const bf16x8_t*)(kl + o); }
#pragma unroll 1
        for (int it = 0; it < 4; ++it) {
            const int tl = wave * 64 + it * 16 + i, s = s0 + tl, tg = b * SEQ + s, blk = s >> 8;
            v4f acc[2] = {{0.f, 0.f, 0.f, 0.f}, {0.f, 0.f, 0.f, 0.f}};
#pragma unroll
            for (int ks = 0; ks < 4; ++ks) { const bf16x8_t bq = *(const bf16x8_t*)(Qb + (size_t)tg * 1024 + h * 128 + ks * 32 + 8 * g);
#pragma unroll
                for (int nt = 0; nt < 2; ++nt) { acc[nt] = __builtin_amdgcn_mfma_f32_16x16x32_bf16(ah[nt][ks], bq, acc[nt], 0, 0, 0); acc[nt] = __builtin_amdgcn_mfma_f32_16x16x32_bf16(al[nt][ks], bq, acc[nt], 0, 0, 0); } }
            float gv[8];
#pragma unroll
            for (int q = 0; q < 8; ++q) { const int n = (q >> 2) * 16 + 4 * g + (q & 3); gv[q] = n < blk ? acc[q >> 2][q & 3] : -INFINITY; }
            const int nsel = blk < 3 ? blk : 3;
#pragma unroll
            for (int j = 0; j < 3; ++j) {
                float bm = -INFINITY; int bn = 64;
#pragma unroll
                for (int q = 0; q < 8; ++q) { const int n = (q >> 2) * 16 + 4 * g + (q & 3); if (gv[q] > bm) { bm = gv[q]; bn = n; } }
#pragma unroll
                for (int off = 16; off <= 32; off <<= 1) { const float om = __shfl_xor(bm, off); const int on = __shfl_xor(bn, off); if (om > bm || (om == bm && on < bn)) { bm = om; bn = on; } }
#pragma unroll
                for (int q = 0; q < 8; ++q) { const int n = (q >> 2) * 16 + 4 * g + (q & 3); if (n == bn) gv[q] = -INFINITY; }
                if (g == 0 && j < nsel) { const int off = atomicAdd((int*)&lcnt[bn], 1); lsel[tl * 3 + j] = (unsigned)bn | ((unsigned)off << 8); }
            }
        }
        __syncthreads();
        if (tid < 32) { const int c = lcnt[tid]; lbase[tid] = c ? atomicAdd(qcnt + (b * 8 + h) * 32 + tid, c) : 0; }
        __syncthreads();
        { const int s = s0 + tid, blk = s >> 8, nsel = blk < 3 ? blk : 3;
            for (int j = 0; j < nsel; ++j) { const unsigned e = lsel[tid * 3 + j]; const int sel = e & 255, off = e >> 8;
                qlist[((size_t)(b * 8 + h) * 32 + sel) * QCAP + lbase[sel] + off] = (unsigned)(b * SEQ + s) | ((unsigned)j << 16); } }
        __syncthreads();
    }
}

__device__ __forceinline__ void moba_stage_kv(const bf16_t* Kb, const bf16_t* Vb, int b, int h, int n, LAS unsigned char* Ks, LAS unsigned char* Vs, int tid) {
    const size_t rowbase = ((size_t)b * SEQ + n * 256) * 1024 + h * 128;
#pragma unroll
    for (int it = 0; it < 8; ++it) { const int idx = it * 512 + tid, row = idx >> 4, ch = idx & 15;
        const v4u kv = *(const v4u*)(Kb + rowbase + (size_t)row * 1024 + ch * 8), vv = *(const v4u*)(Vb + rowbase + (size_t)row * 1024 + ch * 8);
        *(LAS v4u*)(Ks + row * 256 + ((ch ^ (row & 15)) << 4)) = kv; *(LAS v4u*)(Vs + row * 256 + ((ch ^ ((row & 7) << 1)) << 4)) = vv; }
}

__device__ __forceinline__ void moba_wave_attn(const bf16_t* qrow, LAS unsigned char* Ks, LAS unsigned char* Vs, int g, int i, bool own, int t_local, int nkt, v4f (&o)[8], float& m_out, float& l_out) {
    bf16x8_t bq[4];
#pragma unroll
    for (int ks = 0; ks < 4; ++ks) bq[ks] = *(const bf16x8_t*)(qrow + ks * 32 + 8 * g);
    v4f st[16];
#pragma unroll
    for (int kt = 0; kt < 16; ++kt) {
        st[kt] = (v4f){0.f, 0.f, 0.f, 0.f};
        if (kt < nkt) {
            const int row = kt * 16 + i;
#pragma unroll
            for (int ks = 0; ks < 4; ++ks) { const bf16x8_t a = *(const LAS bf16x8_t*)(Ks + row * 256 + (((ks * 4 + g) ^ (row & 15)) << 4)); st[kt] = __builtin_amdgcn_mfma_f32_16x16x32_bf16(a, bq[ks], st[kt], 0, 0, 0); }
        }
    }
    float m = -INFINITY;
#pragma unroll
    for (int kt = 0; kt < 16; ++kt)
#pragma unroll
        for (int r = 0; r < 4; ++r) { const int key = kt * 16 + 4 * g + r; const bool ok = (kt < nkt) && (!own || key <= t_local); st[kt][r] = ok ? st[kt][r] : -INFINITY; m = fmaxf(m, st[kt][r]); }
    m = fmaxf(m, __shfl_xor(m, 16)); m = fmaxf(m, __shfl_xor(m, 32));
    float l = 0.f;
#pragma unroll
    for (int kt = 0; kt < 16; ++kt)
#pragma unroll
        for (int r = 0; r < 4; ++r) { const float e = __expf(st[kt][r] - m); st[kt][r] = e; l += e; }
    l += __shfl_xor(l, 16); l += __shfl_xor(l, 32);
#pragma unroll
    for (int dt = 0; dt < 8; ++dt) o[dt] = (v4f){0.f, 0.f, 0.f, 0.f};
    const int q = i >> 2, pp = i & 3;
#pragma unroll
    for (int k2 = 0; k2 < 8; ++k2) {
        if (2 * k2 < nkt) {
            union { bf16x8_t v; unsigned u[4]; } pb;
            pb.u[0] = pg8::cvt_pk_bf16(st[2 * k2][0], st[2 * k2][1]); pb.u[1] = pg8::cvt_pk_bf16(st[2 * k2][2], st[2 * k2][3]);
            pb.u[2] = pg8::cvt_pk_bf16(st[2 * k2 + 1][0], st[2 * k2 + 1][1]); pb.u[3] = pg8::cvt_pk_bf16(st[2 * k2 + 1][2], st[2 * k2 + 1][3]);
            const int r0 = (2 * k2) * 16 + 4 * g + q, r1 = r0 + 16;
#pragma unroll
            for (int dt = 0; dt < 8; ++dt) {
                const int ch = dt * 2 + (pp >> 1);
                const s16x4_t a0 = __builtin_amdgcn_ds_read_tr16_b64_v4i16((LAS s16x4_t*)(Vs + r0 * 256 + ((ch ^ ((r0 & 7) << 1)) << 4) + (pp & 1) * 8));
                const s16x4_t a1 = __builtin_amdgcn_ds_read_tr16_b64_v4i16((LAS s16x4_t*)(Vs + r1 * 256 + ((ch ^ ((r1 & 7) << 1)) << 4) + (pp & 1) * 8));
                const bf16x8_t a = {a0[0], a0[1], a0[2], a0[3], a1[0], a1[1], a1[2], a1[3]};
                o[dt] = __builtin_amdgcn_mfma_f32_16x16x32_bf16(a, pb.v, o[dt], 0, 0, 0);
            }
        }
    }
    m_out = m; l_out = l;
}

__device__ void phase_moba_sel(const Params& p, unsigned char* lds) {
    const int tid = otid(), wave = __builtin_amdgcn_readfirstlane(tid >> 6), lane = tid & 63, g = lane >> 4, i = lane & 15;
    LAS unsigned char* Ks = (LAS unsigned char*)lds; LAS unsigned char* Vs = Ks + 65536; LAS int* pre = (LAS int*)(Ks + 131072);
    const bf16_t* Kb = (const bf16_t*)(p.ws + OFF_BIG + B_K); const bf16_t* Vb = (const bf16_t*)(p.ws + OFF_BIG + B_VB); const bf16_t* Qb = (const bf16_t*)(p.ws + OFF_BIG + B_Q);
    bf16_t* PART = (bf16_t*)(p.ws + OFF_BIG + B_PART); float* ML = (float*)(p.ws + OFF_XN + X_ML);
    const int* qcnt = (const int*)(p.ws + OFF_CTRL) + CT_QCNT; const unsigned* qlist = (const unsigned*)(p.ws + OFF_XN + X_QLIST);
    __syncthreads();
    pre[516 + tid] = qcnt[tid];
    __syncthreads();
    if (tid == 0) { int s = 0; for (int l = 0; l < 512; ++l) { pre[l] = s; s += (pre[516 + l] + 127) >> 7; } pre[512] = s; }
    __syncthreads();
    const int NT = pre[512], G = (int)gridDim.x, c = obid();
    const int t_begin = (int)(((long)NT * c) / G), t_end = (int)(((long)NT * (c + 1)) / G);
    int li = 0, cur = -1;
    for (int tile = t_begin; tile < t_end; ++tile) {
        while (tile >= pre[li + 1]) ++li;
        const int b = li >> 8, h = (li >> 5) & 7, n = li & 31;
        if (li != cur) { __syncthreads(); moba_stage_kv(Kb, Vb, b, h, n, Ks, Vs, tid); __syncthreads(); cur = li; }
        const int cnt = pre[516 + li], row = (tile - pre[li]) * 128 + wave * 16 + i; const bool valid = row < cnt;
        const unsigned e = qlist[(size_t)li * QCAP + (valid ? row : 0)]; const int tg = e & 0xffff, j = e >> 16;
        v4f o[8]; float m, l;
        moba_wave_attn(Qb + (size_t)tg * 1024 + h * 128, Ks, Vs, g, i, false, 0, 16, o, m, l);
        if (valid) {
            bf16_t* po = PART + ((size_t)(tg * 8 + h) * 3 + j) * 128 + 4 * g;
#pragma unroll
            for (int dt = 0; dt < 8; ++dt) *(uint2*)(po + dt * 16) = make_uint2(pg8::cvt_pk_bf16(o[dt][0], o[dt][1]), pg8::cvt_pk_bf16(o[dt][2], o[dt][3]));
            if (g == 0) *(float2*)(ML + ((size_t)(tg * 8 + h) * 3 + j) * 2) = make_float2(m, l);
        }
    }
}

__device__ void phase_moba_own(const Params& p, unsigned char* lds) {
    const int tid = otid(), wave = __builtin_amdgcn_readfirstlane(tid >> 6), lane = tid & 63, g = lane >> 4, i = lane & 15;
    LAS unsigned char* Ks = (LAS unsigned char*)lds; LAS unsigned char* Vs = Ks + 65536;
    const bf16_t* Kb = (const bf16_t*)(p.ws + OFF_BIG + B_K); const bf16_t* Vb = (const bf16_t*)(p.ws + OFF_BIG + B_VB); const bf16_t* Qb = (const bf16_t*)(p.ws + OFF_BIG + B_Q);
    const bf16_t* PART = (const bf16_t*)(p.ws + OFF_BIG + B_PART); const float* ML = (const float*)(p.ws + OFF_XN + X_ML); bf16_t* AO = (bf16_t*)(p.ws + OFF_BIG + B_AO);
    for (int unit = obid(); unit < 512; unit += gridDim.x) {
        const int b = unit >> 8, h = (unit >> 5) & 7, blk = unit & 31, nsel = blk < 3 ? blk : 3;
        __syncthreads(); moba_stage_kv(Kb, Vb, b, h, blk, Ks, Vs, tid); __syncthreads();
#pragma unroll 1
        for (int tile = 0; tile < 2; ++tile) {
            const int t_local = tile * 128 + wave * 16 + i, tg = b * SEQ + blk * 256 + t_local, nkt = tile * 8 + wave + 1;
            v4f o[8]; float m, l;
            moba_wave_attn(Qb + (size_t)tg * 1024 + h * 128, Ks, Vs, g, i, true, t_local, nkt, o, m, l);
            float mj[3], lj[3], M = m;
#pragma unroll
            for (int j = 0; j < 3; ++j) { mj[j] = -INFINITY; lj[j] = 0.f; if (j < nsel) { const float2 v = *(const float2*)(ML + ((size_t)(tg * 8 + h) * 3 + j) * 2); mj[j] = v.x; lj[j] = v.y; } M = fmaxf(M, mj[j]); }
            const float w0 = __expf(m - M); float den = l * w0; float wj[3];
#pragma unroll
            for (int j = 0; j < 3; ++j) { wj[j] = (j < nsel) ? __expf(mj[j] - M) : 0.f; den += lj[j] * wj[j]; }
            const float inv = 1.0f / den;
#pragma unroll
            for (int dt = 0; dt < 8; ++dt) {
                v4f acc = o[dt] * w0;
#pragma unroll
                for (int j = 0; j < 3; ++j) if (j < nsel) { const uint2 u = *(const uint2*)(PART + ((size_t)(tg * 8 + h) * 3 + j) * 128 + dt * 16 + 4 * g);
                    acc[0] += bflo(u.x) * wj[j]; acc[1] += bfhi(u.x) * wj[j]; acc[2] += bflo(u.y) * wj[j]; acc[3] += bfhi(u.y) * wj[j]; }
                acc = acc * inv;
                *(uint2*)(AO + (size_t)tg * 1024 + h * 128 + dt * 16 + 4 * g) = make_uint2(pg8::cvt_pk_bf16(acc[0], acc[1]), pg8::cvt_pk_bf16(acc[2], acc[3]));
            }
        }
    }
}

constexpr int RL = 512;
constexpr size_t ST_SLOT = (size_t)512 * 256;
__device__ __forceinline__ float ret_lg(int h) { return log2f(1.f - exp2f(-5.f - (float)h)); }

__device__ void phase_ret_kv(const Params& p, unsigned char* lds) {
    const int tid = otid(), wave = __builtin_amdgcn_readfirstlane(tid >> 6), lane = tid & 63, g = lane >> 4, i = lane & 15, q = i >> 2, pp = i & 3;
    const int we = wave >> 2, wd = wave & 3;
    LAS unsigned char* Ks = (LAS unsigned char*)lds;
    const bf16_t* QK = (const bf16_t*)(p.ws + OFF_BIG + B_QK); const bf16_t* Vt = (const bf16_t*)(p.ws + OFF_BIG + B_V); bf16_t* ST = (bf16_t*)(p.ws + OFF_BIG + B_ST);
    for (int unit = obid(); unit < 240; unit += gridDim.x) {
        const int eh = unit & 1, s = (unit >> 1) % 15, bh = (unit >> 1) / 15, b = bh >> 2, h = bh & 3;
        const float lg = ret_lg(h);
        v4f acc[4][8];
#pragma unroll
        for (int m = 0; m < 4; ++m)
#pragma unroll
            for (int n = 0; n < 8; ++n) acc[m][n] = (v4f){0.f, 0.f, 0.f, 0.f};
        const bf16_t* krow = QK + ((size_t)b * SEQ + s * RL) * 2048 + 1024 + h * 256;
        const bf16_t* vrow = Vt + (size_t)(h * 512 + eh * 256 + we * 128 + i) * 16384 + (size_t)b * SEQ + s * RL + 8 * g;
#pragma unroll 1
        for (int st = 0; st < 8; ++st) {
            __syncthreads();
#pragma unroll
            for (int it = 0; it < 4; ++it) { const int idx = it * 512 + tid, row = idx >> 5, ch = idx & 31;
                const v4u kv = *(const v4u*)(krow + (size_t)(st * 64 + row) * 2048 + ch * 8);
                const float w = exp2f((float)(RL - 1 - (st * 64 + row)) * lg);
                v4u o; o.x = pg8::cvt_pk_bf16(bflo(kv.x) * w, bfhi(kv.x) * w); o.y = pg8::cvt_pk_bf16(bflo(kv.y) * w, bfhi(kv.y) * w); o.z = pg8::cvt_pk_bf16(bflo(kv.z) * w, bfhi(kv.z) * w); o.w = pg8::cvt_pk_bf16(bflo(kv.w) * w, bfhi(kv.w) * w);
                const int f = ((row & 3) | ((row >> 1) & 4)) << 1;
                *(LAS v4u*)(Ks + row * 512 + ((ch ^ f) << 4)) = o; }
            __syncthreads();
#pragma unroll
            for (int kk = 0; kk < 2; ++kk) {
                bf16x8_t af[4];
#pragma unroll
                for (int m = 0; m < 4; ++m) {
                    const int r0 = kk * 32 + 8 * g + q, r1 = r0 + 4, ch = (wd * 64 + m * 16) / 8 + (pp >> 1);
                    const int f0 = ((r0 & 3) | ((r0 >> 1) & 4)) << 1, f1 = ((r1 & 3) | ((r1 >> 1) & 4)) << 1;
                    const s16x4_t a0 = __builtin_amdgcn_ds_read_tr16_b64_v4i16((LAS s16x4_t*)(Ks + r0 * 512 + ((ch ^ f0) << 4) + (pp & 1) * 8));
                    const s16x4_t a1 = __builtin_amdgcn_ds_read_tr16_b64_v4i16((LAS s16x4_t*)(Ks + r1 * 512 + ((ch ^ f1) << 4) + (pp & 1) * 8));
                    af[m] = (bf16x8_t){a0[0], a0[1], a0[2], a0[3], a1[0], a1[1], a1[2], a1[3]};
                }
#pragma unroll
                for (int nh = 0; nh < 2; ++nh) { bf16x8_t bf[4];
#pragma unroll
                    for (int n = 0; n < 4; ++n) bf[n] = *(const bf16x8_t*)(vrow + (size_t)(16 * (nh * 4 + n)) * 16384 + st * 64 + kk * 32);
#pragma unroll
                    for (int m = 0; m < 4; ++m)
#pragma unroll
                        for (int n = 0; n < 4; ++n) acc[m][nh * 4 + n] = __builtin_amdgcn_mfma_f32_16x16x32_bf16(af[m], bf[n], acc[m][nh * 4 + n], 0, 0, 0); }
            }
        }
        bf16_t* out = ST + ((size_t)bh * 15 + s) * ST_SLOT;
#pragma unroll
        for (int m = 0; m < 4; ++m)
#pragma unroll
            for (int n = 0; n < 8; ++n) { const int e = eh * 256 + we * 128 + n * 16 + i, d = wd * 64 + m * 16 + 4 * g;
                *(uint2*)(out + (size_t)e * 256 + d) = make_uint2(pg8::cvt_pk_bf16(acc[m][n][0], acc[m][n][1]), pg8::cvt_pk_bf16(acc[m][n][2], acc[m][n][3])); }
    }
}

__device__ void phase_ret_scan2(const Params& p) {
    bf16_t* ST = (bf16_t*)(p.ws + OFF_BIG + B_ST);
    for (int gid = obid() * 512 + otid(); gid < 8 * 16384; gid += gridDim.x * 512) {
        const int bh = gid >> 14, h = bh & 3; const size_t off = (size_t)(gid & 16383) * 8;
        const float cd = exp2f((float)RL * ret_lg(h));
        float S[8];
#pragma unroll
        for (int k = 0; k < 8; ++k) S[k] = 0.f;
        bf16_t* base = ST + (size_t)bh * 15 * ST_SLOT + off;
#pragma unroll 1
        for (int s = 0; s < 15; ++s) {
            const v4u u = *(const v4u*)(base + s * ST_SLOT);
            S[0] = S[0] * cd + bflo(u.x); S[1] = S[1] * cd + bfhi(u.x); S[2] = S[2] * cd + bflo(u.y); S[3] = S[3] * cd + bfhi(u.y);
            S[4] = S[4] * cd + bflo(u.z); S[5] = S[5] * cd + bfhi(u.z); S[6] = S[6] * cd + bflo(u.w); S[7] = S[7] * cd + bfhi(u.w);
            v4u o; o.x = pg8::cvt_pk_bf16(S[0], S[1]); o.y = pg8::cvt_pk_bf16(S[2], S[3]); o.z = pg8::cvt_pk_bf16(S[4], S[5]); o.w = pg8::cvt_pk_bf16(S[6], S[7]);
            *(v4u*)(base + s * ST_SLOT) = o;
        }
    }
}

__device__ void phase_ret_out(const Params& p, unsigned char* lds) {
    const int tid = otid(), wave = __builtin_amdgcn_readfirstlane(tid >> 6), lane = tid & 63, g = lane >> 4, i = lane & 15;
    LAS unsigned char* Ks = (LAS unsigned char*)lds;
    LAS unsigned char* Ps = Ks + 65536;
    LAS float* red = (LAS float*)(Ks + 98304);
    const bf16_t* QK = (const bf16_t*)(p.ws + OFF_BIG + B_QK); const bf16_t* Vt = (const bf16_t*)(p.ws + OFF_BIG + B_V); const bf16_t* ST = (const bf16_t*)(p.ws + OFF_BIG + B_ST);
    bf16_t* O = (bf16_t*)(p.ws + OFF_BIG + B_O);
    for (int unit = obid(); unit < 256; unit += gridDim.x) {
        const int pi = unit & 1, s = (unit >> 1) & 15, bh = unit >> 5, b = bh >> 2, h = bh & 3;
        const float lg = ret_lg(h);
#pragma unroll 1
        for (int half = 0; half < 2; ++half) {
            const int a = half ? 3 - pi : pi;
            const size_t trow0 = (size_t)b * SEQ + s * RL + a * 128;
            v4f o[4][8];
#pragma unroll
            for (int mt = 0; mt < 4; ++mt)
#pragma unroll
                for (int nt = 0; nt < 8; ++nt) o[mt][nt] = (v4f){0.f, 0.f, 0.f, 0.f};
            if (s > 0) {
                const bf16_t* sp = ST + ((size_t)bh * 15 + (s - 1)) * ST_SLOT + (size_t)(wave * 64 + i) * 256 + 8 * g;
                const bf16_t* qp = QK + (trow0 + i) * 2048 + h * 256 + 8 * g;
#pragma unroll 1
                for (int ks = 0; ks < 8; ++ks) {
                    bf16x8_t af[4];
#pragma unroll
                    for (int mt = 0; mt < 4; ++mt) af[mt] = *(const bf16x8_t*)(sp + (size_t)(16 * mt) * 256 + ks * 32);
#pragma unroll
                    for (int nh = 0; nh < 2; ++nh) { bf16x8_t bfq[4];
#pragma unroll
                        for (int nt = 0; nt < 4; ++nt) bfq[nt] = *(const bf16x8_t*)(qp + (size_t)(16 * (nh * 4 + nt)) * 2048 + ks * 32);
#pragma unroll
                        for (int mt = 0; mt < 4; ++mt)
#pragma unroll
                            for (int nt = 0; nt < 4; ++nt) o[mt][nh * 4 + nt] = __builtin_amdgcn_mfma_f32_16x16x32_bf16(af[mt], bfq[nt], o[mt][nh * 4 + nt], 0, 0, 0); }
                }
#pragma unroll
                for (int nt = 0; nt < 8; ++nt) { const float sc = exp2f((float)(a * 128 + nt * 16 + i + 1) * lg);
#pragma unroll
                    for (int mt = 0; mt < 4; ++mt) o[mt][nt] = o[mt][nt] * sc; }
            }
#pragma unroll 1
            for (int j = 0; j <= a; ++j) {
                __syncthreads();
                { const bf16_t* krow = QK + ((size_t)b * SEQ + s * RL + j * 128) * 2048 + 1024 + h * 256;
#pragma unroll
                    for (int it = 0; it < 8; ++it) { const int idx = it * 512 + tid, row = idx >> 5, ch = idx & 31;
                        *(LAS v4u*)(Ks + row * 512 + ((ch ^ (row & 15)) << 4)) = *(const v4u*)(krow + (size_t)row * 2048 + ch * 8); } }
                __syncthreads();
                {
                    const bf16_t* qp = QK + (trow0 + wave * 16 + i) * 2048 + h * 256 + 8 * g;
                    const int prow = wave * 16 + i, tq = a * 128 + prow;
#pragma unroll 1
                    for (int kh = 0; kh < 2; ++kh) {
                        v4f st[4];
#pragma unroll
                        for (int kt = 0; kt < 4; ++kt) st[kt] = (v4f){0.f, 0.f, 0.f, 0.f};
#pragma unroll 2
                        for (int ks = 0; ks < 8; ++ks) { const bf16x8_t bq = *(const bf16x8_t*)(qp + ks * 32);
#pragma unroll
                            for (int kt = 0; kt < 4; ++kt) { const int row = (kh * 4 + kt) * 16 + i; const bf16x8_t ak = *(const LAS bf16x8_t*)(Ks + row * 512 + (((ks * 4 + g) ^ (row & 15)) << 4));
                                st[kt] = __builtin_amdgcn_mfma_f32_16x16x32_bf16(ak, bq, st[kt], 0, 0, 0); } }
#pragma unroll
                        for (int kt = 0; kt < 4; ++kt) { float v[4]; const int ktt = kh * 4 + kt;
#pragma unroll
                            for (int r = 0; r < 4; ++r) { const int dist = tq - (j * 128 + ktt * 16 + 4 * g + r); v[r] = dist >= 0 ? st[kt][r] * exp2f((float)dist * lg) : 0.f; }
                            const int ch = 2 * ktt + (g >> 1);
                            pg8::u32x2 pw; pw.x = pg8::cvt_pk_bf16(v[0], v[1]); pw.y = pg8::cvt_pk_bf16(v[2], v[3]); *(LAS pg8::u32x2*)(Ps + prow * 256 + ((ch ^ (prow & 15)) << 4) + (g & 1) * 8) = pw; }
                    }
                }
                __syncthreads();
                const bf16_t* vp = Vt + (size_t)(h * 512 + wave * 64 + i) * 16384 + (size_t)b * SEQ + s * RL + j * 128 + 8 * g;
#pragma unroll 1
                for (int ks = 0; ks < 4; ++ks) {
                    bf16x8_t af[4];
#pragma unroll
                    for (int mt = 0; mt < 4; ++mt) af[mt] = *(const bf16x8_t*)(vp + (size_t)(16 * mt) * 16384 + ks * 32);
#pragma unroll
                    for (int nh = 0; nh < 2; ++nh) { bf16x8_t bp[4];
#pragma unroll
                        for (int nt = 0; nt < 4; ++nt) { const int row = (nh * 4 + nt) * 16 + i; bp[nt] = *(const LAS bf16x8_t*)(Ps + row * 256 + (((ks * 4 + g) ^ (row & 15)) << 4)); }
#pragma unroll
                        for (int mt = 0; mt < 4; ++mt)
#pragma unroll
                            for (int nt = 0; nt < 4; ++nt) o[mt][nh * 4 + nt] = __builtin_amdgcn_mfma_f32_16x16x32_bf16(af[mt], bp[nt], o[mt][nh * 4 + nt], 0, 0, 0); }
                }
            }
            float ssq[8];
#pragma unroll
            for (int nt = 0; nt < 8; ++nt) { float a2 = 0.f;
#pragma unroll
                for (int mt = 0; mt < 4; ++mt)
#pragma unroll
                    for (int r = 0; r < 4; ++r) a2 += o[mt][nt][r] * o[mt][nt][r];
                a2 += __shfl_xor(a2, 16); a2 += __shfl_xor(a2, 32); ssq[nt] = a2; }
            __syncthreads();
            if (g == 0) {
#pragma unroll
                for (int nt = 0; nt < 8; ++nt) red[wave * 128 + nt * 16 + i] = ssq[nt]; }
            __syncthreads();
#pragma unroll
            for (int nt = 0; nt < 8; ++nt) { float tot = 0.f;
#pragma unroll
                for (int w = 0; w < 8; ++w) tot += red[w * 128 + nt * 16 + i];
                const float rstd = 1.0f / sqrtf(tot * (1.0f / 512.0f) + 1e-6f);
                bf16_t* po = O + (trow0 + nt * 16 + i) * 2048 + h * 512 + wave * 64 + 4 * g;
#pragma unroll
                for (int mt = 0; mt < 4; ++mt) *(uint2*)(po + mt * 16) = make_uint2(pg8::cvt_pk_bf16(o[mt][nt][0] * rstd, o[mt][nt][1] * rstd), pg8::cvt_pk_bf16(o[mt][nt][2] * rstd, o[mt][nt][3] * rstd)); }
        }
    }
}

template <class Epi>
__device__ __forceinline__ void dense_gemm(unsigned char* lds, const bf16_t* A, const bf16_t* Bt, int N, int K, const Epi& E, int M = T) {
    pg8::Gemm g{A, Bt, M, N, K}; pg8::StaticOrder S; S.init(M, N, (int)gridDim.x, obid());
    pg8::gemm_phase<Epi, pg8::StaticOrder, true, true>((LAS unsigned char*)lds, g, S, E);
}

template <int STAGE>
__device__ __forceinline__ void expert_gemm(const Params& p, int L, unsigned char* lds) {
    Route R = get_route(p, L);
    LAS int* tab = (LAS int*)((LAS unsigned char*)lds + 131072);
    __syncthreads();
    if (otid() == 0) { int s = 0, b = 0; for (int e = 0; e < 16; ++e) { const int c = R.cnt[e]; tab[e] = s; tab[32 + e] = c; tab[48 + e] = b; s += ((c + 255) >> 8) * 4; b += (c + 255) & ~255; } tab[16] = s; }
    __syncthreads();
    const bf16_t* E = (const bf16_t*)(p.ws + OFF_BIG + B_E);
    bf16_t* HG = (bf16_t*)(p.ws + OFF_BIG + B_HG); bf16_t* YG = (bf16_t*)(p.ws + OFF_BIG + B_YG);
    if (STAGE == 1) {
        pg8::GroupedOrder<1> S{tab, (int)gridDim.x, obid(), R.list, (const char*)E};
        pg8::EpiExp1 Ep{HG, R.cwl, tab};
        pg8::gemm_phase_g<pg8::EpiExp1, pg8::GroupedOrder<1>, true>((LAS unsigned char*)lds, (const char*)(p.ws + OFF_XN), 1024, S, Ep);
    } else {
        pg8::GroupedOrder<2> S{tab, (int)gridDim.x, obid(), nullptr, (const char*)E + (2u << 20)};
        pg8::EpiExp2 Ep{YG};
        pg8::gemm_phase_g<pg8::EpiExp2, pg8::GroupedOrder<2>, true>((LAS unsigned char*)lds, (const char*)HG, 512, S, Ep);
    }
}

constexpr int NPHASE = 20;
__device__ __forceinline__ void run_phase(const Params& p, int ph, unsigned char* lds) {
    float* sm = (float*)lds;
    unsigned char* big = p.ws + OFF_BIG;
    const bf16_t* XN = (const bf16_t*)(p.ws + OFF_XN);
    const bf16_t* WB = (const bf16_t*)(p.ws + OFF_WB);
    switch (ph) {
    case 0: phase_prologue(p, lds); break;
    case 1: { pg8::EpiInproj E{(bf16_t*)(big + B_QK), (const float*)(p.ws + OFF_TABRET), (const float*)(p.ws + OFF_TABRET) + 8192 * 128};
        dense_gemm(lds, XN, WB + W_IN / 2, 2048, 1024, E);
        pg8::EpiVt E2{(bf16_t*)(big + B_V)};
        dense_gemm(lds, WB + W_IN / 2 + (size_t)2048 * 1024, XN, 16384, 1024, E2, 2048); } break;
    case 2: phase_ret_kv(p, lds); break;
    case 3: phase_ret_scan2(p); break;
    case 4: phase_ret_out(p, lds); break;
    case 5: { pg8::EpiG E{(bf16_t*)(big + B_O)}; dense_gemm(lds, XN, WB + W_IN / 2 + (size_t)4096 * 1024, 2048, 1024, E); } break;
    case 6: { pg8::EpiResid E{p.x, p.out}; dense_gemm(lds, (const bf16_t*)(big + B_O), WB + W_OUT / 2, 1024, 2048, E); } break;
    case 7: convert_expert_weights(p, 0, lds); __syncthreads(); norm_pass<1>(p, 0, lds); break;
    case 8: expert_gemm<1>(p, 0, lds); break;
    case 9: expert_gemm<2>(p, 0, lds); break;
    case 10: norm_pass<2>(p, 0, lds); break;
    case 11: { pg8::EpiKVQ E{(bf16_t*)(big + B_K), (bf16_t*)(big + B_VB), (bf16_t*)(big + B_Q), (const float*)(p.ws + OFF_TABROPE), (const float*)(p.ws + OFF_TABROPE) + 8192 * 16};
        dense_gemm(lds, XN, WB + W_KVQ / 2, 3072, 1024, E); } break;
    case 12: phase_kmean2(p); break;
    case 13: phase_moba_gate(p, lds); break;
    case 14: phase_moba_sel(p, lds); break;
    case 15: phase_moba_own(p, lds); break;
    case 16: { pg8::EpiResid E{p.out, p.out}; dense_gemm(lds, (const bf16_t*)(big + B_AO), WB + W_O / 2, 1024, 1024, E); } break;
    case 17: convert_expert_weights(p, 1, lds); __syncthreads(); norm_pass<1>(p, 1, lds); break;
    case 18: expert_gemm<1>(p, 1, lds); break;
    case 19: expert_gemm<2>(p, 1, lds); break;
    case 20: norm_pass<3>(p, 1, lds); break;
    default: break;
    }
}
constexpr int LAST_PHASE = 20;

#if MK_SINGLE
constexpr int PARAM_LDS_OFF = LDS_BYTES - 256;
__device__ __forceinline__ Params get_params(unsigned char* lds) {
    const LAS unsigned* w = (const LAS unsigned*)((LAS unsigned char*)lds + PARAM_LDS_OFF);
    union { Params p; unsigned u[sizeof(Params) / 4]; } x;
#pragma unroll
    for (int k = 0; k < (int)(sizeof(Params) / 4); ++k) x.u[k] = __builtin_amdgcn_readfirstlane(w[k]);
    return x.p;
}
template <int PH> __device__ __forceinline__ void run_all(unsigned char* lds, cg::grid_group& grid) {
    { const Params q = get_params(lds); run_phase(q, PH, lds); }
    if constexpr (PH < LAST_PHASE) { grid.sync(); run_all<PH + 1>(lds, grid); }
}
__global__ void __launch_bounds__(512) mega(Params p) {
    extern __shared__ __attribute__((aligned(16))) unsigned char lds[];
    cg::grid_group grid = cg::this_grid();
    if (threadIdx.x == 0) { union { Params p; unsigned u[sizeof(Params) / 4]; } x; x.p = p; LAS unsigned* w = (LAS unsigned*)((LAS unsigned char*)lds + PARAM_LDS_OFF);
#pragma unroll
        for (int k = 0; k < (int)(sizeof(Params) / 4); ++k) w[k] = x.u[k]; }
    __syncthreads();
    run_all<0>(lds, grid);
}
#else
template <int PH> __global__ void __launch_bounds__(512) phase_kernel(Params p) {
    extern __shared__ __attribute__((aligned(16))) unsigned char lds[];
    run_phase(p, PH, lds);
}
template <int PH> static void launch_phases(const Params& p, int grid, hipStream_t stream) {
    if constexpr (PH <= LAST_PHASE) {
        static bool attr = false;
        if (!attr) { (void)hipFuncSetAttribute((const void*)phase_kernel<PH>, hipFuncAttributeMaxDynamicSharedMemorySize, LDS_BYTES); attr = true; }
        phase_kernel<PH><<<grid, 512, LDS_BYTES, stream>>>(p); launch_phases<PH + 1>(p, grid, stream); }
}
#endif

extern "C" void kernel_launch(void* const* d_in, const int* in_sizes, int n_in, void* d_out, int out_size, void* d_ws, size_t ws_size, hipStream_t stream) {
    if (ws_size < WS_NEED) { fprintf(stderr, "workspace too small: %zu < %zu\n", ws_size, WS_NEED); return; }
    Params p{};
    p.x = (const float*)d_in[0]; p.ret_norm = (const float*)d_in[1]; p.ret_w_in = (const float*)d_in[2]; p.ret_w_out = (const float*)d_in[3]; p.kv_norm = (const float*)d_in[4];
    p.w_kv = (const float*)d_in[5]; p.attn_norm = (const float*)d_in[6]; p.w_q = (const float*)d_in[7]; p.w_o = (const float*)d_in[8]; p.ffn_norm = (const float*)d_in[9];
    p.rg_w = (const float*)d_in[10]; p.rg_b = (const float*)d_in[11]; p.re_w = (const float*)d_in[12]; p.re_b = (const float*)d_in[13]; p.wg = (const float*)d_in[14];
    p.wu = (const float*)d_in[15]; p.wd = (const float*)d_in[16]; p.final_norm = (const float*)d_in[17];
    p.out = (float*)d_out; p.ws = (unsigned char*)d_ws;
    static int grid_blocks = 0;
    if (!grid_blocks) {
        int dev = 0, cus = 0, per_cu = 0;
        (void)hipGetDevice(&dev);
        (void)hipDeviceGetAttribute(&cus, hipDeviceAttributeMultiprocessorCount, dev);
#if MK_SINGLE
        if (hipFuncSetAttribute((const void*)mega, hipFuncAttributeMaxDynamicSharedMemorySize, LDS_BYTES) != hipSuccess) fprintf(stderr, "hipFuncSetAttribute failed\n");
        if (hipOccupancyMaxActiveBlocksPerMultiprocessor(&per_cu, (const void*)mega, 512, LDS_BYTES) != hipSuccess || per_cu < 1) fprintf(stderr, "occupancy query: %d blocks per CU\n", per_cu);
#endif
        grid_blocks = cus;
    }
#if MK_SINGLE
    void* args[] = {&p};
    hipError_t e = hipLaunchCooperativeKernel((void*)mega, dim3(grid_blocks), dim3(512), args, LDS_BYTES, stream);
    if (e != hipSuccess) fprintf(stderr, "cooperative launch failed: %s (grid %d)\n", hipGetErrorString(e), grid_blocks);
#else
    launch_phases<0>(p, grid_blocks, stream);
#endif
}
```

```cpp
#include <hip/hip_runtime.h>
#include <hip/hip_cooperative_groups.h>
#include <cstdio>
#include <cstdint>
namespace cg = cooperative_groups;

#ifndef MK_SINGLE
#define MK_SINGLE 1
#endif

typedef unsigned short bf16_t;
#define LAS __attribute__((address_space(3)))
typedef float v4f __attribute__((ext_vector_type(4)));
typedef unsigned v4u __attribute__((ext_vector_type(4)));
constexpr int T = 16384, SEQ = 8192;
constexpr size_t MiB = (size_t)1 << 20;
constexpr size_t OFF_CTRL = 0, OFF_ROUTE = 1 * MiB, OFF_KMEAN = 3 * MiB + 512 * 1024, OFF_TABROPE = 4 * MiB,
                 OFF_WB = 8 * MiB, OFF_XN = 32 * MiB, OFF_BIG = 64 * MiB, OFF_EXTRA = 288 * MiB, OFF_TABRET = OFF_EXTRA, WS_NEED = 304 * MiB;
constexpr size_t W_IN = 0, W_OUT = 12 * MiB, W_KVQ = 16 * MiB, W_O = 22 * MiB;
constexpr int LDS_BYTES = 147456;
constexpr size_t B_QK = 0, B_V = 64 * MiB, B_O = 128 * MiB, B_ST = 192 * MiB;
constexpr size_t B_E = 0, B_HG = 48 * MiB, B_YG = 84 * MiB;
constexpr size_t B_K = 0, B_VB = 32 * MiB, B_Q = 64 * MiB, B_PART = 96 * MiB, B_AO = 192 * MiB;

struct Params {
    const float *x, *ret_norm, *ret_w_in, *ret_w_out, *kv_norm, *w_kv, *attn_norm, *w_q, *w_o, *ffn_norm, *rg_w, *rg_b, *re_w, *re_b, *wg, *wu, *wd, *final_norm;
    float* out; unsigned char* ws;
};

__device__ __forceinline__ int otid() { int t = threadIdx.x; asm volatile("" : "+v"(t)); return t; }
__device__ __forceinline__ int obid() { int b = blockIdx.x; asm volatile("" : "+s"(b)); return b; }
__device__ __forceinline__ bf16_t f2bf(float f) { unsigned u = __float_as_uint(f); u += 0x7fffu + ((u >> 16) & 1u); return (bf16_t)(u >> 16); }
__device__ __forceinline__ float bf2f(bf16_t h) { return __uint_as_float(((unsigned)h) << 16); }
__device__ __forceinline__ float bflo(unsigned u) { return __uint_as_float(u << 16); }
__device__ __forceinline__ float bfhi(unsigned u) { return __uint_as_float(u & 0xffff0000u); }
__device__ __forceinline__ unsigned pack2(float a, float b) { return (unsigned)f2bf(a) | ((unsigned)f2bf(b) << 16); }
__device__ __forceinline__ float wsum(float v) { for (int o = 32; o > 0; o >>= 1) v += __shfl_xor(v, o); return v; }
__device__ __forceinline__ float wmax(float v) { for (int o = 32; o > 0; o >>= 1) v = fmaxf(v, __shfl_xor(v, o)); return v; }
__device__ __forceinline__ float silu(float v) { return v / (1.f + __expf(-v)); }

__device__ void sincos_big(double a, double& s, double& c) {
    const double twopi = 6.283185307179586476925286766559;
    double k = rint(a / twopi); double r = a - k * twopi;
    double x2 = r * r, ts = r, tc = 1.0; s = r; c = 1.0;
#pragma unroll 1
    for (int n = 1; n <= 16; ++n) { tc *= -x2 / (double)((2 * n - 1) * (2 * n)); c += tc; ts *= -x2 / (double)((2 * n) * (2 * n + 1)); s += ts; }
}

struct Route { int* cnt; int *e0, *e1, *p0, *p1; float *w0, *w1; int* list; float* cwl; };
__device__ __forceinline__ Route get_route(const Params& p, int L) {
    Route r; r.cnt = (int*)(p.ws + OFF_CTRL) + L * 16;
    unsigned char* b = p.ws + OFF_ROUTE;
    r.e0 = (int*)b; r.e1 = r.e0 + T; r.p0 = r.e1 + T; r.p1 = r.p0 + T; r.w0 = (float*)(r.p1 + T); r.w1 = r.w0 + T; r.list = (int*)(b + 512 * 1024); r.cwl = (float*)(b + 1536 * 1024);
    return r;
}
__device__ __forceinline__ int expert_base(const int* cnt, int e) { int s = 0; for (int i = 0; i < e; ++i) s += (cnt[i] + 255) & ~255; return s; }

template <int MODE>
__device__ void norm_pass(const Params& p, int L, unsigned char* lds) {
    const int wave = otid() >> 6, lane = otid() & 63;
    LAS float* wr = (LAS float*)(LAS unsigned char*)lds;
    LAS int* ebase = (LAS int*)(LAS unsigned char*)lds;
    if (MODE >= 2) { __syncthreads(); if (otid() < 16) ebase[otid()] = expert_base(get_route(p, L).cnt, otid()); __syncthreads(); }
    if (MODE == 1) {
        for (int i = otid(); i < 1024 * 5; i += 512) { const int k = i / 5, part = i % 5;
            float4 w = part == 0 ? *(const float4*)(p.rg_w + ((size_t)L * 1024 + k) * 4) : *(const float4*)(p.re_w + (((size_t)L * 4 + part - 1) * 1024 + k) * 4);
            const float g = p.ffn_norm[L * 1024 + k]; w.x *= g; w.y *= g; w.z *= g; w.w *= g;
            v4f w4 = {w.x, w.y, w.z, w.w}; *(LAS v4f*)(wr + k * 20 + part * 4) = w4; }
        __syncthreads();
    }
    bf16_t* XN = (bf16_t*)(p.ws + OFF_XN);
    const bf16_t* YG = (const bf16_t*)(p.ws + OFF_BIG + B_YG);
    Route R = get_route(p, L);
    for (int t = obid() * 8 + wave; t < T; t += gridDim.x * 8) {
        const float* src = (MODE == 0 ? p.x : p.out) + (size_t)t * 1024;
        float4 v[4];
#pragma unroll
        for (int j = 0; j < 4; ++j) v[j] = *(const float4*)(src + j * 256 + lane * 4);
        if (MODE >= 2) {
            const int r0 = ebase[R.e0[t]] + R.p0[t], r1 = ebase[R.e1[t]] + R.p1[t];
#pragma unroll
            for (int j = 0; j < 4; ++j) {
                uint2 a = *(const uint2*)(YG + (size_t)r0 * 1024 + j * 256 + lane * 4), b = *(const uint2*)(YG + (size_t)r1 * 1024 + j * 256 + lane * 4);
                v[j].x += bflo(a.x) + bflo(b.x); v[j].y += bfhi(a.x) + bfhi(b.x); v[j].z += bflo(a.y) + bflo(b.y); v[j].w += bfhi(a.y) + bfhi(b.y);
            }
        }
        float ss = 0.f;
#pragma unroll
        for (int j = 0; j < 4; ++j) ss += v[j].x * v[j].x + v[j].y * v[j].y + v[j].z * v[j].z + v[j].w * v[j].w;
        ss = wsum(ss);
        const float rstd = 1.0f / sqrtf(ss * (1.0f / 1024.0f) + 1e-6f);
        if (MODE == 2) {
#pragma unroll
            for (int j = 0; j < 4; ++j) *(float4*)(p.out + (size_t)t * 1024 + j * 256 + lane * 4) = v[j];
        }
        if (MODE == 3) {
#pragma unroll
            for (int j = 0; j < 4; ++j) { float4 g = *(const float4*)(p.final_norm + j * 256 + lane * 4);
                float4 o; o.x = v[j].x * rstd * g.x; o.y = v[j].y * rstd * g.y; o.z = v[j].z * rstd * g.z; o.w = v[j].w * rstd * g.w;
                *(float4*)(p.out + (size_t)t * 1024 + j * 256 + lane * 4) = o; }
        } else {
#pragma unroll
            for (int j = 0; j < 4; ++j) { uint2 o; o.x = pack2(v[j].x * rstd, v[j].y * rstd); o.y = pack2(v[j].z * rstd, v[j].w * rstd);
                *(uint2*)(XN + (size_t)t * 1024 + j * 256 + lane * 4) = o; }
        }
        if (MODE == 1) {
            float acc[20];
#pragma unroll
            for (int i = 0; i < 20; ++i) acc[i] = 0.f;
            const LAS float* wl = wr + lane * 80;
            const float tv[4][4] = {{v[0].x * rstd, v[0].y * rstd, v[0].z * rstd, v[0].w * rstd}, {v[1].x * rstd, v[1].y * rstd, v[1].z * rstd, v[1].w * rstd},
                                    {v[2].x * rstd, v[2].y * rstd, v[2].z * rstd, v[2].w * rstd}, {v[3].x * rstd, v[3].y * rstd, v[3].z * rstd, v[3].w * rstd}};
#pragma unroll
            for (int j = 0; j < 4; ++j) {
                asm volatile("" ::: "memory");
                const float tk[4] = {tv[j][0], tv[j][1], tv[j][2], tv[j][3]};
#pragma unroll
                for (int c = 0; c < 4; ++c) {
#pragma unroll
                    for (int q = 0; q < 5; ++q) { const v4f w = *(const LAS v4f*)(wl + j * 5120 + c * 20 + q * 4);
                        acc[q * 4 + 0] += tk[c] * w[0]; acc[q * 4 + 1] += tk[c] * w[1]; acc[q * 4 + 2] += tk[c] * w[2]; acc[q * 4 + 3] += tk[c] * w[3]; }
                }
            }
#pragma unroll
            for (int i = 0; i < 20; ++i) acc[i] = wsum(acc[i]);
            float lg[4];
#pragma unroll
            for (int g = 0; g < 4; ++g) lg[g] = acc[g] + p.rg_b[L * 4 + g];
            int gi = 0; float gm = lg[0];
#pragma unroll
            for (int g = 1; g < 4; ++g) if (lg[g] > gm) { gm = lg[g]; gi = g; }
            float den = 0.f;
#pragma unroll
            for (int g = 0; g < 4; ++g) den += expf(lg[g] - gm);
            const float gval = 1.0f / den;
            float el[4] = {0.f, 0.f, 0.f, 0.f};
#pragma unroll
            for (int g = 0; g < 4; ++g) if (g == gi) {
#pragma unroll
                for (int e = 0; e < 4; ++e) el[e] = acc[4 + g * 4 + e] + p.re_b[(L * 4 + g) * 4 + e]; }
            int i0 = 0; float v0 = el[0];
#pragma unroll
            for (int e = 1; e < 4; ++e) if (el[e] > v0) { v0 = el[e]; i0 = e; }
            int i1 = -1; float v1 = -INFINITY;
#pragma unroll
            for (int e = 0; e < 4; ++e) if (e != i0 && el[e] > v1) { v1 = el[e]; i1 = e; }
            const float ex = expf(v1 - v0); const float ew0 = 1.0f / (1.0f + ex), ew1 = ex / (1.0f + ex);
            if (lane == 0) {
                const int ea = gi * 4 + i0, eb = gi * 4 + i1;
                const int pa = atomicAdd(R.cnt + ea, 1), pb = atomicAdd(R.cnt + eb, 1);
                R.list[ea * T + pa] = t; R.list[eb * T + pb] = t; R.cwl[ea * T + pa] = gval * ew0; R.cwl[eb * T + pb] = gval * ew1;
                R.e0[t] = ea; R.e1[t] = eb; R.p0[t] = pa; R.p1[t] = pb; R.w0[t] = gval * ew0; R.w1[t] = gval * ew1;
            }
        }
    }
}

template <int NB, class AF, class BF, class EF>
__device__ __forceinline__ void gemm_tile_naive(int K, const AF& af, const BF& bf, const EF& ef, float* sm) {
    float (*As)[132] = (float (*)[132])sm;
    float (*Bs)[16][68] = (float (*)[16][68])(sm + 16 * 132);
    const int tid = otid(), ty = tid >> 4, tx = tid & 15;
    float acc[NB][4][4];
#pragma unroll
    for (int n = 0; n < NB; ++n)
#pragma unroll
        for (int i = 0; i < 4; ++i)
#pragma unroll
            for (int j = 0; j < 4; ++j) acc[n][i][j] = 0.f;
    const int ar = tid >> 2, ak = (tid & 3) * 4, bk = tid >> 5, bc = (tid & 31) * 2;
    for (int k0 = 0; k0 < K; k0 += 16) {
        const float4 a = af(ar, k0 + ak);
        float2 b[NB];
#pragma unroll
        for (int n = 0; n < NB; ++n) b[n] = bf(n, k0 + bk, bc);
        __syncthreads();
        As[ak + 0][ar] = a.x; As[ak + 1][ar] = a.y; As[ak + 2][ar] = a.z; As[ak + 3][ar] = a.w;
#pragma unroll
        for (int n = 0; n < NB; ++n) { Bs[n][bk][bc] = b[n].x; Bs[n][bk][bc + 1] = b[n].y; }
        __syncthreads();
#pragma unroll
        for (int kk = 0; kk < 16; ++kk) {
            const float4 av = *(const float4*)&As[kk][ty * 4];
            const float a4[4] = {av.x, av.y, av.z, av.w};
#pragma unroll
            for (int n = 0; n < NB; ++n) { const float4 bv = *(const float4*)&Bs[n][kk][tx * 4]; const float b4[4] = {bv.x, bv.y, bv.z, bv.w};
#pragma unroll
                for (int i = 0; i < 4; ++i)
#pragma unroll
                    for (int j = 0; j < 4; ++j) acc[n][i][j] += a4[i] * b4[j]; }
        }
    }
#pragma unroll
    for (int i = 0; i < 4; ++i)
#pragma unroll
        for (int j = 0; j < 4; ++j) ef(ty * 4 + i, tx * 4 + j, acc[0][i][j], NB == 2 ? acc[NB - 1][i][j] : 0.f);
}

__device__ __forceinline__ float4 ld_bf4(const bf16_t* p) { const uint2 u = *(const uint2*)p; return make_float4(bflo(u.x), bfhi(u.x), bflo(u.y), bfhi(u.y)); }

template <class EF>
__device__ void gemm_dense_naive(const bf16_t* A, int lda, int K, int N, const float* B0, int ldb0, const float* gain0, int nsplit, const float* B1, int ldb1, const float* gain1, const EF& ef, float* sm) {
    const int ntn = N / 64, ntm = T / 128;
    for (int tile = obid(); tile < ntn * ntm; tile += gridDim.x) {
        const int tm = tile / ntn, tn = tile % ntn, m0 = tm * 128, n0 = tn * 64;
        const float* B; int ldb; const float* gain; int nb0;
        if (n0 < nsplit) { B = B0; ldb = ldb0; gain = gain0; nb0 = n0; } else { B = B1; ldb = ldb1; gain = gain1; nb0 = n0 - nsplit; }
        auto af = [&](int r, int k) { return ld_bf4(A + (size_t)(m0 + r) * lda + k); };
        auto bf = [&](int, int k, int c) { float2 w = *(const float2*)(B + (size_t)k * ldb + nb0 + c); const float g = gain ? gain[k] : 1.f; w.x *= g; w.y *= g; return w; };
        auto e2 = [&](int r, int c, float v, float) { ef(m0 + r, n0 + c, v); };
        gemm_tile_naive<1>(K, af, bf, e2, sm);
    }
}

template <int STAGE>
__device__ void gemm_expert_naive(const Params& p, int L, float* sm) {
    Route R = get_route(p, L);
    const bf16_t* XN = (const bf16_t*)(p.ws + OFF_XN);
    bf16_t* HG = (bf16_t*)(p.ws + OFF_BIG + B_HG); bf16_t* YG = (bf16_t*)(p.ws + OFF_BIG + B_YG);
    const int ntn = STAGE == 1 ? 512 / 64 : 1024 / 64;
    int* tstart = (int*)(sm + 6000);
    __syncthreads();
    if (otid() == 0) { int s = 0; for (int e = 0; e < 16; ++e) { tstart[e] = s; s += ((R.cnt[e] + 127) >> 7) * ntn; } tstart[16] = s; }
    __syncthreads();
    for (int tile = obid(); tile < tstart[16]; tile += gridDim.x) {
        int e = 0;
#pragma unroll 1
        for (int i = 1; i < 16; ++i) if (tile >= tstart[i]) e = i;
        const int lt = tile - tstart[e], tm = lt / ntn, tn = lt % ntn, m0 = tm * 128, n0 = tn * 64, cnt = R.cnt[e], base = expert_base(R.cnt, e);
        const int* list = R.list + e * T;
        if (STAGE == 1) {
            const float* Wg = p.wg + ((size_t)(L * 16 + e)) * 1024 * 512; const float* Wu = p.wu + ((size_t)(L * 16 + e)) * 1024 * 512; const float* gain = p.ffn_norm + L * 1024;
            auto af = [&](int r, int k) { const int rr = m0 + r; if (rr >= cnt) return make_float4(0.f, 0.f, 0.f, 0.f); return ld_bf4(XN + (size_t)list[rr] * 1024 + k); };
            auto bf = [&](int n, int k, int c) { float2 w = *(const float2*)((n == 0 ? Wg : Wu) + (size_t)k * 512 + n0 + c); const float g = gain[k]; w.x *= g; w.y *= g; return w; };
            auto ef = [&](int r, int c, float g, float u) { const int rr = m0 + r; if (rr >= cnt) return; const int tok = list[rr]; const float cw = (R.e0[tok] == e) ? R.w0[tok] : R.w1[tok];
                HG[(size_t)(base + rr) * 512 + n0 + c] = f2bf(silu(g) * u * cw); };
            gemm_tile_naive<2>(1024, af, bf, ef, sm);
        } else {
            const float* Wd = p.wd + ((size_t)(L * 16 + e)) * 512 * 1024;
            auto af = [&](int r, int k) { const int rr = m0 + r; if (rr >= cnt) return make_float4(0.f, 0.f, 0.f, 0.f); return ld_bf4(HG + (size_t)(base + rr) * 512 + k); };
            auto bf = [&](int, int k, int c) { return *(const float2*)(Wd + (size_t)k * 1024 + n0 + c); };
            auto ef = [&](int r, int c, float v, float) { const int rr = m0 + r; if (rr >= cnt) return; YG[(size_t)(base + rr) * 1024 + n0 + c] = f2bf(v); };
            gemm_tile_naive<1>(512, af, bf, ef, sm);
        }
    }
}


namespace pg8 {
#define PG8_LAS __attribute__((address_space(3)))
typedef unsigned short bf16_t;
typedef short bf16x8 __attribute__((ext_vector_type(8)));
typedef float f32x4 __attribute__((ext_vector_type(4)));
typedef unsigned u32x4 __attribute__((ext_vector_type(4)));
constexpr int BM = 256, BK = 64, HALF = 128, HTB = HALF * BK * 2  , STAGE_BYTES = 8 * HTB, NXCD = 8, WGM = 8;

__host__ __device__ __forceinline__ int lds_byte(int r, int c) { const int st = (r >> 4) * 2 + (c >> 5), rr = r & 15, cc = c & 31, ob = rr * 64 + cc * 2; return st * 1024 + (ob ^ (((ob >> 9) & 1) << 5)); }
__host__ __device__ __forceinline__ void stage_rc(int b, int& R, int& C) { const int st = b / 1024, sb = b % 1024, swz = sb ^ (((sb >> 9) & 1) << 5); R = (st >> 1) * 16 + swz / 64; C = (st & 1) * 32 + (swz % 64) / 2; }
__host__ __device__ __forceinline__ int perm32(int rho) { const int n = rho >> 4, i = rho & 15; return 8 * (i >> 2) + 4 * n + (i & 3); }

struct Unit { int pm, pn; };
struct Gemm { const bf16_t* A; const bf16_t* Bt; int M, N, K; };

struct StaticOrder {
    int nM, nN, nwg, G, c;
    __host__ __device__ void init(int M, int N, int G_, int c_) { nM = M / BM; nN = N / BM; nwg = nM * nN; G = G_; c = c_; }
    __host__ __device__ bool next(int i, Unit& u) const {
        const long L = (long)i * G + c; if (L >= nwg) return false;
        int wgid = (int)L; { const int q = nwg / NXCD, r = nwg % NXCD, xcd = wgid % NXCD, off = wgid / NXCD; wgid = (xcd < r ? xcd * (q + 1) : r * (q + 1) + (xcd - r) * q) + off; }
        const int nig = WGM * nN, gid = wgid / nig, fm = gid * WGM, gsz = (nM - fm) < WGM ? (nM - fm) : WGM;
        u.pm = fm + ((wgid % nig) % gsz); u.pn = (wgid % nig) / gsz; return true;
    }
    __device__ __forceinline__ void a_ready(const Unit&) const {}
    __device__ __forceinline__ void done(const Unit&) const {}
};


__device__ __forceinline__ unsigned cvt_pk_bf16(float lo, float hi) { unsigned r; asm volatile("v_cvt_pk_bf16_f32 %0, %1, %2" : "=v"(r) : "v"(lo), "v"(hi)); return r; }
__device__ __forceinline__ u32x4 pk8(const f32x4& a, const f32x4& b) { u32x4 w; w.x = cvt_pk_bf16(a[0], a[1]); w.y = cvt_pk_bf16(a[2], a[3]); w.z = cvt_pk_bf16(b[0], b[1]); w.w = cvt_pk_bf16(b[2], b[3]); return w; }
typedef unsigned u32x2 __attribute__((ext_vector_type(2)));
__device__ __forceinline__ u32x2 pk4(const f32x4& a) { u32x2 w; w.x = cvt_pk_bf16(a[0], a[1]); w.y = cvt_pk_bf16(a[2], a[3]); return w; }
__device__ __forceinline__ float fsilu(float v) { return v * __builtin_amdgcn_rcpf(1.f + __expf(-v)); }

struct EpiInproj {
    static constexpr bool PERM = true, AFTER_DRAIN = false;
    bf16_t* QK; const float* rc; const float* rs;
    __device__ __forceinline__ void operator()(const f32x4 (&acc)[2][2][4][2], const Unit& u, int wr, int wc, int fr, int fq) const {
        const int row0 = u.pm * BM + wr * 64 + fr;
        {
            const int f0 = wc * 32 + 8 * fq;
#pragma unroll
            for (int ai = 0; ai < 2; ++ai)
#pragma unroll
                for (int m = 0; m < 4; ++m) { const int r = row0 + ai * HALF + m * 16, pos = r & 8191;
                    const f32x4 c0 = *(const f32x4*)(rc + pos * 128 + f0), c1 = *(const f32x4*)(rc + pos * 128 + f0 + 4), s0 = *(const f32x4*)(rs + pos * 128 + f0), s1 = *(const f32x4*)(rs + pos * 128 + f0 + 4);
                    const f32x4 x1a = acc[ai][0][m][0], x1b = acc[ai][0][m][1], x2a = acc[ai][1][m][0], x2b = acc[ai][1][m][1];
                    bf16_t* p = QK + (size_t)r * 2048 + u.pn * 256 + f0;
                    *(u32x4*)p = pk8(x1a * c0 - x2a * s0, x1b * c1 - x2b * s1);
                    *(u32x4*)(p + 128) = pk8(x2a * c0 + x1a * s0, x2b * c1 + x1b * s1); }
        }
    }
};
struct EpiVt {
    static constexpr bool PERM = true, AFTER_DRAIN = false;
    bf16_t* Vt;
    __device__ __forceinline__ void operator()(const f32x4 (&acc)[2][2][4][2], const Unit& u, int wr, int wc, int fr, int fq) const {
        const int row0 = u.pm * BM + wr * 64 + fr;
#pragma unroll
        for (int ai = 0; ai < 2; ++ai)
#pragma unroll
            for (int m = 0; m < 4; ++m) { bf16_t* p = Vt + (size_t)(row0 + ai * HALF + m * 16) * 16384 + u.pn * BM + wc * 32 + 8 * fq;
#pragma unroll
                for (int bj = 0; bj < 2; ++bj) *(u32x4*)(p + bj * HALF) = pk8(acc[ai][bj][m][0], acc[ai][bj][m][1]); }
    }
};
struct EpiG {
    static constexpr bool PERM = true, AFTER_DRAIN = false;
    bf16_t* O;
    __device__ __forceinline__ void operator()(const f32x4 (&acc)[2][2][4][2], const Unit& u, int wr, int wc, int fr, int fq) const {
        const int row0 = u.pm * BM + wr * 64 + fr;
#pragma unroll
        for (int ai = 0; ai < 2; ++ai)
#pragma unroll
            for (int m = 0; m < 4; ++m) { const int r = row0 + ai * HALF + m * 16; bf16_t* p = O + (size_t)r * 2048 + u.pn * 256 + wc * 32 + 8 * fq;
#pragma unroll
                for (int bj = 0; bj < 2; ++bj) { const u32x4 o = *(const u32x4*)(p + bj * HALF); const f32x4 g0 = acc[ai][bj][m][0], g1 = acc[ai][bj][m][1];
                    f32x4 y0, y1; y0[0] = fsilu(g0[0]) * bflo(o.x); y0[1] = fsilu(g0[1]) * bfhi(o.x); y0[2] = fsilu(g0[2]) * bflo(o.y); y0[3] = fsilu(g0[3]) * bfhi(o.y);
                    y1[0] = fsilu(g1[0]) * bflo(o.z); y1[1] = fsilu(g1[1]) * bfhi(o.z); y1[2] = fsilu(g1[2]) * bflo(o.w); y1[3] = fsilu(g1[3]) * bfhi(o.w);
                    *(u32x4*)(p + bj * HALF) = pk8(y0, y1); } }
    }
};
struct EpiResid {
    static constexpr bool PERM = false, AFTER_DRAIN = false;
    const float* base; float* out;
    __device__ __forceinline__ void operator()(const f32x4 (&acc)[2][2][4][2], const Unit& u, int wr, int wc, int fr, int fq) const {
        const int row0 = u.pm * BM + wr * 64 + fr, col0 = u.pn * BM + wc * 32 + 4 * fq;
#pragma unroll
        for (int ai = 0; ai < 2; ++ai)
#pragma unroll
            for (int m = 0; m < 4; ++m) { const size_t off = (size_t)(row0 + ai * HALF + m * 16) * 1024 + col0;
#pragma unroll
                for (int bj = 0; bj < 2; ++bj)
#pragma unroll
                    for (int n = 0; n < 2; ++n) { const f32x4 b = *(const f32x4*)(base + off + bj * HALF + n * 16); *(f32x4*)(out + off + bj * HALF + n * 16) = b + acc[ai][bj][m][n]; } }
    }
};
struct EpiKVQ {
    static constexpr bool PERM = false, AFTER_DRAIN = false;
    bf16_t *K, *Vb, *Q; const float* pc; const float* ps;
    __device__ __forceinline__ void operator()(const f32x4 (&acc)[2][2][4][2], const Unit& u, int wr, int wc, int fr, int fq) const {
        const int which = u.pn >> 2; bf16_t* dst = K + (size_t)which * (16u << 20);
        const int row0 = u.pm * BM + wr * 64 + fr, col0 = (u.pn & 3) * BM + wc * 32 + 4 * fq;
        const bool rot = (which != 1) && (wc == 0);
#pragma unroll
        for (int ai = 0; ai < 2; ++ai)
#pragma unroll
            for (int m = 0; m < 4; ++m) { const int r = row0 + ai * HALF + m * 16, pos = r & 8191;
                f32x4 c = {1.f, 1.f, 1.f, 1.f}, s = {0.f, 0.f, 0.f, 0.f};
                if (rot) { c = *(const f32x4*)(pc + pos * 16 + 4 * fq); s = *(const f32x4*)(ps + pos * 16 + 4 * fq); }
#pragma unroll
                for (int bj = 0; bj < 2; ++bj) { f32x4 v0 = acc[ai][bj][m][0], v1 = acc[ai][bj][m][1];
                    if (rot) { const f32x4 y0 = v0 * c - v1 * s, y1 = v1 * c + v0 * s; v0 = y0; v1 = y1; }
                    bf16_t* p = dst + (size_t)r * 1024 + col0 + bj * HALF;
                    *(u32x2*)p = pk4(v0); *(u32x2*)(p + 16) = pk4(v1); } }
    }
};
template <class Epi, class Sched, bool ALIGN_EPI = false, bool SP2 = false>
__device__ __forceinline__ void gemm_phase(PG8_LAS unsigned char* lds, const Gemm g, const Sched& S, const Epi& E) {
    const int tid = otid(), wid = __builtin_amdgcn_readfirstlane(tid >> 6), lane = tid & 63, wr = wid >> 2, wc = wid & 3, fr = lane & 15, fq = lane >> 4;
    const int K = g.K, nt = K / BK;
    unsigned voffA[2], voffB[2];
#pragma unroll
    for (int i = 0; i < 2; ++i) { int R, C; stage_rc(tid * 16 + i * 8192, R, C); const int Rb = Epi::PERM ? ((R & ~31) + perm32(R & 31)) : R;
        voffA[i] = (unsigned)(R * K + C) * 2u; voffB[i] = (unsigned)(Rb * K + C) * 2u; }
    const size_t kstep = (size_t)(BK * 2);
    const size_t hstep = (size_t)HALF * K * 2;
    const size_t tstep = 2 * hstep;
    const unsigned ldsw = (unsigned)wid * 1024u;
    const int aoff = lds_byte(wr * 64 + fr, fq * 8), boff = lds_byte(wc * 32 + fr, fq * 8);
#define PG8_SA(b, h) (((b) * 2 + (h)) * HTB)
#define PG8_SB(b, h) ((4 + (b) * 2 + (h)) * HTB)
#define PG8_STAGE(bufoff, gbase, voff) do { _Pragma("unroll") for (int _i = 0; _i < 2; ++_i) \
        __builtin_amdgcn_global_load_lds((const unsigned*)((const char*)(gbase) + (voff)[_i]), (PG8_LAS unsigned*)(lds + (bufoff) + ldsw + _i * 8192), 16, 0, 0); } while (0)
#define PG8_LDA(dst, b, h) do { _Pragma("unroll") for (int m = 0; m < 4; ++m) _Pragma("unroll") for (int k = 0; k < 2; ++k) dst[m][k] = *(const PG8_LAS bf16x8*)(lds + PG8_SA(b, h) + aoff + m * 2048 + k * 1024); } while (0)
#define PG8_LDB(dst, b, h) do { _Pragma("unroll") for (int n = 0; n < 2; ++n) _Pragma("unroll") for (int k = 0; k < 2; ++k) dst[n][k] = *(const PG8_LAS bf16x8*)(lds + PG8_SB(b, h) + boff + n * 2048 + k * 1024); } while (0)
#define PG8_MMA(ai, bj, At, Bt) do { __builtin_amdgcn_s_setprio(1); _Pragma("unroll") for (int m = 0; m < 4; ++m) _Pragma("unroll") for (int n = 0; n < 2; ++n) _Pragma("unroll") for (int k = 0; k < 2; ++k) \
        acc[ai][bj][m][n] = __builtin_amdgcn_mfma_f32_16x16x32_bf16(Bt[n][k], At[m][k], acc[ai][bj][m][n], 0, 0, 0); __builtin_amdgcn_s_setprio(0); } while (0)
#define PG8_WAIT_V(n) asm volatile("s_waitcnt vmcnt(" #n ")" ::: "memory")
#define PG8_WAIT_L(n) asm volatile("s_waitcnt lgkmcnt(" #n ")" ::: "memory")
#define PG8_BAR __builtin_amdgcn_s_barrier()
#define PG8_SCHED __builtin_amdgcn_sched_barrier(0)
    Unit cur, nxt; int ui = 0;
    if (!S.next(0, cur)) return;
    f32x4 acc[2][2][4][2];
#pragma unroll
    for (int a = 0; a < 2; ++a)
#pragma unroll
        for (int b = 0; b < 2; ++b)
#pragma unroll
            for (int m = 0; m < 4; ++m)
#pragma unroll
                for (int n = 0; n < 2; ++n) acc[a][b][m][n] = (f32x4){0.f, 0.f, 0.f, 0.f};
    bf16x8 At[4][2], B0[2][2], B1[2][2];
    const char* cA = (const char*)g.A + (size_t)cur.pm * tstep; const char* cB = (const char*)g.Bt + (size_t)cur.pn * tstep;
    S.a_ready(cur);
    if constexpr (SP2) {
        PG8_STAGE(PG8_SB(0, 0), cB, voffB); PG8_STAGE(PG8_SB(0, 1), cB + hstep, voffB); PG8_STAGE(PG8_SA(0, 0), cA, voffA); PG8_STAGE(PG8_SA(0, 1), cA + hstep, voffA);
        if (wr == 1) PG8_BAR;
        PG8_WAIT_V(2); PG8_BAR;
        PG8_STAGE(PG8_SB(1, 0), cB + kstep, voffB); PG8_STAGE(PG8_SA(1, 0), cA + kstep, voffA); PG8_STAGE(PG8_SB(1, 1), cB + hstep + kstep, voffB);
        PG8_WAIT_V(6); PG8_BAR;
    } else {
        PG8_STAGE(PG8_SB(0, 0), cB, voffB); PG8_STAGE(PG8_SA(0, 0), cA, voffA); PG8_STAGE(PG8_SB(0, 1), cB + hstep, voffB); PG8_STAGE(PG8_SA(0, 1), cA + hstep, voffA);
        if (wr == 1) PG8_BAR;
        PG8_WAIT_V(4); PG8_BAR;
        PG8_STAGE(PG8_SB(1, 0), cB + kstep, voffB); PG8_STAGE(PG8_SA(1, 0), cA + kstep, voffA); PG8_STAGE(PG8_SB(1, 1), cB + hstep + kstep, voffB);
        PG8_WAIT_V(6); PG8_BAR;
    }
    for (;;) {
        const bool has_next = S.next(ui + 1, nxt);
        const char* nA = has_next ? (const char*)g.A + (size_t)nxt.pm * tstep : cA; const char* nB = has_next ? (const char*)g.Bt + (size_t)nxt.pn * tstep : cB;
        for (int t = 0; t < nt; t += 2) {
            const bool last = (t == nt - 2);
            const char* a1 = cA + (size_t)(t + 1) * kstep;
            const char* a2 = last ? nA : cA + (size_t)(t + 2) * kstep; const char* b2 = last ? nB : cB + (size_t)(t + 2) * kstep;
            const char* a3 = a2 + kstep; const char* b3 = b2 + kstep;
            if (last && has_next) S.a_ready(nxt);
            if constexpr (SP2) {
            PG8_LDB(B0, 0, 0); PG8_LDB(B1, 0, 1); PG8_SCHED; PG8_LDA(At, 0, 0); PG8_STAGE(PG8_SA(1, 1), a1 + hstep, voffA);
            PG8_WAIT_V(8); PG8_WAIT_L(0); PG8_BAR; PG8_MMA(0, 0, At, B0); PG8_MMA(0, 1, At, B1); PG8_BAR; PG8_SCHED;
            PG8_LDA(At, 0, 1); PG8_STAGE(PG8_SB(0, 0), b2, voffB); PG8_STAGE(PG8_SB(0, 1), b2 + hstep, voffB); PG8_STAGE(PG8_SA(0, 0), a2, voffA);
            PG8_WAIT_V(8); PG8_WAIT_L(0); PG8_BAR; PG8_MMA(1, 0, At, B0); PG8_MMA(1, 1, At, B1); PG8_BAR; PG8_SCHED;
            PG8_LDB(B0, 1, 0); PG8_LDB(B1, 1, 1); PG8_SCHED; PG8_LDA(At, 1, 0); PG8_STAGE(PG8_SA(0, 1), a2 + hstep, voffA);
            PG8_WAIT_V(8); PG8_WAIT_L(0); PG8_BAR; PG8_MMA(0, 0, At, B0); PG8_MMA(0, 1, At, B1); PG8_BAR; PG8_SCHED;
            PG8_LDA(At, 1, 1); PG8_STAGE(PG8_SB(1, 0), b3, voffB); PG8_STAGE(PG8_SB(1, 1), b3 + hstep, voffB); PG8_STAGE(PG8_SA(1, 0), a3, voffA);
            PG8_WAIT_V(8); PG8_WAIT_L(0); PG8_BAR; PG8_MMA(1, 0, At, B0); PG8_MMA(1, 1, At, B1); PG8_BAR; PG8_SCHED;
            } else {
            PG8_LDB(B0, 0, 0); PG8_SCHED; PG8_LDA(At, 0, 0); PG8_STAGE(PG8_SA(1, 1), a1 + hstep, voffA);
            PG8_WAIT_L(8); PG8_BAR; PG8_WAIT_L(0); PG8_MMA(0, 0, At, B0); PG8_BAR; PG8_SCHED;
            PG8_LDB(B1, 0, 1); PG8_STAGE(PG8_SB(0, 0), b2, voffB);
            PG8_BAR; PG8_WAIT_L(0); PG8_MMA(0, 1, At, B1); PG8_BAR;
            PG8_LDA(At, 0, 1); PG8_STAGE(PG8_SA(0, 0), a2, voffA);
            PG8_BAR; PG8_WAIT_L(0); PG8_MMA(1, 0, At, B0); PG8_BAR; PG8_SCHED;
            PG8_STAGE(PG8_SB(0, 1), b2 + hstep, voffB);
            PG8_WAIT_V(6); PG8_BAR; PG8_MMA(1, 1, At, B1); PG8_BAR;
            PG8_LDB(B0, 1, 0); PG8_SCHED; PG8_LDA(At, 1, 0); PG8_STAGE(PG8_SA(0, 1), a2 + hstep, voffA);
            PG8_WAIT_L(8); PG8_BAR; PG8_WAIT_L(0); PG8_MMA(0, 0, At, B0); PG8_BAR; PG8_SCHED;
            PG8_LDB(B1, 1, 1); PG8_STAGE(PG8_SB(1, 0), b3, voffB);
            PG8_BAR; PG8_WAIT_L(0); PG8_MMA(0, 1, At, B1); PG8_BAR;
            PG8_LDA(At, 1, 1); PG8_STAGE(PG8_SA(1, 0), a3, voffA);
            PG8_BAR; PG8_WAIT_L(0); PG8_MMA(1, 0, At, B0); PG8_BAR; PG8_SCHED;
            PG8_STAGE(PG8_SB(1, 1), b3 + hstep, voffB);
            PG8_WAIT_V(6); PG8_BAR; PG8_MMA(1, 1, At, B1); PG8_BAR;
            }
        }
        if constexpr (ALIGN_EPI) { if (wr == 0) PG8_BAR; }
        if constexpr (!Epi::AFTER_DRAIN) { E(acc, cur, wr, wc, fr, fq); S.done(cur); }
        if (!has_next) break;
#pragma unroll
        for (int a = 0; a < 2; ++a)
#pragma unroll
            for (int b = 0; b < 2; ++b)
#pragma unroll
                for (int m = 0; m < 4; ++m)
#pragma unroll
                    for (int n = 0; n < 2; ++n) acc[a][b][m][n] = (f32x4){0.f, 0.f, 0.f, 0.f};
        cur = nxt; cA = nA; cB = nB; ++ui;
        if constexpr (ALIGN_EPI) { if (wr == 1) PG8_BAR; }
    }
    PG8_WAIT_V(0);
    if constexpr (!ALIGN_EPI) { if (wr == 0) PG8_BAR; }
    PG8_BAR;
    if constexpr (Epi::AFTER_DRAIN) { E.fused(acc, cur, wr, wc, fr, fq, lds, wid, lane); S.done(cur); }
#undef PG8_SA
#undef PG8_SB
#undef PG8_STAGE
#undef PG8_LDA
#undef PG8_LDB
#undef PG8_MMA
#undef PG8_WAIT_V
#undef PG8_WAIT_L
#undef PG8_BAR
#undef PG8_SCHED
}

struct GUnit { int pm, pn, e, row0; };
template <int STAGE> struct GroupedOrder {
    typedef GUnit UnitT;
    const PG8_LAS int* tab; int G, c; const int* list; const char* Bt;
    __device__ __forceinline__ bool next(int i, GUnit& u) const {
        const int L = i * G + c; if (L >= tab[16]) return false;
        int e = 0;
#pragma unroll
        for (int j = 1; j < 16; ++j) e = (L >= tab[j]) ? j : e;
        const int lt = L - tab[e]; u.e = e; u.pm = lt >> 2; u.pn = lt & 3; u.row0 = tab[48 + e] + u.pm * 256; return true;
    }
    __device__ __forceinline__ unsigned rowoff(const GUnit& u, int r) const {
        if (STAGE == 1) { const int idx = u.pm * 256 + r; const int tok = idx < tab[32 + u.e] ? list[u.e * T + idx] : 0; return (unsigned)tok * 2048u; }
        return (unsigned)(u.row0 + r) * 1024u;
    }
    __device__ __forceinline__ const char* bbase(const GUnit& u) const { return Bt + (size_t)u.e * (3u << 20) + (size_t)u.pn * (STAGE == 1 ? 256 * 1024 * 2 : 256 * 512 * 2); }
    __device__ __forceinline__ void a_ready(const GUnit&) const {}
    __device__ __forceinline__ void done(const GUnit&) const {}
};
struct EpiExp1 {
    static constexpr bool PERM = true, AFTER_DRAIN = false;
    bf16_t* HG; const float* cwl; const PG8_LAS int* tab;
    __device__ __forceinline__ void operator()(const f32x4 (&acc)[2][2][4][2], const GUnit& u, int wr, int wc, int fr, int fq) const {
        const int cnt = tab[32 + u.e];
#pragma unroll
        for (int ai = 0; ai < 2; ++ai)
#pragma unroll
            for (int m = 0; m < 4; ++m) { const int rl = wr * 64 + fr + ai * HALF + m * 16, idx = u.pm * 256 + rl;
                const float cw = idx < cnt ? cwl[u.e * T + idx] : 0.f;
                const f32x4 g0 = acc[ai][0][m][0], g1 = acc[ai][0][m][1], u0 = acc[ai][1][m][0], u1 = acc[ai][1][m][1];
                f32x4 h0, h1;
#pragma unroll
                for (int j = 0; j < 4; ++j) { h0[j] = fsilu(g0[j]) * u0[j] * cw; h1[j] = fsilu(g1[j]) * u1[j] * cw; }
                *(u32x4*)(HG + (size_t)(u.row0 + rl) * 512 + u.pn * 128 + wc * 32 + 8 * fq) = pk8(h0, h1); }
    }
};
struct EpiExp2 {
    static constexpr bool PERM = true, AFTER_DRAIN = false;
    bf16_t* YG;
    __device__ __forceinline__ void operator()(const f32x4 (&acc)[2][2][4][2], const GUnit& u, int wr, int wc, int fr, int fq) const {
#pragma unroll
        for (int ai = 0; ai < 2; ++ai)
#pragma unroll
            for (int m = 0; m < 4; ++m) { const int rl = wr * 64 + fr + ai * HALF + m * 16; bf16_t* p = YG + (size_t)(u.row0 + rl) * 1024 + u.pn * 256 + wc * 32 + 8 * fq;
#pragma unroll
                for (int bj = 0; bj < 2; ++bj) *(u32x4*)(p + bj * HALF) = pk8(acc[ai][bj][m][0], acc[ai][bj][m][1]); }
    }
};
template <class Epi, class Sched, bool ALIGN_EPI = false>
__device__ __forceinline__ void gemm_phase_g(PG8_LAS unsigned char* lds, const char* Abase, const int K, const Sched& S, const Epi& E) {
    constexpr bool SP2 = true;
    const int tid = otid(), wid = __builtin_amdgcn_readfirstlane(tid >> 6), lane = tid & 63, wr = wid >> 2, wc = wid & 3, fr = lane & 15, fq = lane >> 4;
    const int nt = K / BK;
    unsigned voffB[2]; int RA[2], CA2[2];
#pragma unroll
    for (int i = 0; i < 2; ++i) { int R, C; stage_rc(tid * 16 + i * 8192, R, C); const int Rb = Epi::PERM ? ((R & ~31) + perm32(R & 31)) : R;
        RA[i] = R; CA2[i] = C * 2; voffB[i] = (unsigned)(Rb * K + C) * 2u; }
    const size_t kstep = (size_t)(BK * 2);
    const size_t hstep = (size_t)HALF * K * 2;
    const size_t tstep = 2 * hstep;
    const unsigned ldsw = (unsigned)wid * 1024u;
    const int aoff = lds_byte(wr * 64 + fr, fq * 8), boff = lds_byte(wc * 32 + fr, fq * 8);
#define PG8_SA(b, h) (((b) * 2 + (h)) * HTB)
#define PG8_SB(b, h) ((4 + (b) * 2 + (h)) * HTB)
#define PG8_STAGE_A(bufoff, h, kb, nx) do { _Pragma("unroll") for (int _i = 0; _i < 2; ++_i) \
        __builtin_amdgcn_global_load_lds((const unsigned*)(Abase + ((nx) ? vAn[h][_i] : vAc[h][_i]) + (kb)), (PG8_LAS unsigned*)(lds + (bufoff) + ldsw + _i * 8192), 16, 0, 0); } while (0)
#define PG8_STAGE(bufoff, gbase, voff) do { _Pragma("unroll") for (int _i = 0; _i < 2; ++_i) \
        __builtin_amdgcn_global_load_lds((const unsigned*)((const char*)(gbase) + (voff)[_i]), (PG8_LAS unsigned*)(lds + (bufoff) + ldsw + _i * 8192), 16, 0, 0); } while (0)
#define PG8_LDA(dst, b, h) do { _Pragma("unroll") for (int m = 0; m < 4; ++m) _Pragma("unroll") for (int k = 0; k < 2; ++k) dst[m][k] = *(const PG8_LAS bf16x8*)(lds + PG8_SA(b, h) + aoff + m * 2048 + k * 1024); } while (0)
#define PG8_LDB(dst, b, h) do { _Pragma("unroll") for (int n = 0; n < 2; ++n) _Pragma("unroll") for (int k = 0; k < 2; ++k) dst[n][k] = *(const PG8_LAS bf16x8*)(lds + PG8_SB(b, h) + boff + n * 2048 + k * 1024); } while (0)
#define PG8_MMA(ai, bj, At, Bt) do { __builtin_amdgcn_s_setprio(1); _Pragma("unroll") for (int m = 0; m < 4; ++m) _Pragma("unroll") for (int n = 0; n < 2; ++n) _Pragma("unroll") for (int k = 0; k < 2; ++k) \
        acc[ai][bj][m][n] = __builtin_amdgcn_mfma_f32_16x16x32_bf16(Bt[n][k], At[m][k], acc[ai][bj][m][n], 0, 0, 0); __builtin_amdgcn_s_setprio(0); } while (0)
#define PG8_WAIT_V(n) asm volatile("s_waitcnt vmcnt(" #n ")" ::: "memory")
#define PG8_WAIT_L(n) asm volatile("s_waitcnt lgkmcnt(" #n ")" ::: "memory")
#define PG8_BAR __builtin_amdgcn_s_barrier()
#define PG8_SCHED __builtin_amdgcn_sched_barrier(0)
    typename Sched::UnitT cur, nxt; int ui = 0;
    if (!S.next(0, cur)) return;
    unsigned vAc[2][2], vAn[2][2];
#pragma unroll
    for (int h = 0; h < 2; ++h)
#pragma unroll
        for (int i = 0; i < 2; ++i) { vAc[h][i] = S.rowoff(cur, h * HALF + RA[i]) + (unsigned)CA2[i]; vAn[h][i] = vAc[h][i]; }
    f32x4 acc[2][2][4][2];
#pragma unroll
    for (int a = 0; a < 2; ++a)
#pragma unroll
        for (int b = 0; b < 2; ++b)
#pragma unroll
            for (int m = 0; m < 4; ++m)
#pragma unroll
                for (int n = 0; n < 2; ++n) acc[a][b][m][n] = (f32x4){0.f, 0.f, 0.f, 0.f};
    bf16x8 At[4][2], B0[2][2], B1[2][2];
    const char* cB = S.bbase(cur);
    S.a_ready(cur);
    if constexpr (SP2) {
        PG8_STAGE(PG8_SB(0, 0), cB, voffB); PG8_STAGE(PG8_SB(0, 1), cB + hstep, voffB); PG8_STAGE_A(PG8_SA(0, 0), 0, 0, false); PG8_STAGE_A(PG8_SA(0, 1), 1, 0, false);
        if (wr == 1) PG8_BAR;
        PG8_WAIT_V(2); PG8_BAR;
        PG8_STAGE(PG8_SB(1, 0), cB + kstep, voffB); PG8_STAGE_A(PG8_SA(1, 0), 0, (unsigned)kstep, false); PG8_STAGE(PG8_SB(1, 1), cB + hstep + kstep, voffB);
        PG8_WAIT_V(6); PG8_BAR;
    }
    for (;;) {
        const bool has_next = S.next(ui + 1, nxt);
        const char* nB = has_next ? S.bbase(nxt) : cB;
        if (has_next) {
#pragma unroll
            for (int h = 0; h < 2; ++h)
#pragma unroll
                for (int i = 0; i < 2; ++i) vAn[h][i] = S.rowoff(nxt, h * HALF + RA[i]) + (unsigned)CA2[i];
        }
        for (int t = 0; t < nt; t += 2) {
            const bool last = (t == nt - 2);
            const unsigned kb1 = (unsigned)(t + 1) * (unsigned)kstep;
            const unsigned kb2 = last ? 0u : (unsigned)(t + 2) * (unsigned)kstep; const char* b2 = last ? nB : cB + (size_t)(t + 2) * kstep;
            const unsigned kb3 = kb2 + (unsigned)kstep; const char* b3 = b2 + kstep;
            if (last && has_next) S.a_ready(nxt);
            if constexpr (SP2) {
            PG8_LDB(B0, 0, 0); PG8_LDB(B1, 0, 1); PG8_SCHED; PG8_LDA(At, 0, 0); PG8_STAGE_A(PG8_SA(1, 1), 1, kb1, false);
            PG8_WAIT_V(8); PG8_WAIT_L(0); PG8_BAR; PG8_MMA(0, 0, At, B0); PG8_MMA(0, 1, At, B1); PG8_BAR; PG8_SCHED;
            PG8_LDA(At, 0, 1); PG8_STAGE(PG8_SB(0, 0), b2, voffB); PG8_STAGE(PG8_SB(0, 1), b2 + hstep, voffB); PG8_STAGE_A(PG8_SA(0, 0), 0, kb2, last);
            PG8_WAIT_V(8); PG8_WAIT_L(0); PG8_BAR; PG8_MMA(1, 0, At, B0); PG8_MMA(1, 1, At, B1); PG8_BAR; PG8_SCHED;
            PG8_LDB(B0, 1, 0); PG8_LDB(B1, 1, 1); PG8_SCHED; PG8_LDA(At, 1, 0); PG8_STAGE_A(PG8_SA(0, 1), 1, kb2, last);
            PG8_WAIT_V(8); PG8_WAIT_L(0); PG8_BAR; PG8_MMA(0, 0, At, B0); PG8_MMA(0, 1, At, B1); PG8_BAR; PG8_SCHED;
            PG8_LDA(At, 1, 1); PG8_STAGE(PG8_SB(1, 0), b3, voffB); PG8_STAGE(PG8_SB(1, 1), b3 + hstep, voffB); PG8_STAGE_A(PG8_SA(1, 0), 0, kb3, last);
            PG8_WAIT_V(8); PG8_WAIT_L(0); PG8_BAR; PG8_MMA(1, 0, At, B0); PG8_MMA(1, 1, At, B1); PG8_BAR; PG8_SCHED;
            }
        }
        if constexpr (ALIGN_EPI) { if (wr == 0) PG8_BAR; }
        if constexpr (!Epi::AFTER_DRAIN) { E(acc, cur, wr, wc, fr, fq); S.done(cur); }
        if (!has_next) break;
#pragma unroll
        for (int a = 0; a < 2; ++a)
#pragma unroll
            for (int b = 0; b < 2; ++b)
#pragma unroll
                for (int m = 0; m < 4; ++m)
#pragma unroll
                    for (int n = 0; n < 2; ++n) acc[a][b][m][n] = (f32x4){0.f, 0.f, 0.f, 0.f};
        cur = nxt; cB = nB; ++ui;
#pragma unroll
        for (int h = 0; h < 2; ++h)
#pragma unroll
            for (int i = 0; i < 2; ++i) vAc[h][i] = vAn[h][i];
        if constexpr (ALIGN_EPI) { if (wr == 1) PG8_BAR; }
    }
    PG8_WAIT_V(0);
    if constexpr (!ALIGN_EPI) { if (wr == 0) PG8_BAR; }
    PG8_BAR;
    if constexpr (Epi::AFTER_DRAIN) { E.fused(acc, cur, wr, wc, fr, fq, lds, wid, lane); S.done(cur); }
#undef PG8_SA
#undef PG8_SB
#undef PG8_STAGE
#undef PG8_STAGE_A
#undef PG8_LDA
#undef PG8_LDB
#undef PG8_MMA
#undef PG8_WAIT_V
#undef PG8_WAIT_L
#undef PG8_BAR
#undef PG8_SCHED
}
}


__device__ __forceinline__ void tr_block(const float* W, int ldw, int k0, int n0, bf16_t* WT, int K, int drow0, const float* gain, float scale, LAS float* scr, int tid) {
    v4f v[4];
#pragma unroll
    for (int it = 0; it < 4; ++it) { const int idx = it * 512 + tid, row = idx >> 5, c4 = idx & 31; v[it] = *(const v4f*)(W + (size_t)(k0 + row) * ldw + n0 + 4 * c4); }
#pragma unroll
    for (int it = 0; it < 4; ++it) { const int idx = it * 512 + tid, row = idx >> 5, c4 = idx & 31; const float g = gain ? gain[k0 + row] * scale : scale;
        LAS float* d = scr + row * 129 + 4 * c4; d[0] = v[it][0] * g; d[1] = v[it][1] * g; d[2] = v[it][2] * g; d[3] = v[it][3] * g; }
    __syncthreads();
#pragma unroll
    for (int it = 0; it < 2; ++it) { const int idx = it * 512 + tid, n = idx >> 3, c = idx & 7; const LAS float* s = scr + (8 * c) * 129 + n;
        v4u o; o.x = pack2(s[0 * 129], s[1 * 129]); o.y = pack2(s[2 * 129], s[3 * 129]); o.z = pack2(s[4 * 129], s[5 * 129]); o.w = pack2(s[6 * 129], s[7 * 129]);
        *(v4u*)(WT + (size_t)(drow0 + n) * K + k0 + 8 * c) = o; }
    __syncthreads();
}
__device__ __forceinline__ void tr_job(int it, const float* W, int ldw, int K, int N, bf16_t* WT, int drow_base, const float* gain, float scale, LAS float* scr, int tid) {
    const int nblk = N / 128, kb = it / nblk, nb = it % nblk;
    tr_block(W, ldw, kb * 64, nb * 128, WT, K, drow_base + nb * 128, gain, scale, scr, tid);
}
__device__ void convert_dense_weights(const Params& p, unsigned char* lds) {
    const int tid = otid();
    LAS float* scr = (LAS float*)(LAS unsigned char*)lds;
    bf16_t* WB = (bf16_t*)(p.ws + OFF_WB);
    bf16_t* Win = WB + W_IN / 2; bf16_t* Wout = WB + W_OUT / 2; bf16_t* Wkvq = WB + W_KVQ / 2; bf16_t* Wo = WB + W_O / 2;
    constexpr int I0 = 16 * 48, I1 = 32 * 8, I2 = 16 * 16, I3 = 16 * 8, I4 = 16 * 8, NIT = I0 + I1 + I2 + I3 + I4;
    for (int it = obid(); it < NIT; it += gridDim.x) {
        int r = it;
        if (r < I0) { const int nb = r % 48; const float sc = (nb >= 8 && nb < 16) ? 0.0625f : 1.f;
            tr_job(r, p.ret_w_in, 6144, 1024, 6144, Win, 0, p.ret_norm, sc, scr, tid); continue; } r -= I0;
        if (r < I1) { tr_job(r, p.ret_w_out, 1024, 2048, 1024, Wout, 0, nullptr, 1.f, scr, tid); continue; } r -= I1;
        if (r < I2) { tr_job(r, p.w_kv, 2048, 1024, 2048, Wkvq, 0, p.kv_norm, 1.f, scr, tid); continue; } r -= I2;
        if (r < I3) { tr_job(r, p.w_q, 1024, 1024, 1024, Wkvq, 2048, p.attn_norm, 0.08838834764831845f, scr, tid); continue; } r -= I3;
        tr_job(r, p.w_o, 1024, 1024, 1024, Wo, 0, nullptr, 1.f, scr, tid);
    }
}
__device__ void convert_expert_weights(const Params& p, int L, unsigned char* lds) {
    const int tid = otid();
    LAS float* scr = (LAS float*)(LAS unsigned char*)lds;
    bf16_t* E = (bf16_t*)(p.ws + OFF_BIG + B_E);
    const float* gain = p.ffn_norm + L * 1024;
    for (int it = obid(); it < 16 * 192; it += gridDim.x) {
        const int e = it / 192; int r = it % 192;
        bf16_t* W1 = E + (size_t)e * 3 * 512 * 1024; bf16_t* W2 = W1 + 1024 * 1024;
        if (r < 128) { const int up = r >= 64; r &= 63; const int kb = r / 4, nb = r % 4;
            const float* W = (up ? p.wu : p.wg) + (size_t)(L * 16 + e) * 1024 * 512;
            tr_block(W, 512, kb * 64, nb * 128, W1, 1024, nb * 256 + up * 128, gain, 1.f, scr, tid);
        } else { r -= 128; tr_job(r, p.wd + (size_t)(L * 16 + e) * 512 * 1024, 1024, 512, 1024, W2, 0, nullptr, 1.f, scr, tid); }
    }
}

__device__ void phase_prologue(const Params& p, unsigned char* lds) {
    const int gtid = obid() * 512 + otid(), gsz = gridDim.x * 512;
    int* cnt = (int*)(p.ws + OFF_CTRL);
    if (gtid < 64 + 512) cnt[gtid] = 0;
    float* rc = (float*)(p.ws + OFF_TABRET); float* rs = rc + 8192 * 128;
    for (int i = gtid; i < 8192 * 128; i += gsz) { const int pos = i >> 7, f = i & 127;
        const float inv = (float)exp(-9.2103403719761836 * ((double)f / 128.0));
        const float ang = (float)pos * inv; double s, c; sincos_big((double)ang, s, c); rc[i] = (float)c; rs[i] = (float)s; }
    float* pc = (float*)(p.ws + OFF_TABROPE); float* ps = pc + 8192 * 16;
    for (int i = gtid; i < 8192 * 16; i += gsz) { const int pos = i >> 4, f = i & 15;
        const float inv = (float)exp(-13.122363377404328 * ((double)f / 16.0));
        const float ang = (float)pos * inv; double s, c; sincos_big((double)ang, s, c); pc[i] = (float)c; ps[i] = (float)s; }
    convert_dense_weights(p, lds);
    norm_pass<0>(p, 0, lds);
}

__device__ void phase_ret_rotary(const Params& p) {
    bf16_t* QK = (bf16_t*)(p.ws + OFF_BIG + B_QK);
    const float* rc = (const float*)(p.ws + OFF_TABRET); const float* rs = rc + 8192 * 128;
    const size_t total = (size_t)T * 8 * 128;
    for (size_t i = (size_t)obid() * 512 + otid(); i < total; i += (size_t)gridDim.x * 512) {
        const int f = (int)(i & 127), slot = (int)((i >> 7) & 7), t = (int)(i >> 10), pos = t & 8191;
        bf16_t* px = QK + (size_t)t * 2048 + slot * 256 + f;
        const float x1 = bf2f(px[0]), x2 = bf2f(px[128]), c = rc[pos * 128 + f], s = rs[pos * 128 + f];
        const float sc = slot >= 4 ? 0.0625f : 1.f;
        px[0] = f2bf((x1 * c - x2 * s) * sc); px[128] = f2bf((x2 * c + x1 * s) * sc);
    }
}

__device__ void phase_ret_scan(const Params& p) {
    const bf16_t* QK = (const bf16_t*)(p.ws + OFF_BIG + B_QK); const bf16_t* V = (const bf16_t*)(p.ws + OFF_BIG + B_V); bf16_t* O = (bf16_t*)(p.ws + OFF_BIG + B_O);
    const int wave = otid() >> 6, lane = otid() & 63;
    for (int item = obid() * 8 + wave; item < 2048; item += gridDim.x * 8) {
        const int b = item >> 10, h = (item >> 8) & 3, ep = item & 255;
        const float gamma = 1.f - exp2f(-5.f - (float)h);
        float S[4][2];
#pragma unroll
        for (int d = 0; d < 4; ++d) { S[d][0] = 0.f; S[d][1] = 0.f; }
        const bf16_t* qp = QK + (size_t)b * SEQ * 2048 + h * 256 + lane * 4;
        const bf16_t* kp = qp + 1024;
        const bf16_t* vp = V + (size_t)(h * 512 + ep * 2) * 16384 + (size_t)b * SEQ;
        bf16_t* op = O + (size_t)b * SEQ * 2048 + h * 512 + ep * 2;
#pragma unroll 4
        for (int t = 0; t < SEQ; ++t) {
            const uint2 qv = *(const uint2*)(qp + (size_t)t * 2048), kv = *(const uint2*)(kp + (size_t)t * 2048);
            const float q[4] = {bflo(qv.x), bfhi(qv.x), bflo(qv.y), bfhi(qv.y)}, k[4] = {bflo(kv.x), bfhi(kv.x), bflo(kv.y), bfhi(kv.y)};
            const float v0 = bf2f(vp[t]), v1 = bf2f(vp[16384 + t]);
            float p0 = 0.f, p1 = 0.f;
#pragma unroll
            for (int d = 0; d < 4; ++d) { S[d][0] = gamma * S[d][0] + k[d] * v0; S[d][1] = gamma * S[d][1] + k[d] * v1; p0 += q[d] * S[d][0]; p1 += q[d] * S[d][1]; }
            p0 = wsum(p0); p1 = wsum(p1);
            if (lane == 0) *(unsigned*)(op + (size_t)t * 2048) = pack2(p0, p1);
        }
    }
}

__device__ void phase_ret_gnorm(const Params& p) {
    bf16_t* O = (bf16_t*)(p.ws + OFF_BIG + B_O);
    const int wave = otid() >> 6, lane = otid() & 63;
    for (int item = obid() * 8 + wave; item < T * 4; item += gridDim.x * 8) {
        bf16_t* po = O + (size_t)item * 512 + lane * 8;
        const uint4 u = *(const uint4*)po;
        float v[8] = {bflo(u.x), bfhi(u.x), bflo(u.y), bfhi(u.y), bflo(u.z), bfhi(u.z), bflo(u.w), bfhi(u.w)};
        float ss = 0.f;
#pragma unroll
        for (int i = 0; i < 8; ++i) ss += v[i] * v[i];
        ss = wsum(ss);
        const float rstd = 1.0f / sqrtf(ss * (1.0f / 512.0f) + 1e-6f);
        uint4 o; o.x = pack2(v[0] * rstd, v[1] * rstd); o.y = pack2(v[2] * rstd, v[3] * rstd); o.z = pack2(v[4] * rstd, v[5] * rstd); o.w = pack2(v[6] * rstd, v[7] * rstd);
        *(uint4*)po = o;
    }
}

__device__ void phase_rope(const Params& p) {
    bf16_t* Kb = (bf16_t*)(p.ws + OFF_BIG + B_K); bf16_t* Qb = (bf16_t*)(p.ws + OFF_BIG + B_Q);
    const float* pc = (const float*)(p.ws + OFF_TABROPE); const float* ps = pc + 8192 * 16;
    const size_t total = (size_t)T * 2 * 8 * 16;
    for (size_t i = (size_t)obid() * 512 + otid(); i < total; i += (size_t)gridDim.x * 512) {
        const int f = (int)(i & 15), h = (int)((i >> 4) & 7), which = (int)((i >> 7) & 1), t = (int)(i >> 8), pos = t & 8191;
        bf16_t* px = (which ? Qb : Kb) + (size_t)t * 1024 + h * 128 + f;
        const float x1 = bf2f(px[0]), x2 = bf2f(px[16]), c = pc[pos * 16 + f], s = ps[pos * 16 + f];
        px[0] = f2bf(x1 * c - x2 * s); px[16] = f2bf(x2 * c + x1 * s);
    }
}
__device__ void phase_qscale(const Params& p) {
    bf16_t* Qb = (bf16_t*)(p.ws + OFF_BIG + B_Q);
    const size_t total = (size_t)T * 1024;
    const float sc = 0.08838834764831845f;
    for (size_t i = (size_t)obid() * 512 + otid(); i < total; i += (size_t)gridDim.x * 512) Qb[i] = f2bf(bf2f(Qb[i]) * sc);
}

__device__ void phase_kmean(const Params& p) {
    const bf16_t* Kb = (const bf16_t*)(p.ws + OFF_BIG + B_K); float* km = (float*)(p.ws + OFF_KMEAN);
    for (int i = obid() * 512 + otid(); i < 2 * 32 * 1024; i += gridDim.x * 512) {
        const int col = i & 1023, n = (i >> 10) & 31, b = i >> 15, h = col >> 7, d = col & 127;
        const bf16_t* pk = Kb + ((size_t)b * SEQ + n * 256) * 1024 + col;
        float s = 0.f;
        for (int j = 0; j < 256; ++j) s += bf2f(pk[(size_t)j * 1024]);
        km[(((size_t)b * 8 + h) * 32 + n) * 128 + d] = s * (1.0f / 256.0f);
    }
}

__device__ void phase_moba_naive(const Params& p, float* sm) {
    const bf16_t* Kb = (const bf16_t*)(p.ws + OFF_BIG + B_K); const bf16_t* Vb = (const bf16_t*)(p.ws + OFF_BIG + B_VB); const bf16_t* Qb = (const bf16_t*)(p.ws + OFF_BIG + B_Q);
    const float* kmean = (const float*)(p.ws + OFF_KMEAN); bf16_t* AO = (bf16_t*)(p.ws + OFF_BIG + B_AO);
    const int wave = otid() >> 6, lane = otid() & 63;
    float* qs = sm + wave * 128;
    for (int item = obid() * 8 + wave; item < T * 8; item += gridDim.x * 8) {
        const int tg = item >> 3, h = item & 7, b = tg >> 13, s = tg & 8191, blk = s >> 8;
        const unsigned qq = *(const unsigned*)(Qb + (size_t)tg * 1024 + h * 128 + lane * 2);
        qs[lane * 2] = bflo(qq); qs[lane * 2 + 1] = bfhi(qq);
        __builtin_amdgcn_wave_barrier();
        float g = -INFINITY;
        if (lane < blk) { const float* km = kmean + (((size_t)b * 8 + h) * 32 + lane) * 128; float a = 0.f; for (int d = 0; d < 128; ++d) a += qs[d] * km[d]; g = a; }
        const int nsel = blk < 3 ? blk : 3;
        int sel[3];
#pragma unroll
        for (int j = 0; j < 3; ++j) {
            sel[j] = 0;
            if (j < nsel) { const float m = wmax(g); const unsigned long long bal = __ballot(g == m); const int idx = __ffsll((long long)bal) - 1; sel[j] = idx; if (lane == idx) g = -INFINITY; }
        }
        float sc[4][4];
#pragma unroll
        for (int seg = 0; seg < 4; ++seg) {
            const int bid = seg < 3 ? sel[seg] : blk; const bool valid = seg < 3 ? (seg < nsel) : true; const int nkeys = seg < 3 ? 256 : (s - blk * 256 + 1);
#pragma unroll
            for (int kk = 0; kk < 4; ++kk) {
                const int key = kk * 64 + lane; float v = -INFINITY;
                if (valid && key < nkeys) {
                    const bf16_t* kr = Kb + ((size_t)b * SEQ + bid * 256 + key) * 1024 + h * 128; float a = 0.f;
#pragma unroll 4
                    for (int d8 = 0; d8 < 16; ++d8) { const uint4 u = *(const uint4*)(kr + d8 * 8); const float* q8 = qs + d8 * 8;
                        a += q8[0] * bflo(u.x) + q8[1] * bfhi(u.x) + q8[2] * bflo(u.y) + q8[3] * bfhi(u.y) + q8[4] * bflo(u.z) + q8[5] * bfhi(u.z) + q8[6] * bflo(u.w) + q8[7] * bfhi(u.w); }
                    v = a;
                }
                sc[seg][kk] = v;
            }
        }
        float m = -INFINITY;
#pragma unroll
        for (int seg = 0; seg < 4; ++seg)
#pragma unroll
            for (int kk = 0; kk < 4; ++kk) m = fmaxf(m, sc[seg][kk]);
        m = wmax(m);
        float l = 0.f;
#pragma unroll
        for (int seg = 0; seg < 4; ++seg)
#pragma unroll
            for (int kk = 0; kk < 4; ++kk) { const float e = expf(sc[seg][kk] - m); sc[seg][kk] = e; l += e; }
        l = wsum(l);
        float o0 = 0.f, o1 = 0.f;
#pragma unroll
        for (int seg = 0; seg < 4; ++seg) {
            const int bid = seg < 3 ? sel[seg] : blk; const bool valid = seg < 3 ? (seg < nsel) : true; const int nkeys = seg < 3 ? 256 : (s - blk * 256 + 1);
            if (valid) {
#pragma unroll
                for (int kk = 0; kk < 4; ++kk) {
                    if (kk * 64 < nkeys) {
                        const bf16_t* vr = Vb + ((size_t)b * SEQ + bid * 256 + kk * 64) * 1024 + h * 128 + lane * 2;
                        for (int src = 0; src < 64; ++src) { const float pp = __shfl(sc[seg][kk], src); const unsigned vv = *(const unsigned*)(vr + (size_t)src * 1024); o0 += pp * bflo(vv); o1 += pp * bfhi(vv); }
                    }
                }
            }
        }
        const float il = 1.0f / l;
        *(unsigned*)(AO + (size_t)tg * 1024 + h * 128 + lane * 2) = pack2(o0 * il, o1 * il);
        __builtin_amdgcn_wave_barrier();
    }
}

typedef short bf16x8_t __attribute__((ext_vector_type(8)));
typedef short s16x4_t __attribute__((ext_vector_type(4)));
constexpr int QCAP = 8192;
constexpr size_t X_QLIST = 0, X_ML = 16 * MiB;
constexpr int CT_QCNT = 64;

__device__ void phase_kmean2(const Params& p) {
    const bf16_t* Kb = (const bf16_t*)(p.ws + OFF_BIG + B_K); bf16_t* kh = (bf16_t*)(p.ws + OFF_KMEAN); bf16_t* kl = kh + 2 * 8 * 32 * 128;
    for (int i = obid() * 512 + otid(); i < 2 * 32 * 1024; i += gridDim.x * 512) {
        const int col = i & 1023, n = (i >> 10) & 31, b = i >> 15, h = col >> 7, d = col & 127;
        const bf16_t* pk = Kb + ((size_t)b * SEQ + n * 256) * 1024 + col;
        float s = 0.f;
#pragma unroll 8
        for (int j = 0; j < 256; ++j) s += bf2f(pk[(size_t)j * 1024]);
        s *= (1.0f / 256.0f);
        const bf16_t hi = f2bf(s); const size_t o = (((size_t)b * 8 + h) * 32 + n) * 128 + d;
        kh[o] = hi; kl[o] = f2bf(s - bf2f(hi));
    }
}

__device__ void phase_moba_gate(const Params& p, unsigned char* lds) {
    const int tid = otid(), wave = tid >> 6, lane = tid & 63, g = lane >> 4, i = lane & 15;
    LAS int* lcnt = (LAS int*)(LAS unsigned char*)lds; LAS int* lbase = lcnt + 32; LAS unsigned* lsel = (LAS unsigned*)(lcnt + 64);
    const bf16_t* Qb = (const bf16_t*)(p.ws + OFF_BIG + B_Q); const bf16_t* kh = (const bf16_t*)(p.ws + OFF_KMEAN); const bf16_t* kl = kh + 2 * 8 * 32 * 128;
    int* qcnt = (int*)(p.ws + OFF_CTRL) + CT_QCNT; unsigned* qlist = (unsigned*)(p.ws + OFF_XN + X_QLIST);
    for (int unit = obid(); unit < 256; unit += gridDim.x) {
        const int b = unit >> 7, h = (unit >> 4) & 7, s0 = (unit & 15) * 512;
        if (tid < 32) lcnt[tid] = 0;
        __syncthreads();
        bf16x8_t ah[2][4], al[2][4];
#pragma unroll
        for (int nt = 0; nt < 2; ++nt)
#pragma unroll
            for (int ks = 0; ks < 4; ++ks) { const size_t o = (((size_t)b * 8 + h) * 32 + nt * 16 + i) * 128 + ks * 32 + 8 * g; ah[nt][ks] = *(const bf16x8_t*)(kh + o); al[nt][ks] = *(const bf16x8_t*)(kl + o); }
#pragma unroll 1
        for (int it = 0; it < 4; ++it) {
            const int tl = wave * 64 + it * 16 + i, s = s0 + tl, tg = b * SEQ + s, blk = s >> 8;
            v4f acc[2] = {{0.f, 0.f, 0.f, 0.f}, {0.f, 0.f, 0.f, 0.f}};
#pragma unroll
            for (int ks = 0; ks < 4; ++ks) { const bf16x8_t bq = *(const bf16x8_t*)(Qb + (size_t)tg * 1024 + h * 128 + ks * 32 + 8 * g);
#pragma unroll
                for (int nt = 0; nt < 2; ++nt) { acc[nt] = __builtin_amdgcn_mfma_f32_16x16x32_bf16(ah[nt][ks], bq, acc[nt], 0, 0, 0); acc[nt] = __builtin_amdgcn_mfma_f32_16x16x32_bf16(al[nt][ks], bq, acc[nt], 0, 0, 0); } }
            float gv[8];
#pragma unroll
            for (int q = 0; q < 8; ++q) { const int n = (q >> 2) * 16 + 4 * g + (q & 3); gv[q] = n < blk ? acc[q >> 2][q & 3] : -INFINITY; }
            const int nsel = blk < 3 ? blk : 3;
#pragma unroll
            for (int j = 0; j < 3; ++j) {
                float bm = -INFINITY; int bn = 64;
#pragma unroll
                for (int q = 0; q < 8; ++q) { const int n = (q >> 2) * 16 + 4 * g + (q & 3); if (gv[q] > bm) { bm = gv[q]; bn = n; } }
#pragma unroll
                for (int off = 16; off <= 32; off <<= 1) { const float om = __shfl_xor(bm, off); const int on = __shfl_xor(bn, off); if (om > bm || (om == bm && on < bn)) { bm = om; bn = on; } }
#pragma unroll
                for (int q = 0; q < 8; ++q) { const int n = (q >> 2) * 16 + 4 * g + (q & 3); if (n == bn) gv[q] = -INFINITY; }
                if (g == 0 && j < nsel) { const int off = atomicAdd((int*)&lcnt[bn], 1); lsel[tl * 3 + j] = (unsigned)bn | ((unsigned)off << 8); }
            }
        }
        __syncthreads();
        if (tid < 32) { const int c = lcnt[tid]; lbase[tid] = c ? atomicAdd(qcnt + (b * 8 + h) * 32 + tid, c) : 0; }
        __syncthreads();
        { const int s = s0 + tid, blk = s >> 8, nsel = blk < 3 ? blk : 3;
            for (int j = 0; j < nsel; ++j) { const unsigned e = lsel[tid * 3 + j]; const int sel = e & 255, off = e >> 8;
                qlist[((size_t)(b * 8 + h) * 32 + sel) * QCAP + lbase[sel] + off] = (unsigned)(b * SEQ + s) | ((unsigned)j << 16); } }
        __syncthreads();
    }
}

__device__ __forceinline__ void moba_stage_kv(const bf16_t* Kb, const bf16_t* Vb, int b, int h, int n, LAS unsigned char* Ks, LAS unsigned char* Vs, int tid) {
    const size_t rowbase = ((size_t)b * SEQ + n * 256) * 1024 + h * 128;
#pragma unroll
    for (int it = 0; it < 8; ++it) { const int idx = it * 512 + tid, row = idx >> 4, ch = idx & 15;
        const v4u kv = *(const v4u*)(Kb + rowbase + (size_t)row * 1024 + ch * 8), vv = *(const v4u*)(Vb + rowbase + (size_t)row * 1024 + ch * 8);
        *(LAS v4u*)(Ks + row * 256 + ((ch ^ (row & 15)) << 4)) = kv; *(LAS v4u*)(Vs + row * 256 + ((ch ^ ((row & 7) << 1)) << 4)) = vv; }
}

__device__ __forceinline__ void moba_wave_attn(const bf16_t* qrow, LAS unsigned char* Ks, LAS unsigned char* Vs, int g, int i, bool own, int t_local, int nkt, v4f (&o)[8], float& m_out, float& l_out) {
    bf16x8_t bq[4];
#pragma unroll
    for (int ks = 0; ks < 4; ++ks) bq[ks] = *(const bf16x8_t*)(qrow + ks * 32 + 8 * g);
    v4f st[16];
#pragma unroll
    for (int kt = 0; kt < 16; ++kt) {
        st[kt] = (v4f){0.f, 0.f, 0.f, 0.f};
        if (kt < nkt) {
            const int row = kt * 16 + i;
#pragma unroll
            for (int ks = 0; ks < 4; ++ks) { const bf16x8_t a = *(const LAS bf16x8_t*)(Ks + row * 256 + (((ks * 4 + g) ^ (row & 15)) << 4)); st[kt] = __builtin_amdgcn_mfma_f32_16x16x32_bf16(a, bq[ks], st[kt], 0, 0, 0); }
        }
    }
    float m = -INFINITY;
#pragma unroll
    for (int kt = 0; kt < 16; ++kt)
#pragma unroll
        for (int r = 0; r < 4; ++r) { const int key = kt * 16 + 4 * g + r; const bool ok = (kt < nkt) && (!own || key <= t_local); st[kt][r] = ok ? st[kt][r] : -INFINITY; m = fmaxf(m, st[kt][r]); }
    m = fmaxf(m, __shfl_xor(m, 16)); m = fmaxf(m, __shfl_xor(m, 32));
    float l = 0.f;
#pragma unroll
    for (int kt = 0; kt < 16; ++kt)
#pragma unroll
        for (int r = 0; r < 4; ++r) { const float e = __expf(st[kt][r] - m); st[kt][r] = e; l += e; }
    l += __shfl_xor(l, 16); l += __shfl_xor(l, 32);
#pragma unroll
    for (int dt = 0; dt < 8; ++dt) o[dt] = (v4f){0.f, 0.f, 0.f, 0.f};
    const int q = i >> 2, pp = i & 3;
#pragma unroll
    for (int k2 = 0; k2 < 8; ++k2) {
        if (2 * k2 < nkt) {
            union { bf16x8_t v; unsigned u[4]; } pb;
            pb.u[0] = pg8::cvt_pk_bf16(st[2 * k2][0], st[2 * k2][1]); pb.u[1] = pg8::cvt_pk_bf16(st[2 * k2][2], st[2 * k2][3]);
            pb.u[2] = pg8::cvt_pk_bf16(st[2 * k2 + 1][0], st[2 * k2 + 1][1]); pb.u[3] = pg8::cvt_pk_bf16(st[2 * k2 + 1][2], st[2 * k2 + 1][3]);
            const int r0 = (2 * k2) * 16 + 4 * g + q, r1 = r0 + 16;
#pragma unroll
            for (int dt = 0; dt < 8; ++dt) {
                const int ch = dt * 2 + (pp >> 1);
                const s16x4_t a0 = __builtin_amdgcn_ds_read_tr16_b64_v4i16((LAS s16x4_t*)(Vs + r0 * 256 + ((ch ^ ((r0 & 7) << 1)) << 4) + (pp & 1) * 8));
                const s16x4_t a1 = __builtin_amdgcn_ds_read_tr16_b64_v4i16((LAS s16x4_t*)(Vs + r1 * 256 + ((ch ^ ((r1 & 7) << 1)) << 4) + (pp & 1) * 8));
                const bf16x8_t a = {a0[0], a0[1], a0[2], a0[3], a1[0], a1[1], a1[2], a1[3]};
                o[dt] = __builtin_amdgcn_mfma_f32_16x16x32_bf16(a, pb.v, o[dt], 0, 0, 0);
            }
        }
    }
    m_out = m; l_out = l;
}

__device__ void phase_moba_sel(const Params& p, unsigned char* lds) {
    const int tid = otid(), wave = __builtin_amdgcn_readfirstlane(tid >> 6), lane = tid & 63, g = lane >> 4, i = lane & 15;
    LAS unsigned char* Ks = (LAS unsigned char*)lds; LAS unsigned char* Vs = Ks + 65536; LAS int* pre = (LAS int*)(Ks + 131072);
    const bf16_t* Kb = (const bf16_t*)(p.ws + OFF_BIG + B_K); const bf16_t* Vb = (const bf16_t*)(p.ws + OFF_BIG + B_VB); const bf16_t* Qb = (const bf16_t*)(p.ws + OFF_BIG + B_Q);
    bf16_t* PART = (bf16_t*)(p.ws + OFF_BIG + B_PART); float* ML = (float*)(p.ws + OFF_XN + X_ML);
    const int* qcnt = (const int*)(p.ws + OFF_CTRL) + CT_QCNT; const unsigned* qlist = (const unsigned*)(p.ws + OFF_XN + X_QLIST);
    __syncthreads();
    pre[516 + tid] = qcnt[tid];
    __syncthreads();
    if (tid == 0) { int s = 0; for (int l = 0; l < 512; ++l) { pre[l] = s; s += (pre[516 + l] + 127) >> 7; } pre[512] = s; }
    __syncthreads();
    const int NT = pre[512], G = (int)gridDim.x, c = obid();
    const int t_begin = (int)(((long)NT * c) / G), t_end = (int)(((long)NT * (c + 1)) / G);
    int li = 0, cur = -1;
    for (int tile = t_begin; tile < t_end; ++tile) {
        while (tile >= pre[li + 1]) ++li;
        const int b = li >> 8, h = (li >> 5) & 7, n = li & 31;
        if (li != cur) { __syncthreads(); moba_stage_kv(Kb, Vb, b, h, n, Ks, Vs, tid); __syncthreads(); cur = li; }
        const int cnt = pre[516 + li], row = (tile - pre[li]) * 128 + wave * 16 + i; const bool valid = row < cnt;
        const unsigned e = qlist[(size_t)li * QCAP + (valid ? row : 0)]; const int tg = e & 0xffff, j = e >> 16;
        v4f o[8]; float m, l;
        moba_wave_attn(Qb + (size_t)tg * 1024 + h * 128, Ks, Vs, g, i, false, 0, 16, o, m, l);
        if (valid) {
            bf16_t* po = PART + ((size_t)(tg * 8 + h) * 3 + j) * 128 + 4 * g;
#pragma unroll
            for (int dt = 0; dt < 8; ++dt) *(uint2*)(po + dt * 16) = make_uint2(pg8::cvt_pk_bf16(o[dt][0], o[dt][1]), pg8::cvt_pk_bf16(o[dt][2], o[dt][3]));
            if (g == 0) *(float2*)(ML + ((size_t)(tg * 8 + h) * 3 + j) * 2) = make_float2(m, l);
        }
    }
}

__device__ void phase_moba_own(const Params& p, unsigned char* lds) {
    const int tid = otid(), wave = __builtin_amdgcn_readfirstlane(tid >> 6), lane = tid & 63, g = lane >> 4, i = lane & 15;
    LAS unsigned char* Ks = (LAS unsigned char*)lds; LAS unsigned char* Vs = Ks + 65536;
    const bf16_t* Kb = (const bf16_t*)(p.ws + OFF_BIG + B_K); const bf16_t* Vb = (const bf16_t*)(p.ws + OFF_BIG + B_VB); const bf16_t* Qb = (const bf16_t*)(p.ws + OFF_BIG + B_Q);
    const bf16_t* PART = (const bf16_t*)(p.ws + OFF_BIG + B_PART); const float* ML = (const float*)(p.ws + OFF_XN + X_ML); bf16_t* AO = (bf16_t*)(p.ws + OFF_BIG + B_AO);
    for (int unit = obid(); unit < 512; unit += gridDim.x) {
        const int b = unit >> 8, h = (unit >> 5) & 7, blk = unit & 31, nsel = blk < 3 ? blk : 3;
        __syncthreads(); moba_stage_kv(Kb, Vb, b, h, blk, Ks, Vs, tid); __syncthreads();
#pragma unroll 1
        for (int tile = 0; tile < 2; ++tile) {
            const int t_local = tile * 128 + wave * 16 + i, tg = b * SEQ + blk * 256 + t_local, nkt = tile * 8 + wave + 1;
            v4f o[8]; float m, l;
            moba_wave_attn(Qb + (size_t)tg * 1024 + h * 128, Ks, Vs, g, i, true, t_local, nkt, o, m, l);
            float mj[3], lj[3], M = m;
#pragma unroll
            for (int j = 0; j < 3; ++j) { mj[j] = -INFINITY; lj[j] = 0.f; if (j < nsel) { const float2 v = *(const float2*)(ML + ((size_t)(tg * 8 + h) * 3 + j) * 2); mj[j] = v.x; lj[j] = v.y; } M = fmaxf(M, mj[j]); }
            const float w0 = __expf(m - M); float den = l * w0; float wj[3];
#pragma unroll
            for (int j = 0; j < 3; ++j) { wj[j] = (j < nsel) ? __expf(mj[j] - M) : 0.f; den += lj[j] * wj[j]; }
            const float inv = 1.0f / den;
#pragma unroll
            for (int dt = 0; dt < 8; ++dt) {
                v4f acc = o[dt] * w0;
#pragma unroll
                for (int j = 0; j < 3; ++j) if (j < nsel) { const uint2 u = *(const uint2*)(PART + ((size_t)(tg * 8 + h) * 3 + j) * 128 + dt * 16 + 4 * g);
                    acc[0] += bflo(u.x) * wj[j]; acc[1] += bfhi(u.x) * wj[j]; acc[2] += bflo(u.y) * wj[j]; acc[3] += bfhi(u.y) * wj[j]; }
                acc = acc * inv;
                *(uint2*)(AO + (size_t)tg * 1024 + h * 128 + dt * 16 + 4 * g) = make_uint2(pg8::cvt_pk_bf16(acc[0], acc[1]), pg8::cvt_pk_bf16(acc[2], acc[3]));
            }
        }
    }
}

constexpr int RL = 512;
constexpr size_t ST_SLOT = (size_t)512 * 256;
__device__ __forceinline__ float ret_lg(int h) { return log2f(1.f - exp2f(-5.f - (float)h)); }

__device__ void phase_ret_kv(const Params& p, unsigned char* lds) {
    const int tid = otid(), wave = __builtin_amdgcn_readfirstlane(tid >> 6), lane = tid & 63, g = lane >> 4, i = lane & 15, q = i >> 2, pp = i & 3;
    const int we = wave >> 2, wd = wave & 3;
    LAS unsigned char* Ks = (LAS unsigned char*)lds;
    const bf16_t* QK = (const bf16_t*)(p.ws + OFF_BIG + B_QK); const bf16_t* Vt = (const bf16_t*)(p.ws + OFF_BIG + B_V); bf16_t* ST = (bf16_t*)(p.ws + OFF_BIG + B_ST);
    for (int unit = obid(); unit < 240; unit += gridDim.x) {
        const int eh = unit & 1, s = (unit >> 1) % 15, bh = (unit >> 1) / 15, b = bh >> 2, h = bh & 3;
        const float lg = ret_lg(h);
        v4f acc[4][8];
#pragma unroll
        for (int m = 0; m < 4; ++m)
#pragma unroll
            for (int n = 0; n < 8; ++n) acc[m][n] = (v4f){0.f, 0.f, 0.f, 0.f};
        const bf16_t* krow = QK + ((size_t)b * SEQ + s * RL) * 2048 + 1024 + h * 256;
        const bf16_t* vrow = Vt + (size_t)(h * 512 + eh * 256 + we * 128 + i) * 16384 + (size_t)b * SEQ + s * RL + 8 * g;
#pragma unroll 1
        for (int st = 0; st < 8; ++st) {
            __syncthreads();
#pragma unroll
            for (int it = 0; it < 4; ++it) { const int idx = it * 512 + tid, row = idx >> 5, ch = idx & 31;
                const v4u kv = *(const v4u*)(krow + (size_t)(st * 64 + row) * 2048 + ch * 8);
                const float w = exp2f((float)(RL - 1 - (st * 64 + row)) * lg);
                v4u o; o.x = pg8::cvt_pk_bf16(bflo(kv.x) * w, bfhi(kv.x) * w); o.y = pg8::cvt_pk_bf16(bflo(kv.y) * w, bfhi(kv.y) * w); o.z = pg8::cvt_pk_bf16(bflo(kv.z) * w, bfhi(kv.z) * w); o.w = pg8::cvt_pk_bf16(bflo(kv.w) * w, bfhi(kv.w) * w);
                const int f = ((row & 3) | ((row >> 1) & 4)) << 1;
                *(LAS v4u*)(Ks + row * 512 + ((ch ^ f) << 4)) = o; }
            __syncthreads();
#pragma unroll
            for (int kk = 0; kk < 2; ++kk) {
                bf16x8_t af[4];
#pragma unroll
                for (int m = 0; m < 4; ++m) {
                    const int r0 = kk * 32 + 8 * g + q, r1 = r0 + 4, ch = (wd * 64 + m * 16) / 8 + (pp >> 1);
                    const int f0 = ((r0 & 3) | ((r0 >> 1) & 4)) << 1, f1 = ((r1 & 3) | ((r1 >> 1) & 4)) << 1;
                    const s16x4_t a0 = __builtin_amdgcn_ds_read_tr16_b64_v4i16((LAS s16x4_t*)(Ks + r0 * 512 + ((ch ^ f0) << 4) + (pp & 1) * 8));
                    const s16x4_t a1 = __builtin_amdgcn_ds_read_tr16_b64_v4i16((LAS s16x4_t*)(Ks + r1 * 512 + ((ch ^ f1) << 4) + (pp & 1) * 8));
                    af[m] = (bf16x8_t){a0[0], a0[1], a0[2], a0[3], a1[0], a1[1], a1[2], a1[3]};
                }
#pragma unroll
                for (int nh = 0; nh < 2; ++nh) { bf16x8_t bf[4];
#pragma unroll
                    for (int n = 0; n < 4; ++n) bf[n] = *(const bf16x8_t*)(vrow + (size_t)(16 * (nh * 4 + n)) * 16384 + st * 64 + kk * 32);
#pragma unroll
                    for (int m = 0; m < 4; ++m)
#pragma unroll
                        for (int n = 0; n < 4; ++n) acc[m][nh * 4 + n] = __builtin_amdgcn_mfma_f32_16x16x32_bf16(af[m], bf[n], acc[m][nh * 4 + n], 0, 0, 0); }
            }
        }
        bf16_t* out = ST + ((size_t)bh * 15 + s) * ST_SLOT;
#pragma unroll
        for (int m = 0; m < 4; ++m)
#pragma unroll
            for (int n = 0; n < 8; ++n) { const int e = eh * 256 + we * 128 + n * 16 + i, d = wd * 64 + m * 16 + 4 * g;
                *(uint2*)(out + (size_t)e * 256 + d) = make_uint2(pg8::cvt_pk_bf16(acc[m][n][0], acc[m][n][1]), pg8::cvt_pk_bf16(acc[m][n][2], acc[m][n][3])); }
    }
}

__device__ void phase_ret_scan2(const Params& p) {
    bf16_t* ST = (bf16_t*)(p.ws + OFF_BIG + B_ST);
    for (int gid = obid() * 512 + otid(); gid < 8 * 16384; gid += gridDim.x * 512) {
        const int bh = gid >> 14, h = bh & 3; const size_t off = (size_t)(gid & 16383) * 8;
        const float cd = exp2f((float)RL * ret_lg(h));
        float S[8];
#pragma unroll
        for (int k = 0; k < 8; ++k) S[k] = 0.f;
        bf16_t* base = ST + (size_t)bh * 15 * ST_SLOT + off;
#pragma unroll 1
        for (int s = 0; s < 15; ++s) {
            const v4u u = *(const v4u*)(base + s * ST_SLOT);
            S[0] = S[0] * cd + bflo(u.x); S[1] = S[1] * cd + bfhi(u.x); S[2] = S[2] * cd + bflo(u.y); S[3] = S[3] * cd + bfhi(u.y);
            S[4] = S[4] * cd + bflo(u.z); S[5] = S[5] * cd + bfhi(u.z); S[6] = S[6] * cd + bflo(u.w); S[7] = S[7] * cd + bfhi(u.w);
            v4u o; o.x = pg8::cvt_pk_bf16(S[0], S[1]); o.y = pg8::cvt_pk_bf16(S[2], S[3]); o.z = pg8::cvt_pk_bf16(S[4], S[5]); o.w = pg8::cvt_pk_bf16(S[6], S[7]);
            *(v4u*)(base + s * ST_SLOT) = o;
        }
    }
}

__device__ void phase_ret_out(const Params& p, unsigned char* lds) {
    const int tid = otid(), wave = __builtin_amdgcn_readfirstlane(tid >> 6), lane = tid & 63, g = lane >> 4, i = lane & 15;
    LAS unsigned char* Ks = (LAS unsigned char*)lds;
    LAS unsigned char* Ps = Ks + 65536;
    LAS float* red = (LAS float*)(Ks + 98304);
    const bf16_t* QK = (const bf16_t*)(p.ws + OFF_BIG + B_QK); const bf16_t* Vt = (const bf16_t*)(p.ws + OFF_BIG + B_V); const bf16_t* ST = (const bf16_t*)(p.ws + OFF_BIG + B_ST);
    bf16_t* O = (bf16_t*)(p.ws + OFF_BIG + B_O);
    for (int unit = obid(); unit < 256; unit += gridDim.x) {
        const int pi = unit & 1, s = (unit >> 1) & 15, bh = unit >> 5, b = bh >> 2, h = bh & 3;
        const float lg = ret_lg(h);
#pragma unroll 1
        for (int half = 0; half < 2; ++half) {
            const int a = half ? 3 - pi : pi;
            const size_t trow0 = (size_t)b * SEQ + s * RL + a * 128;
            v4f o[4][8];
#pragma unroll
            for (int mt = 0; mt < 4; ++mt)
#pragma unroll
                for (int nt = 0; nt < 8; ++nt) o[mt][nt] = (v4f){0.f, 0.f, 0.f, 0.f};
            if (s > 0) {
                const bf16_t* sp = ST + ((size_t)bh * 15 + (s - 1)) * ST_SLOT + (size_t)(wave * 64 + i) * 256 + 8 * g;
                const bf16_t* qp = QK + (trow0 + i) * 2048 + h * 256 + 8 * g;
#pragma unroll 1
                for (int ks = 0; ks < 8; ++ks) {
                    bf16x8_t af[4];
#pragma unroll
                    for (int mt = 0; mt < 4; ++mt) af[mt] = *(const bf16x8_t*)(sp + (size_t)(16 * mt) * 256 + ks * 32);
#pragma unroll
                    for (int nh = 0; nh < 2; ++nh) { bf16x8_t bfq[4];
#pragma unroll
                        for (int nt = 0; nt < 4; ++nt) bfq[nt] = *(const bf16x8_t*)(qp + (size_t)(16 * (nh * 4 + nt)) * 2048 + ks * 32);
#pragma unroll
                        for (int mt = 0; mt < 4; ++mt)
#pragma unroll
                            for (int nt = 0; nt < 4; ++nt) o[mt][nh * 4 + nt] = __builtin_amdgcn_mfma_f32_16x16x32_bf16(af[mt], bfq[nt], o[mt][nh * 4 + nt], 0, 0, 0); }
                }
#pragma unroll
                for (int nt = 0; nt < 8; ++nt) { const float sc = exp2f((float)(a * 128 + nt * 16 + i + 1) * lg);
#pragma unroll
                    for (int mt = 0; mt < 4; ++mt) o[mt][nt] = o[mt][nt] * sc; }
            }
#pragma unroll 1
            for (int j = 0; j <= a; ++j) {
                __syncthreads();
                { const bf16_t* krow = QK + ((size_t)b * SEQ + s * RL + j * 128) * 2048 + 1024 + h * 256;
#pragma unroll
                    for (int it = 0; it < 8; ++it) { const int idx = it * 512 + tid, row = idx >> 5, ch = idx & 31;
                        *(LAS v4u*)(Ks + row * 512 + ((ch ^ (row & 15)) << 4)) = *(const v4u*)(krow + (size_t)row * 2048 + ch * 8); } }
                __syncthreads();
                {
                    const bf16_t* qp = QK + (trow0 + wave * 16 + i) * 2048 + h * 256 + 8 * g;
                    const int prow = wave * 16 + i, tq = a * 128 + prow;
#pragma unroll 1
                    for (int kh = 0; kh < 2; ++kh) {
                        v4f st[4];
#pragma unroll
                        for (int kt = 0; kt < 4; ++kt) st[kt] = (v4f){0.f, 0.f, 0.f, 0.f};
#pragma unroll 2
                        for (int ks = 0; ks < 8; ++ks) { const bf16x8_t bq = *(const bf16x8_t*)(qp + ks * 32);
#pragma unroll
                            for (int kt = 0; kt < 4; ++kt) { const int row = (kh * 4 + kt) * 16 + i; const bf16x8_t ak = *(const LAS bf16x8_t*)(Ks + row * 512 + (((ks * 4 + g) ^ (row & 15)) << 4));
                                st[kt] = __builtin_amdgcn_mfma_f32_16x16x32_bf16(ak, bq, st[kt], 0, 0, 0); } }
#pragma unroll
                        for (int kt = 0; kt < 4; ++kt) { float v[4]; const int ktt = kh * 4 + kt;
#pragma unroll
                            for (int r = 0; r < 4; ++r) { const int dist = tq - (j * 128 + ktt * 16 + 4 * g + r); v[r] = dist >= 0 ? st[kt][r] * exp2f((float)dist * lg) : 0.f; }
                            const int ch = 2 * ktt + (g >> 1);
                            pg8::u32x2 pw; pw.x = pg8::cvt_pk_bf16(v[0], v[1]); pw.y = pg8::cvt_pk_bf16(v[2], v[3]); *(LAS pg8::u32x2*)(Ps + prow * 256 + ((ch ^ (prow & 15)) << 4) + (g & 1) * 8) = pw; }
                    }
                }
                __syncthreads();
                const bf16_t* vp = Vt + (size_t)(h * 512 + wave * 64 + i) * 16384 + (size_t)b * SEQ + s * RL + j * 128 + 8 * g;
#pragma unroll 1
                for (int ks = 0; ks < 4; ++ks) {
                    bf16x8_t af[4];
#pragma unroll
                    for (int mt = 0; mt < 4; ++mt) af[mt] = *(const bf16x8_t*)(vp + (size_t)(16 * mt) * 16384 + ks * 32);
#pragma unroll
                    for (int nh = 0; nh < 2; ++nh) { bf16x8_t bp[4];
#pragma unroll
                        for (int nt = 0; nt < 4; ++nt) { const int row = (nh * 4 + nt) * 16 + i; bp[nt] = *(const LAS bf16x8_t*)(Ps + row * 256 + (((ks * 4 + g) ^ (row & 15)) << 4)); }
#pragma unroll
                        for (int mt = 0; mt < 4; ++mt)
#pragma unroll
                            for (int nt = 0; nt < 4; ++nt) o[mt][nh * 4 + nt] = __builtin_amdgcn_mfma_f32_16x16x32_bf16(af[mt], bp[nt], o[mt][nh * 4 + nt], 0, 0, 0); }
                }
            }
            float ssq[8];
#pragma unroll
            for (int nt = 0; nt < 8; ++nt) { float a2 = 0.f;
#pragma unroll
                for (int mt = 0; mt < 4; ++mt)
#pragma unroll
                    for (int r = 0; r < 4; ++r) a2 += o[mt][nt][r] * o[mt][nt][r];
                a2 += __shfl_xor(a2, 16); a2 += __shfl_xor(a2, 32); ssq[nt] = a2; }
            __syncthreads();
            if (g == 0) {
#pragma unroll
                for (int nt = 0; nt < 8; ++nt) red[wave * 128 + nt * 16 + i] = ssq[nt]; }
            __syncthreads();
#pragma unroll
            for (int nt = 0; nt < 8; ++nt) { float tot = 0.f;
#pragma unroll
                for (int w = 0; w < 8; ++w) tot += red[w * 128 + nt * 16 + i];
                const float rstd = 1.0f / sqrtf(tot * (1.0f / 512.0f) + 1e-6f);
                bf16_t* po = O + (trow0 + nt * 16 + i) * 2048 + h * 512 + wave * 64 + 4 * g;
#pragma unroll
                for (int mt = 0; mt < 4; ++mt) *(uint2*)(po + mt * 16) = make_uint2(pg8::cvt_pk_bf16(o[mt][nt][0] * rstd, o[mt][nt][1] * rstd), pg8::cvt_pk_bf16(o[mt][nt][2] * rstd, o[mt][nt][3] * rstd)); }
        }
    }
}

template <class Epi>
__device__ __forceinline__ void dense_gemm(unsigned char* lds, const bf16_t* A, const bf16_t* Bt, int N, int K, const Epi& E, int M = T) {
    pg8::Gemm g{A, Bt, M, N, K}; pg8::StaticOrder S; S.init(M, N, (int)gridDim.x, obid());
    pg8::gemm_phase<Epi, pg8::StaticOrder, true, true>((LAS unsigned char*)lds, g, S, E);
}

template <int STAGE>
__device__ __forceinline__ void expert_gemm(const Params& p, int L, unsigned char* lds) {
    Route R = get_route(p, L);
    LAS int* tab = (LAS int*)((LAS unsigned char*)lds + 131072);
    __syncthreads();
    if (otid() == 0) { int s = 0, b = 0; for (int e = 0; e < 16; ++e) { const int c = R.cnt[e]; tab[e] = s; tab[32 + e] = c; tab[48 + e] = b; s += ((c + 255) >> 8) * 4; b += (c + 255) & ~255; } tab[16] = s; }
    __syncthreads();
    const bf16_t* E = (const bf16_t*)(p.ws + OFF_BIG + B_E);
    bf16_t* HG = (bf16_t*)(p.ws + OFF_BIG + B_HG); bf16_t* YG = (bf16_t*)(p.ws + OFF_BIG + B_YG);
    if (STAGE == 1) {
        pg8::GroupedOrder<1> S{tab, (int)gridDim.x, obid(), R.list, (const char*)E};
        pg8::EpiExp1 Ep{HG, R.cwl, tab};
        pg8::gemm_phase_g<pg8::EpiExp1, pg8::GroupedOrder<1>, true>((LAS unsigned char*)lds, (const char*)(p.ws + OFF_XN), 1024, S, Ep);
    } else {
        pg8::GroupedOrder<2> S{tab, (int)gridDim.x, obid(), nullptr, (const char*)E + (2u << 20)};
        pg8::EpiExp2 Ep{YG};
        pg8::gemm_phase_g<pg8::EpiExp2, pg8::GroupedOrder<2>, true>((LAS unsigned char*)lds, (const char*)HG, 512, S, Ep);
    }
}

constexpr int NPHASE = 20;
__device__ __forceinline__ void run_phase(const Params& p, int ph, unsigned char* lds) {
    float* sm = (float*)lds;
    unsigned char* big = p.ws + OFF_BIG;
    const bf16_t* XN = (const bf16_t*)(p.ws + OFF_XN);
    const bf16_t* WB = (const bf16_t*)(p.ws + OFF_WB);
    switch (ph) {
    case 0: phase_prologue(p, lds); break;
    case 1: { pg8::EpiInproj E{(bf16_t*)(big + B_QK), (const float*)(p.ws + OFF_TABRET), (const float*)(p.ws + OFF_TABRET) + 8192 * 128};
        dense_gemm(lds, XN, WB + W_IN / 2, 2048, 1024, E);
        pg8::EpiVt E2{(bf16_t*)(big + B_V)};
        dense_gemm(lds, WB + W_IN / 2 + (size_t)2048 * 1024, XN, 16384, 1024, E2, 2048); } break;
    case 2: phase_ret_kv(p, lds); break;
    case 3: phase_ret_scan2(p); break;
    case 4: phase_ret_out(p, lds); break;
    case 5: { pg8::EpiG E{(bf16_t*)(big + B_O)}; dense_gemm(lds, XN, WB + W_IN / 2 + (size_t)4096 * 1024, 2048, 1024, E); } break;
    case 6: { pg8::EpiResid E{p.x, p.out}; dense_gemm(lds, (const bf16_t*)(big + B_O), WB + W_OUT / 2, 1024, 2048, E); } break;
    case 7: convert_expert_weights(p, 0, lds); __syncthreads(); norm_pass<1>(p, 0, lds); break;
    case 8: expert_gemm<1>(p, 0, lds); break;
    case 9: expert_gemm<2>(p, 0, lds); break;
    case 10: norm_pass<2>(p, 0, lds); break;
    case 11: { pg8::EpiKVQ E{(bf16_t*)(big + B_K), (bf16_t*)(big + B_VB), (bf16_t*)(big + B_Q), (const float*)(p.ws + OFF_TABROPE), (const float*)(p.ws + OFF_TABROPE) + 8192 * 16};
        dense_gemm(lds, XN, WB + W_KVQ / 2, 3072, 1024, E); } break;
    case 12: phase_kmean2(p); break;
    case 13: phase_moba_gate(p, lds); break;
    case 14: phase_moba_sel(p, lds); break;
    case 15: phase_moba_own(p, lds); break;
    case 16: { pg8::EpiResid E{p.out, p.out}; dense_gemm(lds, (const bf16_t*)(big + B_AO), WB + W_O / 2, 1024, 1024, E); } break;
    case 17: convert_expert_weights(p, 1, lds); __syncthreads(); norm_pass<1>(p, 1, lds); break;
    case 18: expert_gemm<1>(p, 1, lds); break;
    case 19: expert_gemm<2>(p, 1, lds); break;
    case 20: norm_pass<3>(p, 1, lds); break;
    default: break;
    }
}
constexpr int LAST_PHASE = 20;

#if MK_SINGLE
#define XB_TMO      128
#define XB_XCNT(j)  (256  + 64 * (j))
#define XB_XSUB(j)  (1280 + 64 * (j))
#define XB_XGEN(j)  (2304 + 64 * (j))
#define XB_TOP      3328
#define XB_TOPGEN   3392
#define XCD_BAR_WORDS 3456
#define XB_SPIN_CAP (1u << 18)

__device__ __forceinline__ unsigned xb_ld(unsigned* p)              { return __hip_atomic_load(p, __ATOMIC_RELAXED, __HIP_MEMORY_SCOPE_AGENT); }
__device__ __forceinline__ unsigned xb_add(unsigned* p, unsigned v) { return __hip_atomic_fetch_add(p, v, __ATOMIC_RELAXED, __HIP_MEMORY_SCOPE_AGENT); }
__device__ __forceinline__ unsigned xb_xcc_id() { return (unsigned)__builtin_amdgcn_s_getreg((3 << 11) | 20) & 0xFu; }
#define XB_SPIN(cond, bar) do { unsigned _sp = 0; while (cond) { __builtin_amdgcn_s_sleep(1); \
    if ((++_sp & 255u) == 0u) { if (xb_ld(&(bar)[XB_TMO])) break; if (_sp > XB_SPIN_CAP) { atomicAdd(&(bar)[XB_TMO], 1u); break; } } } } while (0)

struct XcdBarrier {
    unsigned* bar; unsigned x;
    volatile LAS unsigned* st;
};

__device__ __forceinline__ XcdBarrier xcd_barrier_post(unsigned* bar, volatile LAS unsigned* st) {
    XcdBarrier b; b.bar = bar; b.x = xb_xcc_id(); b.st = st;
    if (threadIdx.x == 0) (void)xb_add(&bar[XB_XCNT(b.x)], 1u);
    return b;
}
__device__ __forceinline__ void xcd_barrier_complete(unsigned* bar, unsigned x, unsigned& nloc, unsigned& nx) {
    const unsigned G = gridDim.x * gridDim.y * gridDim.z;
    unsigned sum, cnt, mine, sp = 0u;
    for (;;) {
        sum = 0u; cnt = 0u; mine = 0u;
#pragma unroll
        for (unsigned j = 0; j < 16; ++j) { const unsigned c = xb_ld(&bar[XB_XCNT(j)]); sum += c; cnt += (c > 0u) ? 1u : 0u; mine = (j == x) ? c : mine; }
        if (sum == G) break;
        __builtin_amdgcn_s_sleep(1);
        if ((++sp & 255u) == 0u) { if (xb_ld(&bar[XB_TMO])) break; if (sp > XB_SPIN_CAP) { atomicAdd(&bar[XB_TMO], 1u); break; } }
    }
    nloc = mine > 0u ? mine : 1u; nx = cnt > 0u ? cnt : 1u;
}

__device__ __forceinline__ void xcd_barrier(const XcdBarrier& b) {
    asm volatile("s_waitcnt vmcnt(0)" ::: "memory");
    __syncthreads();
    if (threadIdx.x == 0) {
        unsigned* bar = b.bar;
        __builtin_amdgcn_s_waitcnt(0);
        unsigned nloc = b.st[0], nx = b.st[1];
        if (nloc == 0u) { xcd_barrier_complete(bar, b.x, nloc, nx); b.st[0] = nloc; b.st[1] = nx; }
        const unsigned old = xb_add(&bar[XB_XSUB(b.x)], 1u);
        const unsigned gen = old / nloc;
        if (old + 1u == (gen + 1u) * nloc) {
            __builtin_amdgcn_fence(__ATOMIC_RELEASE, "agent");
            asm volatile("s_waitcnt vmcnt(0)" ::: "memory");
            const unsigned og = xb_add(&bar[XB_TOP], 1u);
            const unsigned tg = og / nx;
            if (og + 1u == (tg + 1u) * nx) xb_add(&bar[XB_TOPGEN], 1u);
            else XB_SPIN(xb_ld(&bar[XB_TOPGEN]) == tg, bar);
            __builtin_amdgcn_fence(__ATOMIC_ACQUIRE, "agent");
            xb_add(&bar[XB_XGEN(b.x)], 1u);
            asm volatile("s_waitcnt vmcnt(0)" ::: "memory");
        } else {
            XB_SPIN(xb_ld(&bar[XB_XGEN(b.x)]) == gen, bar);
            __builtin_amdgcn_fence(__ATOMIC_ACQUIRE, "agent");
            asm volatile("s_waitcnt vmcnt(0)" ::: "memory");
        }
    }
    __syncthreads();
}

constexpr size_t CTRL_BAR_OFF = 65536;
constexpr int PARAM_LDS_OFF = LDS_BYTES - 256;
constexpr int BARST_LDS_OFF = LDS_BYTES - 512;
__device__ __forceinline__ Params get_params(unsigned char* lds) {
    const LAS unsigned* w = (const LAS unsigned*)((LAS unsigned char*)lds + PARAM_LDS_OFF);
    union { Params p; unsigned u[sizeof(Params) / 4]; } x;
#pragma unroll
    for (int k = 0; k < (int)(sizeof(Params) / 4); ++k) x.u[k] = __builtin_amdgcn_readfirstlane(w[k]);
    return x.p;
}
template <int PH> __device__ __forceinline__ void run_all(unsigned char* lds, cg::grid_group& grid, const XcdBarrier& bar) {
#ifdef MK_REP_PHASE
    if constexpr (PH == MK_REP_PHASE) { for (int rep = 0; rep < MK_REP_N; ++rep) { const Params q0 = get_params(lds); run_phase(q0, PH, lds); xcd_barrier(bar); } }
#endif
    { const Params q = get_params(lds); run_phase(q, PH, lds); }
    if constexpr (PH < LAST_PHASE) {
        if constexpr (PH == 0) grid.sync(); else xcd_barrier(bar);
        run_all<PH + 1>(lds, grid, bar);
    }
}
__global__ void __launch_bounds__(512) mega(Params p) {
    extern __shared__ __attribute__((aligned(16))) unsigned char lds[];
    cg::grid_group grid = cg::this_grid();
    if (threadIdx.x == 0) { union { Params p; unsigned u[sizeof(Params) / 4]; } x; x.p = p; LAS unsigned* w = (LAS unsigned*)((LAS unsigned char*)lds + PARAM_LDS_OFF);
#pragma unroll
        for (int k = 0; k < (int)(sizeof(Params) / 4); ++k) w[k] = x.u[k];
        LAS unsigned* st = (LAS unsigned*)((LAS unsigned char*)lds + BARST_LDS_OFF); st[0] = 0u; st[1] = 0u; }
    __syncthreads();
    const XcdBarrier bar = xcd_barrier_post((unsigned*)(p.ws + OFF_CTRL + CTRL_BAR_OFF), (volatile LAS unsigned*)((LAS unsigned char*)lds + BARST_LDS_OFF));
    run_all<0>(lds, grid, bar);
}
#else
template <int PH> __global__ void __launch_bounds__(512) phase_kernel(Params p) {
    extern __shared__ __attribute__((aligned(16))) unsigned char lds[];
    run_phase(p, PH, lds);
}
template <int PH> static void launch_phases(const Params& p, int grid, hipStream_t stream) {
    if constexpr (PH <= LAST_PHASE) {
        static bool attr = false;
        if (!attr) { (void)hipFuncSetAttribute((const void*)phase_kernel<PH>, hipFuncAttributeMaxDynamicSharedMemorySize, LDS_BYTES); attr = true; }
        phase_kernel<PH><<<grid, 512, LDS_BYTES, stream>>>(p); launch_phases<PH + 1>(p, grid, stream); }
}
#endif

extern "C" void kernel_launch(void* const* d_in, const int* in_sizes, int n_in, void* d_out, int out_size, void* d_ws, size_t ws_size, hipStream_t stream) {
    if (ws_size < WS_NEED) { fprintf(stderr, "workspace too small: %zu < %zu\n", ws_size, WS_NEED); return; }
    Params p{};
    p.x = (const float*)d_in[0]; p.ret_norm = (const float*)d_in[1]; p.ret_w_in = (const float*)d_in[2]; p.ret_w_out = (const float*)d_in[3]; p.kv_norm = (const float*)d_in[4];
    p.w_kv = (const float*)d_in[5]; p.attn_norm = (const float*)d_in[6]; p.w_q = (const float*)d_in[7]; p.w_o = (const float*)d_in[8]; p.ffn_norm = (const float*)d_in[9];
    p.rg_w = (const float*)d_in[10]; p.rg_b = (const float*)d_in[11]; p.re_w = (const float*)d_in[12]; p.re_b = (const float*)d_in[13]; p.wg = (const float*)d_in[14];
    p.wu = (const float*)d_in[15]; p.wd = (const float*)d_in[16]; p.final_norm = (const float*)d_in[17];
    p.out = (float*)d_out; p.ws = (unsigned char*)d_ws;
    static int grid_blocks = 0;
    if (!grid_blocks) {
        int dev = 0, cus = 0, per_cu = 0;
        (void)hipGetDevice(&dev);
        (void)hipDeviceGetAttribute(&cus, hipDeviceAttributeMultiprocessorCount, dev);
#if MK_SINGLE
        if (hipFuncSetAttribute((const void*)mega, hipFuncAttributeMaxDynamicSharedMemorySize, LDS_BYTES) != hipSuccess) fprintf(stderr, "hipFuncSetAttribute failed\n");
        if (hipOccupancyMaxActiveBlocksPerMultiprocessor(&per_cu, (const void*)mega, 512, LDS_BYTES) != hipSuccess || per_cu < 1) fprintf(stderr, "occupancy query: %d blocks per CU\n", per_cu);
#endif
        grid_blocks = cus;
    }
#if MK_SINGLE
    if (hipMemsetAsync((unsigned char*)d_ws + OFF_CTRL, 0, 131072, stream) != hipSuccess) fprintf(stderr, "memset failed\n");
    void* args[] = {&p};
    hipError_t e = hipLaunchCooperativeKernel((void*)mega, dim3(grid_blocks), dim3(512), args, LDS_BYTES, stream);
    if (e != hipSuccess) fprintf(stderr, "cooperative launch failed: %s (grid %d)\n", hipGetErrorString(e), grid_blocks);
#else
    launch_phases<0>(p, grid_blocks, stream);
#endif
}
```

```cpp
#include <hip/hip_runtime.h>
#include <hip/hip_cooperative_groups.h>
#include <cstdio>
#include <cstdint>
namespace cg = cooperative_groups;

#ifndef MK_SINGLE
#define MK_SINGLE 1
#endif

typedef unsigned short bf16_t;
#define LAS __attribute__((address_space(3)))
typedef float v4f __attribute__((ext_vector_type(4)));
typedef unsigned v4u __attribute__((ext_vector_type(4)));
constexpr int T = 16384, SEQ = 8192;
constexpr size_t MiB = (size_t)1 << 20;
constexpr size_t OFF_CTRL = 0, OFF_ROUTE = 1 * MiB, OFF_KMEAN = 3 * MiB + 512 * 1024, OFF_TABROPE = 4 * MiB,
                 OFF_WB = 8 * MiB, OFF_XN = 32 * MiB, OFF_BIG = 64 * MiB, OFF_EXTRA = 288 * MiB, OFF_TABRET = OFF_EXTRA, WS_NEED = 304 * MiB;
constexpr size_t W_IN = 0, W_OUT = 12 * MiB, W_KVQ = 16 * MiB, W_O = 22 * MiB;
constexpr int LDS_BYTES = 147456;
constexpr size_t B_QK = 0, B_V = 64 * MiB, B_O = 128 * MiB, B_ST = 192 * MiB;
constexpr size_t B_E = 0, B_HG = 48 * MiB, B_YG = 84 * MiB;
constexpr size_t B_K = 0, B_VB = 32 * MiB, B_Q = 64 * MiB, B_PART = 96 * MiB, B_AO = 192 * MiB;

struct Params {
    const float *x, *ret_norm, *ret_w_in, *ret_w_out, *kv_norm, *w_kv, *attn_norm, *w_q, *w_o, *ffn_norm, *rg_w, *rg_b, *re_w, *re_b, *wg, *wu, *wd, *final_norm;
    float* out; unsigned char* ws;
};

__device__ __forceinline__ int otid() { int t = threadIdx.x; asm volatile("" : "+v"(t)); return t; }
__device__ __forceinline__ int obid() { int b = blockIdx.x; asm volatile("" : "+s"(b)); return b; }
__device__ __forceinline__ bf16_t f2bf(float f) { unsigned u = __float_as_uint(f); u += 0x7fffu + ((u >> 16) & 1u); return (bf16_t)(u >> 16); }
__device__ __forceinline__ float bf2f(bf16_t h) { return __uint_as_float(((unsigned)h) << 16); }
__device__ __forceinline__ float bflo(unsigned u) { return __uint_as_float(u << 16); }
__device__ __forceinline__ float bfhi(unsigned u) { return __uint_as_float(u & 0xffff0000u); }
__device__ __forceinline__ unsigned pack2(float a, float b) { return (unsigned)f2bf(a) | ((unsigned)f2bf(b) << 16); }
__device__ __forceinline__ float wsum(float v) { for (int o = 32; o > 0; o >>= 1) v += __shfl_xor(v, o); return v; }
__device__ __forceinline__ float wmax(float v) { for (int o = 32; o > 0; o >>= 1) v = fmaxf(v, __shfl_xor(v, o)); return v; }
__device__ __forceinline__ float silu(float v) { return v / (1.f + __expf(-v)); }

__device__ void sincos_big(double a, double& s, double& c) {
    const double twopi = 6.283185307179586476925286766559;
    double k = rint(a / twopi); double r = a - k * twopi;
    double x2 = r * r, ts = r, tc = 1.0; s = r; c = 1.0;
#pragma unroll 1
    for (int n = 1; n <= 16; ++n) { tc *= -x2 / (double)((2 * n - 1) * (2 * n)); c += tc; ts *= -x2 / (double)((2 * n) * (2 * n + 1)); s += ts; }
}

struct Route { int* cnt; int *e0, *e1, *p0, *p1; float *w0, *w1; int* list; float* cwl; };
__device__ __forceinline__ Route get_route(const Params& p, int L) {
    Route r; r.cnt = (int*)(p.ws + OFF_CTRL) + L * 16;
    unsigned char* b = p.ws + OFF_ROUTE;
    r.e0 = (int*)b; r.e1 = r.e0 + T; r.p0 = r.e1 + T; r.p1 = r.p0 + T; r.w0 = (float*)(r.p1 + T); r.w1 = r.w0 + T; r.list = (int*)(b + 512 * 1024); r.cwl = (float*)(b + 1536 * 1024);
    return r;
}
__device__ __forceinline__ int expert_base(const int* cnt, int e) { int s = 0; for (int i = 0; i < e; ++i) s += (cnt[i] + 255) & ~255; return s; }

template <int MODE>
__device__ void norm_pass(const Params& p, int L, unsigned char* lds) {
    const int wave = otid() >> 6, lane = otid() & 63;
    LAS float* wr = (LAS float*)(LAS unsigned char*)lds;
    LAS int* ebase = (LAS int*)(LAS unsigned char*)lds;
    if (MODE >= 2) { __syncthreads(); if (otid() < 16) ebase[otid()] = expert_base(get_route(p, L).cnt, otid()); __syncthreads(); }
    LAS int* lcnt = (LAS int*)((LAS unsigned char*)lds + 81920);
    LAS int* rec = lcnt + 64;
    int nrec = 0;
    if (MODE == 1) {
        if (otid() < 16) lcnt[otid()] = 0;
        for (int i = otid(); i < 1024 * 5; i += 512) { const int k = i / 5, part = i % 5;
            float4 w = part == 0 ? *(const float4*)(p.rg_w + ((size_t)L * 1024 + k) * 4) : *(const float4*)(p.re_w + (((size_t)L * 4 + part - 1) * 1024 + k) * 4);
            const float g = p.ffn_norm[L * 1024 + k]; w.x *= g; w.y *= g; w.z *= g; w.w *= g;
            v4f w4 = {w.x, w.y, w.z, w.w}; *(LAS v4f*)(wr + k * 20 + part * 4) = w4; }
        __syncthreads();
    }
    bf16_t* XN = (bf16_t*)(p.ws + OFF_XN);
    const bf16_t* YG = (const bf16_t*)(p.ws + OFF_BIG + B_YG);
    Route R = get_route(p, L);
    for (int t = obid() * 8 + wave; t < T; t += gridDim.x * 8) {
        const float* src = (MODE == 0 ? p.x : p.out) + (size_t)t * 1024;
        float4 v[4];
#pragma unroll
        for (int j = 0; j < 4; ++j) v[j] = *(const float4*)(src + j * 256 + lane * 4);
        if (MODE >= 2) {
            const int r0 = ebase[R.e0[t]] + R.p0[t], r1 = ebase[R.e1[t]] + R.p1[t];
#pragma unroll
            for (int j = 0; j < 4; ++j) {
                uint2 a = *(const uint2*)(YG + (size_t)r0 * 1024 + j * 256 + lane * 4), b = *(const uint2*)(YG + (size_t)r1 * 1024 + j * 256 + lane * 4);
                v[j].x += bflo(a.x) + bflo(b.x); v[j].y += bfhi(a.x) + bfhi(b.x); v[j].z += bflo(a.y) + bflo(b.y); v[j].w += bfhi(a.y) + bfhi(b.y);
            }
        }
        float ss = 0.f;
#pragma unroll
        for (int j = 0; j < 4; ++j) ss += v[j].x * v[j].x + v[j].y * v[j].y + v[j].z * v[j].z + v[j].w * v[j].w;
        ss = wsum(ss);
        const float rstd = 1.0f / sqrtf(ss * (1.0f / 1024.0f) + 1e-6f);
        if (MODE == 2) {
#pragma unroll
            for (int j = 0; j < 4; ++j) *(float4*)(p.out + (size_t)t * 1024 + j * 256 + lane * 4) = v[j];
        }
        if (MODE == 3) {
#pragma unroll
            for (int j = 0; j < 4; ++j) { float4 g = *(const float4*)(p.final_norm + j * 256 + lane * 4);
                float4 o; o.x = v[j].x * rstd * g.x; o.y = v[j].y * rstd * g.y; o.z = v[j].z * rstd * g.z; o.w = v[j].w * rstd * g.w;
                *(float4*)(p.out + (size_t)t * 1024 + j * 256 + lane * 4) = o; }
        } else {
#pragma unroll
            for (int j = 0; j < 4; ++j) { uint2 o; o.x = pack2(v[j].x * rstd, v[j].y * rstd); o.y = pack2(v[j].z * rstd, v[j].w * rstd);
                *(uint2*)(XN + (size_t)t * 1024 + j * 256 + lane * 4) = o; }
        }
        if (MODE == 1) {
            float acc[20];
#pragma unroll
            for (int i = 0; i < 20; ++i) acc[i] = 0.f;
            const LAS float* wl = wr + lane * 80;
            const float tv[4][4] = {{v[0].x * rstd, v[0].y * rstd, v[0].z * rstd, v[0].w * rstd}, {v[1].x * rstd, v[1].y * rstd, v[1].z * rstd, v[1].w * rstd},
                                    {v[2].x * rstd, v[2].y * rstd, v[2].z * rstd, v[2].w * rstd}, {v[3].x * rstd, v[3].y * rstd, v[3].z * rstd, v[3].w * rstd}};
#pragma unroll
            for (int j = 0; j < 4; ++j) {
                asm volatile("" ::: "memory");
                const float tk[4] = {tv[j][0], tv[j][1], tv[j][2], tv[j][3]};
#pragma unroll
                for (int c = 0; c < 4; ++c) {
#pragma unroll
                    for (int q = 0; q < 5; ++q) { const v4f w = *(const LAS v4f*)(wl + j * 5120 + c * 20 + q * 4);
                        acc[q * 4 + 0] += tk[c] * w[0]; acc[q * 4 + 1] += tk[c] * w[1]; acc[q * 4 + 2] += tk[c] * w[2]; acc[q * 4 + 3] += tk[c] * w[3]; }
                }
            }
#pragma unroll
            for (int i = 0; i < 20; ++i) acc[i] = wsum(acc[i]);
            float lg[4];
#pragma unroll
            for (int g = 0; g < 4; ++g) lg[g] = acc[g] + p.rg_b[L * 4 + g];
            int gi = 0; float gm = lg[0];
#pragma unroll
            for (int g = 1; g < 4; ++g) if (lg[g] > gm) { gm = lg[g]; gi = g; }
            float den = 0.f;
#pragma unroll
            for (int g = 0; g < 4; ++g) den += expf(lg[g] - gm);
            const float gval = 1.0f / den;
            float el[4] = {0.f, 0.f, 0.f, 0.f};
#pragma unroll
            for (int g = 0; g < 4; ++g) if (g == gi) {
#pragma unroll
                for (int e = 0; e < 4; ++e) el[e] = acc[4 + g * 4 + e] + p.re_b[(L * 4 + g) * 4 + e]; }
            int i0 = 0; float v0 = el[0];
#pragma unroll
            for (int e = 1; e < 4; ++e) if (el[e] > v0) { v0 = el[e]; i0 = e; }
            int i1 = -1; float v1 = -INFINITY;
#pragma unroll
            for (int e = 0; e < 4; ++e) if (e != i0 && el[e] > v1) { v1 = el[e]; i1 = e; }
            const float ex = expf(v1 - v0); const float ew0 = 1.0f / (1.0f + ex), ew1 = ex / (1.0f + ex);
            if (lane == 0) {
                const int ea = gi * 4 + i0, eb = gi * 4 + i1;
                const int la = __hip_atomic_fetch_add(lcnt + ea, 1, __ATOMIC_RELAXED, __HIP_MEMORY_SCOPE_WORKGROUP), lb = __hip_atomic_fetch_add(lcnt + eb, 1, __ATOMIC_RELAXED, __HIP_MEMORY_SCOPE_WORKGROUP);
                LAS int* rc = rec + (nrec * 8 + wave) * 8;
                rc[0] = t; rc[1] = ea; rc[2] = eb; rc[3] = la; rc[4] = lb; rc[5] = __float_as_int(gval * ew0); rc[6] = __float_as_int(gval * ew1);
            }
            ++nrec;
        }
    }
    if (MODE == 1) {
        __syncthreads();
        if (otid() < 16) { const int c = lcnt[otid()]; lcnt[16 + otid()] = c ? atomicAdd(R.cnt + otid(), c) : 0; }
        __syncthreads();
        for (int r = otid(); r < nrec * 8; r += 512) { const LAS int* rc = rec + r * 8;
            const int t = rc[0], ea = rc[1], eb = rc[2], pa = lcnt[16 + ea] + rc[3], pb = lcnt[16 + eb] + rc[4]; const float wa = __int_as_float(rc[5]), wb = __int_as_float(rc[6]);
            R.list[ea * T + pa] = t; R.list[eb * T + pb] = t; R.cwl[ea * T + pa] = wa; R.cwl[eb * T + pb] = wb;
            R.e0[t] = ea; R.e1[t] = eb; R.p0[t] = pa; R.p1[t] = pb; R.w0[t] = wa; R.w1[t] = wb; }
    }
}

template <int NB, class AF, class BF, class EF>
__device__ __forceinline__ void gemm_tile_naive(int K, const AF& af, const BF& bf, const EF& ef, float* sm) {
    float (*As)[132] = (float (*)[132])sm;
    float (*Bs)[16][68] = (float (*)[16][68])(sm + 16 * 132);
    const int tid = otid(), ty = tid >> 4, tx = tid & 15;
    float acc[NB][4][4];
#pragma unroll
    for (int n = 0; n < NB; ++n)
#pragma unroll
        for (int i = 0; i < 4; ++i)
#pragma unroll
            for (int j = 0; j < 4; ++j) acc[n][i][j] = 0.f;
    const int ar = tid >> 2, ak = (tid & 3) * 4, bk = tid >> 5, bc = (tid & 31) * 2;
    for (int k0 = 0; k0 < K; k0 += 16) {
        const float4 a = af(ar, k0 + ak);
        float2 b[NB];
#pragma unroll
        for (int n = 0; n < NB; ++n) b[n] = bf(n, k0 + bk, bc);
        __syncthreads();
        As[ak + 0][ar] = a.x; As[ak + 1][ar] = a.y; As[ak + 2][ar] = a.z; As[ak + 3][ar] = a.w;
#pragma unroll
        for (int n = 0; n < NB; ++n) { Bs[n][bk][bc] = b[n].x; Bs[n][bk][bc + 1] = b[n].y; }
        __syncthreads();
#pragma unroll
        for (int kk = 0; kk < 16; ++kk) {
            const float4 av = *(const float4*)&As[kk][ty * 4];
            const float a4[4] = {av.x, av.y, av.z, av.w};
#pragma unroll
            for (int n = 0; n < NB; ++n) { const float4 bv = *(const float4*)&Bs[n][kk][tx * 4]; const float b4[4] = {bv.x, bv.y, bv.z, bv.w};
#pragma unroll
                for (int i = 0; i < 4; ++i)
#pragma unroll
                    for (int j = 0; j < 4; ++j) acc[n][i][j] += a4[i] * b4[j]; }
        }
    }
#pragma unroll
    for (int i = 0; i < 4; ++i)
#pragma unroll
        for (int j = 0; j < 4; ++j) ef(ty * 4 + i, tx * 4 + j, acc[0][i][j], NB == 2 ? acc[NB - 1][i][j] : 0.f);
}

__device__ __forceinline__ float4 ld_bf4(const bf16_t* p) { const uint2 u = *(const uint2*)p; return make_float4(bflo(u.x), bfhi(u.x), bflo(u.y), bfhi(u.y)); }

template <class EF>
__device__ void gemm_dense_naive(const bf16_t* A, int lda, int K, int N, const float* B0, int ldb0, const float* gain0, int nsplit, const float* B1, int ldb1, const float* gain1, const EF& ef, float* sm) {
    const int ntn = N / 64, ntm = T / 128;
    for (int tile = obid(); tile < ntn * ntm; tile += gridDim.x) {
        const int tm = tile / ntn, tn = tile % ntn, m0 = tm * 128, n0 = tn * 64;
        const float* B; int ldb; const float* gain; int nb0;
        if (n0 < nsplit) { B = B0; ldb = ldb0; gain = gain0; nb0 = n0; } else { B = B1; ldb = ldb1; gain = gain1; nb0 = n0 - nsplit; }
        auto af = [&](int r, int k) { return ld_bf4(A + (size_t)(m0 + r) * lda + k); };
        auto bf = [&](int, int k, int c) { float2 w = *(const float2*)(B + (size_t)k * ldb + nb0 + c); const float g = gain ? gain[k] : 1.f; w.x *= g; w.y *= g; return w; };
        auto e2 = [&](int r, int c, float v, float) { ef(m0 + r, n0 + c, v); };
        gemm_tile_naive<1>(K, af, bf, e2, sm);
    }
}

template <int STAGE>
__device__ void gemm_expert_naive(const Params& p, int L, float* sm) {
    Route R = get_route(p, L);
    const bf16_t* XN = (const bf16_t*)(p.ws + OFF_XN);
    bf16_t* HG = (bf16_t*)(p.ws + OFF_BIG + B_HG); bf16_t* YG = (bf16_t*)(p.ws + OFF_BIG + B_YG);
    const int ntn = STAGE == 1 ? 512 / 64 : 1024 / 64;
    int* tstart = (int*)(sm + 6000);
    __syncthreads();
    if (otid() == 0) { int s = 0; for (int e = 0; e < 16; ++e) { tstart[e] = s; s += ((R.cnt[e] + 127) >> 7) * ntn; } tstart[16] = s; }
    __syncthreads();
    for (int tile = obid(); tile < tstart[16]; tile += gridDim.x) {
        int e = 0;
#pragma unroll 1
        for (int i = 1; i < 16; ++i) if (tile >= tstart[i]) e = i;
        const int lt = tile - tstart[e], tm = lt / ntn, tn = lt % ntn, m0 = tm * 128, n0 = tn * 64, cnt = R.cnt[e], base = expert_base(R.cnt, e);
        const int* list = R.list + e * T;
        if (STAGE == 1) {
            const float* Wg = p.wg + ((size_t)(L * 16 + e)) * 1024 * 512; const float* Wu = p.wu + ((size_t)(L * 16 + e)) * 1024 * 512; const float* gain = p.ffn_norm + L * 1024;
            auto af = [&](int r, int k) { const int rr = m0 + r; if (rr >= cnt) return make_float4(0.f, 0.f, 0.f, 0.f); return ld_bf4(XN + (size_t)list[rr] * 1024 + k); };
            auto bf = [&](int n, int k, int c) { float2 w = *(const float2*)((n == 0 ? Wg : Wu) + (size_t)k * 512 + n0 + c); const float g = gain[k]; w.x *= g; w.y *= g; return w; };
            auto ef = [&](int r, int c, float g, float u) { const int rr = m0 + r; if (rr >= cnt) return; const int tok = list[rr]; const float cw = (R.e0[tok] == e) ? R.w0[tok] : R.w1[tok];
                HG[(size_t)(base + rr) * 512 + n0 + c] = f2bf(silu(g) * u * cw); };
            gemm_tile_naive<2>(1024, af, bf, ef, sm);
        } else {
            const float* Wd = p.wd + ((size_t)(L * 16 + e)) * 512 * 1024;
            auto af = [&](int r, int k) { const int rr = m0 + r; if (rr >= cnt) return make_float4(0.f, 0.f, 0.f, 0.f); return ld_bf4(HG + (size_t)(base + rr) * 512 + k); };
            auto bf = [&](int, int k, int c) { return *(const float2*)(Wd + (size_t)k * 1024 + n0 + c); };
            auto ef = [&](int r, int c, float v, float) { const int rr = m0 + r; if (rr >= cnt) return; YG[(size_t)(base + rr) * 1024 + n0 + c] = f2bf(v); };
            gemm_tile_naive<1>(512, af, bf, ef, sm);
        }
    }
}


namespace pg8 {
#define PG8_LAS __attribute__((address_space(3)))
typedef unsigned short bf16_t;
typedef short bf16x8 __attribute__((ext_vector_type(8)));
typedef float f32x4 __attribute__((ext_vector_type(4)));
typedef unsigned u32x4 __attribute__((ext_vector_type(4)));
constexpr int BM = 256, BK = 64, HALF = 128, HTB = HALF * BK * 2  , STAGE_BYTES = 8 * HTB, NXCD = 8, WGM = 8;

__host__ __device__ __forceinline__ int lds_byte(int r, int c) { const int st = (r >> 4) * 2 + (c >> 5), rr = r & 15, cc = c & 31, ob = rr * 64 + cc * 2; return st * 1024 + (ob ^ (((ob >> 9) & 1) << 5)); }
__host__ __device__ __forceinline__ void stage_rc(int b, int& R, int& C) { const int st = b / 1024, sb = b % 1024, swz = sb ^ (((sb >> 9) & 1) << 5); R = (st >> 1) * 16 + swz / 64; C = (st & 1) * 32 + (swz % 64) / 2; }
__host__ __device__ __forceinline__ int perm32(int rho) { const int n = rho >> 4, i = rho & 15; return 8 * (i >> 2) + 4 * n + (i & 3); }

struct Unit { int pm, pn; };
struct Gemm { const bf16_t* A; const bf16_t* Bt; int M, N, K; };

struct StaticOrder {
    int nM, nN, nwg, G, c;
    __host__ __device__ void init(int M, int N, int G_, int c_) { nM = M / BM; nN = N / BM; nwg = nM * nN; G = G_; c = c_; }
    __host__ __device__ bool next(int i, Unit& u) const {
        const long L = (long)i * G + c; if (L >= nwg) return false;
        int wgid = (int)L; { const int q = nwg / NXCD, r = nwg % NXCD, xcd = wgid % NXCD, off = wgid / NXCD; wgid = (xcd < r ? xcd * (q + 1) : r * (q + 1) + (xcd - r) * q) + off; }
        const int nig = WGM * nN, gid = wgid / nig, fm = gid * WGM, gsz = (nM - fm) < WGM ? (nM - fm) : WGM;
        u.pm = fm + ((wgid % nig) % gsz); u.pn = (wgid % nig) / gsz; return true;
    }
    __device__ __forceinline__ void a_ready(const Unit&) const {}
    __device__ __forceinline__ void done(const Unit&) const {}
};


__device__ __forceinline__ unsigned cvt_pk_bf16(float lo, float hi) { unsigned r; asm volatile("v_cvt_pk_bf16_f32 %0, %1, %2" : "=v"(r) : "v"(lo), "v"(hi)); return r; }
__device__ __forceinline__ u32x4 pk8(const f32x4& a, const f32x4& b) { u32x4 w; w.x = cvt_pk_bf16(a[0], a[1]); w.y = cvt_pk_bf16(a[2], a[3]); w.z = cvt_pk_bf16(b[0], b[1]); w.w = cvt_pk_bf16(b[2], b[3]); return w; }
typedef unsigned u32x2 __attribute__((ext_vector_type(2)));
__device__ __forceinline__ u32x2 pk4(const f32x4& a) { u32x2 w; w.x = cvt_pk_bf16(a[0], a[1]); w.y = cvt_pk_bf16(a[2], a[3]); return w; }
__device__ __forceinline__ float fsilu(float v) { return v * __builtin_amdgcn_rcpf(1.f + __expf(-v)); }

struct EpiInproj {
    static constexpr bool PERM = true, AFTER_DRAIN = false;
    bf16_t* QK; const float* rc; const float* rs;
    __device__ __forceinline__ void operator()(const f32x4 (&acc)[2][2][4][2], const Unit& u, int wr, int wc, int fr, int fq) const {
        const int row0 = u.pm * BM + wr * 64 + fr;
        {
            const int f0 = wc * 32 + 8 * fq;
#pragma unroll
            for (int ai = 0; ai < 2; ++ai)
#pragma unroll
                for (int m = 0; m < 4; ++m) { const int r = row0 + ai * HALF + m * 16, pos = r & 8191;
                    const f32x4 c0 = *(const f32x4*)(rc + pos * 128 + f0), c1 = *(const f32x4*)(rc + pos * 128 + f0 + 4), s0 = *(const f32x4*)(rs + pos * 128 + f0), s1 = *(const f32x4*)(rs + pos * 128 + f0 + 4);
                    const f32x4 x1a = acc[ai][0][m][0], x1b = acc[ai][0][m][1], x2a = acc[ai][1][m][0], x2b = acc[ai][1][m][1];
                    bf16_t* p = QK + (size_t)r * 2048 + u.pn * 256 + f0;
                    *(u32x4*)p = pk8(x1a * c0 - x2a * s0, x1b * c1 - x2b * s1);
                    *(u32x4*)(p + 128) = pk8(x2a * c0 + x1a * s0, x2b * c1 + x1b * s1); }
        }
    }
};
struct EpiVt {
    static constexpr bool PERM = true, AFTER_DRAIN = false;
    bf16_t* Vt;
    __device__ __forceinline__ void operator()(const f32x4 (&acc)[2][2][4][2], const Unit& u, int wr, int wc, int fr, int fq) const {
        const int row0 = u.pm * BM + wr * 64 + fr;
#pragma unroll
        for (int ai = 0; ai < 2; ++ai)
#pragma unroll
            for (int m = 0; m < 4; ++m) { bf16_t* p = Vt + (size_t)(row0 + ai * HALF + m * 16) * 16384 + u.pn * BM + wc * 32 + 8 * fq;
#pragma unroll
                for (int bj = 0; bj < 2; ++bj) *(u32x4*)(p + bj * HALF) = pk8(acc[ai][bj][m][0], acc[ai][bj][m][1]); }
    }
};
struct EpiG {
    static constexpr bool PERM = true, AFTER_DRAIN = false;
    bf16_t* O;
    __device__ __forceinline__ void operator()(const f32x4 (&acc)[2][2][4][2], const Unit& u, int wr, int wc, int fr, int fq) const {
        const int row0 = u.pm * BM + wr * 64 + fr;
#pragma unroll
        for (int ai = 0; ai < 2; ++ai)
#pragma unroll
            for (int m = 0; m < 4; ++m) { const int r = row0 + ai * HALF + m * 16; bf16_t* p = O + (size_t)r * 2048 + u.pn * 256 + wc * 32 + 8 * fq;
#pragma unroll
                for (int bj = 0; bj < 2; ++bj) { const u32x4 o = *(const u32x4*)(p + bj * HALF); const f32x4 g0 = acc[ai][bj][m][0], g1 = acc[ai][bj][m][1];
                    f32x4 y0, y1; y0[0] = fsilu(g0[0]) * bflo(o.x); y0[1] = fsilu(g0[1]) * bfhi(o.x); y0[2] = fsilu(g0[2]) * bflo(o.y); y0[3] = fsilu(g0[3]) * bfhi(o.y);
                    y1[0] = fsilu(g1[0]) * bflo(o.z); y1[1] = fsilu(g1[1]) * bfhi(o.z); y1[2] = fsilu(g1[2]) * bflo(o.w); y1[3] = fsilu(g1[3]) * bfhi(o.w);
                    *(u32x4*)(p + bj * HALF) = pk8(y0, y1); } }
    }
};
struct EpiResid {
    static constexpr bool PERM = false, AFTER_DRAIN = false;
    const float* base; float* out;
    __device__ __forceinline__ void operator()(const f32x4 (&acc)[2][2][4][2], const Unit& u, int wr, int wc, int fr, int fq) const {
        const int row0 = u.pm * BM + wr * 64 + fr, col0 = u.pn * BM + wc * 32 + 4 * fq;
#pragma unroll
        for (int ai = 0; ai < 2; ++ai)
#pragma unroll
            for (int m = 0; m < 4; ++m) { const size_t off = (size_t)(row0 + ai * HALF + m * 16) * 1024 + col0;
#pragma unroll
                for (int bj = 0; bj < 2; ++bj)
#pragma unroll
                    for (int n = 0; n < 2; ++n) { const f32x4 b = *(const f32x4*)(base + off + bj * HALF + n * 16); *(f32x4*)(out + off + bj * HALF + n * 16) = b + acc[ai][bj][m][n]; } }
    }
};
struct EpiKVQ {
    static constexpr bool PERM = false, AFTER_DRAIN = false;
    bf16_t *K, *Vb, *Q; const float* pc; const float* ps; float* kms;
    __device__ __forceinline__ void operator()(const f32x4 (&acc)[2][2][4][2], const Unit& u, int wr, int wc, int fr, int fq) const {
        const int which = u.pn >> 2; bf16_t* dst = K + (size_t)which * (16u << 20);
        const int row0 = u.pm * BM + wr * 64 + fr, col0 = (u.pn & 3) * BM + wc * 32 + 4 * fq;
        const bool rot = (which != 1) && (wc == 0);
        f32x4 cs[2][2];
#pragma unroll
        for (int bj = 0; bj < 2; ++bj) { cs[bj][0] = (f32x4){0.f, 0.f, 0.f, 0.f}; cs[bj][1] = (f32x4){0.f, 0.f, 0.f, 0.f}; }
#pragma unroll
        for (int ai = 0; ai < 2; ++ai)
#pragma unroll
            for (int m = 0; m < 4; ++m) { const int r = row0 + ai * HALF + m * 16, pos = r & 8191;
                f32x4 c = {1.f, 1.f, 1.f, 1.f}, s = {0.f, 0.f, 0.f, 0.f};
                if (rot) { c = *(const f32x4*)(pc + pos * 16 + 4 * fq); s = *(const f32x4*)(ps + pos * 16 + 4 * fq); }
#pragma unroll
                for (int bj = 0; bj < 2; ++bj) { f32x4 v0 = acc[ai][bj][m][0], v1 = acc[ai][bj][m][1];
                    if (rot) { const f32x4 y0 = v0 * c - v1 * s, y1 = v1 * c + v0 * s; v0 = y0; v1 = y1; }
                    cs[bj][0] += v0; cs[bj][1] += v1;
                    bf16_t* p = dst + (size_t)r * 1024 + col0 + bj * HALF;
                    *(u32x2*)p = pk4(v0); *(u32x2*)(p + 16) = pk4(v1); } }
        if (which == 0) {
#pragma unroll
            for (int bj = 0; bj < 2; ++bj)
#pragma unroll
                for (int n = 0; n < 2; ++n)
#pragma unroll
                    for (int j = 0; j < 4; ++j) { float v = cs[bj][n][j]; v += __shfl_xor(v, 1); v += __shfl_xor(v, 2); v += __shfl_xor(v, 4); v += __shfl_xor(v, 8); cs[bj][n][j] = v; }
            if (fr == 0) { const int b = u.pm >> 5, blk = u.pm & 31;
#pragma unroll
                for (int bj = 0; bj < 2; ++bj)
#pragma unroll
                    for (int n = 0; n < 2; ++n) { const int h = (u.pn & 3) * 2 + bj; float* d = kms + (((size_t)b * 8 + h) * 32 + blk) * 128 + wc * 32 + 16 * n + 4 * fq;
#pragma unroll
                        for (int j = 0; j < 4; ++j) atomicAdd(d + j, cs[bj][n][j]); } }
        }
    }
};
template <class Epi, class Sched, bool ALIGN_EPI = false, bool SP2 = false>
__device__ __forceinline__ void gemm_phase(PG8_LAS unsigned char* lds, const Gemm g, const Sched& S, const Epi& E) {
    const int tid = otid(), wid = __builtin_amdgcn_readfirstlane(tid >> 6), lane = tid & 63, wr = wid >> 2, wc = wid & 3, fr = lane & 15, fq = lane >> 4;
    const int K = g.K, nt = K / BK;
    unsigned voffA[2], voffB[2];
#pragma unroll
    for (int i = 0; i < 2; ++i) { int R, C; stage_rc(tid * 16 + i * 8192, R, C); const int Rb = Epi::PERM ? ((R & ~31) + perm32(R & 31)) : R;
        voffA[i] = (unsigned)(R * K + C) * 2u; voffB[i] = (unsigned)(Rb * K + C) * 2u; }
    const size_t kstep = (size_t)(BK * 2);
    const size_t hstep = (size_t)HALF * K * 2;
    const size_t tstep = 2 * hstep;
    const unsigned ldsw = (unsigned)wid * 1024u;
    const int aoff = lds_byte(wr * 64 + fr, fq * 8), boff = lds_byte(wc * 32 + fr, fq * 8);
#define PG8_SA(b, h) (((b) * 2 + (h)) * HTB)
#define PG8_SB(b, h) ((4 + (b) * 2 + (h)) * HTB)
#define PG8_STAGE(bufoff, gbase, voff) do { _Pragma("unroll") for (int _i = 0; _i < 2; ++_i) \
        __builtin_amdgcn_global_load_lds((const unsigned*)((const char*)(gbase) + (voff)[_i]), (PG8_LAS unsigned*)(lds + (bufoff) + ldsw + _i * 8192), 16, 0, 0); } while (0)
#define PG8_LDA(dst, b, h) do { _Pragma("unroll") for (int m = 0; m < 4; ++m) _Pragma("unroll") for (int k = 0; k < 2; ++k) dst[m][k] = *(const PG8_LAS bf16x8*)(lds + PG8_SA(b, h) + aoff + m * 2048 + k * 1024); } while (0)
#define PG8_LDB(dst, b, h) do { _Pragma("unroll") for (int n = 0; n < 2; ++n) _Pragma("unroll") for (int k = 0; k < 2; ++k) dst[n][k] = *(const PG8_LAS bf16x8*)(lds + PG8_SB(b, h) + boff + n * 2048 + k * 1024); } while (0)
#define PG8_MMA(ai, bj, At, Bt) do { __builtin_amdgcn_s_setprio(1); _Pragma("unroll") for (int m = 0; m < 4; ++m) _Pragma("unroll") for (int n = 0; n < 2; ++n) _Pragma("unroll") for (int k = 0; k < 2; ++k) \
        acc[ai][bj][m][n] = __builtin_amdgcn_mfma_f32_16x16x32_bf16(Bt[n][k], At[m][k], acc[ai][bj][m][n], 0, 0, 0); __builtin_amdgcn_s_setprio(0); } while (0)
#define PG8_WAIT_V(n) asm volatile("s_waitcnt vmcnt(" #n ")" ::: "memory")
#define PG8_WAIT_L(n) asm volatile("s_waitcnt lgkmcnt(" #n ")" ::: "memory")
#define PG8_BAR __builtin_amdgcn_s_barrier()
#define PG8_SCHED __builtin_amdgcn_sched_barrier(0)
    Unit cur, nxt; int ui = 0;
    if (!S.next(0, cur)) return;
    f32x4 acc[2][2][4][2];
#pragma unroll
    for (int a = 0; a < 2; ++a)
#pragma unroll
        for (int b = 0; b < 2; ++b)
#pragma unroll
            for (int m = 0; m < 4; ++m)
#pragma unroll
                for (int n = 0; n < 2; ++n) acc[a][b][m][n] = (f32x4){0.f, 0.f, 0.f, 0.f};
    bf16x8 At[4][2], B0[2][2], B1[2][2];
    const char* cA = (const char*)g.A + (size_t)cur.pm * tstep; const char* cB = (const char*)g.Bt + (size_t)cur.pn * tstep;
    S.a_ready(cur);
    if constexpr (SP2) {
        PG8_STAGE(PG8_SB(0, 0), cB, voffB); PG8_STAGE(PG8_SB(0, 1), cB + hstep, voffB); PG8_STAGE(PG8_SA(0, 0), cA, voffA); PG8_STAGE(PG8_SA(0, 1), cA + hstep, voffA);
        if (wr == 1) PG8_BAR;
        PG8_WAIT_V(2); PG8_BAR;
        PG8_STAGE(PG8_SB(1, 0), cB + kstep, voffB); PG8_STAGE(PG8_SA(1, 0), cA + kstep, voffA); PG8_STAGE(PG8_SB(1, 1), cB + hstep + kstep, voffB);
        PG8_WAIT_V(6); PG8_BAR;
    } else {
        PG8_STAGE(PG8_SB(0, 0), cB, voffB); PG8_STAGE(PG8_SA(0, 0), cA, voffA); PG8_STAGE(PG8_SB(0, 1), cB + hstep, voffB); PG8_STAGE(PG8_SA(0, 1), cA + hstep, voffA);
        if (wr == 1) PG8_BAR;
        PG8_WAIT_V(4); PG8_BAR;
        PG8_STAGE(PG8_SB(1, 0), cB + kstep, voffB); PG8_STAGE(PG8_SA(1, 0), cA + kstep, voffA); PG8_STAGE(PG8_SB(1, 1), cB + hstep + kstep, voffB);
        PG8_WAIT_V(6); PG8_BAR;
    }
    for (;;) {
        const bool has_next = S.next(ui + 1, nxt);
        const char* nA = has_next ? (const char*)g.A + (size_t)nxt.pm * tstep : cA; const char* nB = has_next ? (const char*)g.Bt + (size_t)nxt.pn * tstep : cB;
        for (int t = 0; t < nt; t += 2) {
            const bool last = (t == nt - 2);
            const char* a1 = cA + (size_t)(t + 1) * kstep;
            const char* a2 = last ? nA : cA + (size_t)(t + 2) * kstep; const char* b2 = last ? nB : cB + (size_t)(t + 2) * kstep;
            const char* a3 = a2 + kstep; const char* b3 = b2 + kstep;
            if (last && has_next) S.a_ready(nxt);
            if constexpr (SP2) {
            PG8_LDB(B0, 0, 0); PG8_LDB(B1, 0, 1); PG8_SCHED; PG8_LDA(At, 0, 0); PG8_STAGE(PG8_SA(1, 1), a1 + hstep, voffA);
            PG8_WAIT_V(8); PG8_WAIT_L(0); PG8_BAR; PG8_MMA(0, 0, At, B0); PG8_MMA(0, 1, At, B1); PG8_BAR; PG8_SCHED;
            PG8_LDA(At, 0, 1); PG8_STAGE(PG8_SB(0, 0), b2, voffB); PG8_STAGE(PG8_SB(0, 1), b2 + hstep, voffB); PG8_STAGE(PG8_SA(0, 0), a2, voffA);
            PG8_WAIT_V(8); PG8_WAIT_L(0); PG8_BAR; PG8_MMA(1, 0, At, B0); PG8_MMA(1, 1, At, B1); PG8_BAR; PG8_SCHED;
            PG8_LDB(B0, 1, 0); PG8_LDB(B1, 1, 1); PG8_SCHED; PG8_LDA(At, 1, 0); PG8_STAGE(PG8_SA(0, 1), a2 + hstep, voffA);
            PG8_WAIT_V(8); PG8_WAIT_L(0); PG8_BAR; PG8_MMA(0, 0, At, B0); PG8_MMA(0, 1, At, B1); PG8_BAR; PG8_SCHED;
            PG8_LDA(At, 1, 1); PG8_STAGE(PG8_SB(1, 0), b3, voffB); PG8_STAGE(PG8_SB(1, 1), b3 + hstep, voffB); PG8_STAGE(PG8_SA(1, 0), a3, voffA);
            PG8_WAIT_V(8); PG8_WAIT_L(0); PG8_BAR; PG8_MMA(1, 0, At, B0); PG8_MMA(1, 1, At, B1); PG8_BAR; PG8_SCHED;
            } else {
            PG8_LDB(B0, 0, 0); PG8_SCHED; PG8_LDA(At, 0, 0); PG8_STAGE(PG8_SA(1, 1), a1 + hstep, voffA);
            PG8_WAIT_L(8); PG8_BAR; PG8_WAIT_L(0); PG8_MMA(0, 0, At, B0); PG8_BAR; PG8_SCHED;
            PG8_LDB(B1, 0, 1); PG8_STAGE(PG8_SB(0, 0), b2, voffB);
            PG8_BAR; PG8_WAIT_L(0); PG8_MMA(0, 1, At, B1); PG8_BAR;
            PG8_LDA(At, 0, 1); PG8_STAGE(PG8_SA(0, 0), a2, voffA);
            PG8_BAR; PG8_WAIT_L(0); PG8_MMA(1, 0, At, B0); PG8_BAR; PG8_SCHED;
            PG8_STAGE(PG8_SB(0, 1), b2 + hstep, voffB);
            PG8_WAIT_V(6); PG8_BAR; PG8_MMA(1, 1, At, B1); PG8_BAR;
            PG8_LDB(B0, 1, 0); PG8_SCHED; PG8_LDA(At, 1, 0); PG8_STAGE(PG8_SA(0, 1), a2 + hstep, voffA);
            PG8_WAIT_L(8); PG8_BAR; PG8_WAIT_L(0); PG8_MMA(0, 0, At, B0); PG8_BAR; PG8_SCHED;
            PG8_LDB(B1, 1, 1); PG8_STAGE(PG8_SB(1, 0), b3, voffB);
            PG8_BAR; PG8_WAIT_L(0); PG8_MMA(0, 1, At, B1); PG8_BAR;
            PG8_LDA(At, 1, 1); PG8_STAGE(PG8_SA(1, 0), a3, voffA);
            PG8_BAR; PG8_WAIT_L(0); PG8_MMA(1, 0, At, B0); PG8_BAR; PG8_SCHED;
            PG8_STAGE(PG8_SB(1, 1), b3 + hstep, voffB);
            PG8_WAIT_V(6); PG8_BAR; PG8_MMA(1, 1, At, B1); PG8_BAR;
            }
        }
        if constexpr (ALIGN_EPI) { if (wr == 0) PG8_BAR; }
        if constexpr (!Epi::AFTER_DRAIN) { E(acc, cur, wr, wc, fr, fq); S.done(cur); }
        if (!has_next) break;
#pragma unroll
        for (int a = 0; a < 2; ++a)
#pragma unroll
            for (int b = 0; b < 2; ++b)
#pragma unroll
                for (int m = 0; m < 4; ++m)
#pragma unroll
                    for (int n = 0; n < 2; ++n) acc[a][b][m][n] = (f32x4){0.f, 0.f, 0.f, 0.f};
        cur = nxt; cA = nA; cB = nB; ++ui;
        if constexpr (ALIGN_EPI) { if (wr == 1) PG8_BAR; }
    }
    PG8_WAIT_V(0);
    if constexpr (!ALIGN_EPI) { if (wr == 0) PG8_BAR; }
    PG8_BAR;
    if constexpr (Epi::AFTER_DRAIN) { E.fused(acc, cur, wr, wc, fr, fq, lds, wid, lane); S.done(cur); }
#undef PG8_SA
#undef PG8_SB
#undef PG8_STAGE
#undef PG8_LDA
#undef PG8_LDB
#undef PG8_MMA
#undef PG8_WAIT_V
#undef PG8_WAIT_L
#undef PG8_BAR
#undef PG8_SCHED
}

struct GUnit { int pm, pn, e, row0; };
template <int STAGE> struct GroupedOrder {
    typedef GUnit UnitT;
    const PG8_LAS int* tab; int G, c; const int* list; const char* Bt;
    __device__ __forceinline__ bool next(int i, GUnit& u) const {
        const int L = i * G + c; if (L >= tab[16]) return false;
        int e = 0;
#pragma unroll
        for (int j = 1; j < 16; ++j) e = (L >= tab[j]) ? j : e;
        const int lt = L - tab[e]; u.e = e; u.pm = lt >> 2; u.pn = lt & 3; u.row0 = tab[48 + e] + u.pm * 256; return true;
    }
    __device__ __forceinline__ unsigned rowoff(const GUnit& u, int r) const {
        if (STAGE == 1) { const int idx = u.pm * 256 + r; const int tok = idx < tab[32 + u.e] ? list[u.e * T + idx] : 0; return (unsigned)tok * 2048u; }
        return (unsigned)(u.row0 + r) * 1024u;
    }
    __device__ __forceinline__ const char* bbase(const GUnit& u) const { return Bt + (size_t)u.e * (3u << 20) + (size_t)u.pn * (STAGE == 1 ? 256 * 1024 * 2 : 256 * 512 * 2); }
    __device__ __forceinline__ void a_ready(const GUnit&) const {}
    __device__ __forceinline__ void done(const GUnit&) const {}
};
struct EpiExp1 {
    static constexpr bool PERM = true, AFTER_DRAIN = false;
    bf16_t* HG; const float* cwl; const PG8_LAS int* tab;
    __device__ __forceinline__ void operator()(const f32x4 (&acc)[2][2][4][2], const GUnit& u, int wr, int wc, int fr, int fq) const {
        const int cnt = tab[32 + u.e];
#pragma unroll
        for (int ai = 0; ai < 2; ++ai)
#pragma unroll
            for (int m = 0; m < 4; ++m) { const int rl = wr * 64 + fr + ai * HALF + m * 16, idx = u.pm * 256 + rl;
                const float cw = idx < cnt ? cwl[u.e * T + idx] : 0.f;
                const f32x4 g0 = acc[ai][0][m][0], g1 = acc[ai][0][m][1], u0 = acc[ai][1][m][0], u1 = acc[ai][1][m][1];
                f32x4 h0, h1;
#pragma unroll
                for (int j = 0; j < 4; ++j) { h0[j] = fsilu(g0[j]) * u0[j] * cw; h1[j] = fsilu(g1[j]) * u1[j] * cw; }
                *(u32x4*)(HG + (size_t)(u.row0 + rl) * 512 + u.pn * 128 + wc * 32 + 8 * fq) = pk8(h0, h1); }
    }
};
struct EpiExp2 {
    static constexpr bool PERM = true, AFTER_DRAIN = false;
    bf16_t* YG;
    __device__ __forceinline__ void operator()(const f32x4 (&acc)[2][2][4][2], const GUnit& u, int wr, int wc, int fr, int fq) const {
#pragma unroll
        for (int ai = 0; ai < 2; ++ai)
#pragma unroll
            for (int m = 0; m < 4; ++m) { const int rl = wr * 64 + fr + ai * HALF + m * 16; bf16_t* p = YG + (size_t)(u.row0 + rl) * 1024 + u.pn * 256 + wc * 32 + 8 * fq;
#pragma unroll
                for (int bj = 0; bj < 2; ++bj) *(u32x4*)(p + bj * HALF) = pk8(acc[ai][bj][m][0], acc[ai][bj][m][1]); }
    }
};
template <class Epi, class Sched, bool ALIGN_EPI = false>
__device__ __forceinline__ void gemm_phase_g(PG8_LAS unsigned char* lds, const char* Abase, const int K, const Sched& S, const Epi& E) {
    constexpr bool SP2 = true;
    const int tid = otid(), wid = __builtin_amdgcn_readfirstlane(tid >> 6), lane = tid & 63, wr = wid >> 2, wc = wid & 3, fr = lane & 15, fq = lane >> 4;
    const int nt = K / BK;
    unsigned voffB[2]; int RA[2], CA2[2];
#pragma unroll
    for (int i = 0; i < 2; ++i) { int R, C; stage_rc(tid * 16 + i * 8192, R, C); const int Rb = Epi::PERM ? ((R & ~31) + perm32(R & 31)) : R;
        RA[i] = R; CA2[i] = C * 2; voffB[i] = (unsigned)(Rb * K + C) * 2u; }
    const size_t kstep = (size_t)(BK * 2);
    const size_t hstep = (size_t)HALF * K * 2;
    const size_t tstep = 2 * hstep;
    const unsigned ldsw = (unsigned)wid * 1024u;
    const int aoff = lds_byte(wr * 64 + fr, fq * 8), boff = lds_byte(wc * 32 + fr, fq * 8);
#define PG8_SA(b, h) (((b) * 2 + (h)) * HTB)
#define PG8_SB(b, h) ((4 + (b) * 2 + (h)) * HTB)
#define PG8_STAGE_A(bufoff, h, kb, nx) do { _Pragma("unroll") for (int _i = 0; _i < 2; ++_i) \
        __builtin_amdgcn_global_load_lds((const unsigned*)(Abase + ((nx) ? vAn[h][_i] : vAc[h][_i]) + (kb)), (PG8_LAS unsigned*)(lds + (bufoff) + ldsw + _i * 8192), 16, 0, 0); } while (0)
#define PG8_STAGE(bufoff, gbase, voff) do { _Pragma("unroll") for (int _i = 0; _i < 2; ++_i) \
        __builtin_amdgcn_global_load_lds((const unsigned*)((const char*)(gbase) + (voff)[_i]), (PG8_LAS unsigned*)(lds + (bufoff) + ldsw + _i * 8192), 16, 0, 0); } while (0)
#define PG8_LDA(dst, b, h) do { _Pragma("unroll") for (int m = 0; m < 4; ++m) _Pragma("unroll") for (int k = 0; k < 2; ++k) dst[m][k] = *(const PG8_LAS bf16x8*)(lds + PG8_SA(b, h) + aoff + m * 2048 + k * 1024); } while (0)
#define PG8_LDB(dst, b, h) do { _Pragma("unroll") for (int n = 0; n < 2; ++n) _Pragma("unroll") for (int k = 0; k < 2; ++k) dst[n][k] = *(const PG8_LAS bf16x8*)(lds + PG8_SB(b, h) + boff + n * 2048 + k * 1024); } while (0)
#define PG8_MMA(ai, bj, At, Bt) do { __builtin_amdgcn_s_setprio(1); _Pragma("unroll") for (int m = 0; m < 4; ++m) _Pragma("unroll") for (int n = 0; n < 2; ++n) _Pragma("unroll") for (int k = 0; k < 2; ++k) \
        acc[ai][bj][m][n] = __builtin_amdgcn_mfma_f32_16x16x32_bf16(Bt[n][k], At[m][k], acc[ai][bj][m][n], 0, 0, 0); __builtin_amdgcn_s_setprio(0); } while (0)
#define PG8_WAIT_V(n) asm volatile("s_waitcnt vmcnt(" #n ")" ::: "memory")
#define PG8_WAIT_L(n) asm volatile("s_waitcnt lgkmcnt(" #n ")" ::: "memory")
#define PG8_BAR __builtin_amdgcn_s_barrier()
#define PG8_SCHED __builtin_amdgcn_sched_barrier(0)
    typename Sched::UnitT cur, nxt; int ui = 0;
    if (!S.next(0, cur)) return;
    unsigned vAc[2][2], vAn[2][2];
#pragma unroll
    for (int h = 0; h < 2; ++h)
#pragma unroll
        for (int i = 0; i < 2; ++i) { vAc[h][i] = S.rowoff(cur, h * HALF + RA[i]) + (unsigned)CA2[i]; vAn[h][i] = vAc[h][i]; }
    f32x4 acc[2][2][4][2];
#pragma unroll
    for (int a = 0; a < 2; ++a)
#pragma unroll
        for (int b = 0; b < 2; ++b)
#pragma unroll
            for (int m = 0; m < 4; ++m)
#pragma unroll
                for (int n = 0; n < 2; ++n) acc[a][b][m][n] = (f32x4){0.f, 0.f, 0.f, 0.f};
    bf16x8 At[4][2], B0[2][2], B1[2][2];
    const char* cB = S.bbase(cur);
    S.a_ready(cur);
    if constexpr (SP2) {
        PG8_STAGE(PG8_SB(0, 0), cB, voffB); PG8_STAGE(PG8_SB(0, 1), cB + hstep, voffB); PG8_STAGE_A(PG8_SA(0, 0), 0, 0, false); PG8_STAGE_A(PG8_SA(0, 1), 1, 0, false);
        if (wr == 1) PG8_BAR;
        PG8_WAIT_V(2); PG8_BAR;
        PG8_STAGE(PG8_SB(1, 0), cB + kstep, voffB); PG8_STAGE_A(PG8_SA(1, 0), 0, (unsigned)kstep, false); PG8_STAGE(PG8_SB(1, 1), cB + hstep + kstep, voffB);
        PG8_WAIT_V(6); PG8_BAR;
    }
    for (;;) {
        const bool has_next = S.next(ui + 1, nxt);
        const char* nB = has_next ? S.bbase(nxt) : cB;
        if (has_next) {
#pragma unroll
            for (int h = 0; h < 2; ++h)
#pragma unroll
                for (int i = 0; i < 2; ++i) vAn[h][i] = S.rowoff(nxt, h * HALF + RA[i]) + (unsigned)CA2[i];
        }
        for (int t = 0; t < nt; t += 2) {
            const bool last = (t == nt - 2);
            const unsigned kb1 = (unsigned)(t + 1) * (unsigned)kstep;
            const unsigned kb2 = last ? 0u : (unsigned)(t + 2) * (unsigned)kstep; const char* b2 = last ? nB : cB + (size_t)(t + 2) * kstep;
            const unsigned kb3 = kb2 + (unsigned)kstep; const char* b3 = b2 + kstep;
            if (last && has_next) S.a_ready(nxt);
            if constexpr (SP2) {
            PG8_LDB(B0, 0, 0); PG8_LDB(B1, 0, 1); PG8_SCHED; PG8_LDA(At, 0, 0); PG8_STAGE_A(PG8_SA(1, 1), 1, kb1, false);
            PG8_WAIT_V(8); PG8_WAIT_L(0); PG8_BAR; PG8_MMA(0, 0, At, B0); PG8_MMA(0, 1, At, B1); PG8_BAR; PG8_SCHED;
            PG8_LDA(At, 0, 1); PG8_STAGE(PG8_SB(0, 0), b2, voffB); PG8_STAGE(PG8_SB(0, 1), b2 + hstep, voffB); PG8_STAGE_A(PG8_SA(0, 0), 0, kb2, last);
            PG8_WAIT_V(8); PG8_WAIT_L(0); PG8_BAR; PG8_MMA(1, 0, At, B0); PG8_MMA(1, 1, At, B1); PG8_BAR; PG8_SCHED;
            PG8_LDB(B0, 1, 0); PG8_LDB(B1, 1, 1); PG8_SCHED; PG8_LDA(At, 1, 0); PG8_STAGE_A(PG8_SA(0, 1), 1, kb2, last);
            PG8_WAIT_V(8); PG8_WAIT_L(0); PG8_BAR; PG8_MMA(0, 0, At, B0); PG8_MMA(0, 1, At, B1); PG8_BAR; PG8_SCHED;
            PG8_LDA(At, 1, 1); PG8_STAGE(PG8_SB(1, 0), b3, voffB); PG8_STAGE(PG8_SB(1, 1), b3 + hstep, voffB); PG8_STAGE_A(PG8_SA(1, 0), 0, kb3, last);
            PG8_WAIT_V(8); PG8_WAIT_L(0); PG8_BAR; PG8_MMA(1, 0, At, B0); PG8_MMA(1, 1, At, B1); PG8_BAR; PG8_SCHED;
            }
        }
        if constexpr (ALIGN_EPI) { if (wr == 0) PG8_BAR; }
        if constexpr (!Epi::AFTER_DRAIN) { E(acc, cur, wr, wc, fr, fq); S.done(cur); }
        if (!has_next) break;
#pragma unroll
        for (int a = 0; a < 2; ++a)
#pragma unroll
            for (int b = 0; b < 2; ++b)
#pragma unroll
                for (int m = 0; m < 4; ++m)
#pragma unroll
                    for (int n = 0; n < 2; ++n) acc[a][b][m][n] = (f32x4){0.f, 0.f, 0.f, 0.f};
        cur = nxt; cB = nB; ++ui;
#pragma unroll
        for (int h = 0; h < 2; ++h)
#pragma unroll
            for (int i = 0; i < 2; ++i) vAc[h][i] = vAn[h][i];
        if constexpr (ALIGN_EPI) { if (wr == 1) PG8_BAR; }
    }
    PG8_WAIT_V(0);
    if constexpr (!ALIGN_EPI) { if (wr == 0) PG8_BAR; }
    PG8_BAR;
    if constexpr (Epi::AFTER_DRAIN) { E.fused(acc, cur, wr, wc, fr, fq, lds, wid, lane); S.done(cur); }
#undef PG8_SA
#undef PG8_SB
#undef PG8_STAGE
#undef PG8_STAGE_A
#undef PG8_LDA
#undef PG8_LDB
#undef PG8_MMA
#undef PG8_WAIT_V
#undef PG8_WAIT_L
#undef PG8_BAR
#undef PG8_SCHED
}
}


__device__ __forceinline__ void tr_block(const float* W, int ldw, int k0, int n0, bf16_t* WT, int K, int drow0, const float* gain, float scale, LAS float* scr, int tid) {
    v4f v[4];
#pragma unroll
    for (int it = 0; it < 4; ++it) { const int idx = it * 512 + tid, row = idx >> 5, c4 = idx & 31; v[it] = *(const v4f*)(W + (size_t)(k0 + row) * ldw + n0 + 4 * c4); }
#pragma unroll
    for (int it = 0; it < 4; ++it) { const int idx = it * 512 + tid, row = idx >> 5, c4 = idx & 31; const float g = gain ? gain[k0 + row] * scale : scale;
        LAS float* d = scr + row * 129 + 4 * c4; d[0] = v[it][0] * g; d[1] = v[it][1] * g; d[2] = v[it][2] * g; d[3] = v[it][3] * g; }
    __syncthreads();
#pragma unroll
    for (int it = 0; it < 2; ++it) { const int idx = it * 512 + tid, n = idx >> 3, c = idx & 7; const LAS float* s = scr + (8 * c) * 129 + n;
        v4u o; o.x = pack2(s[0 * 129], s[1 * 129]); o.y = pack2(s[2 * 129], s[3 * 129]); o.z = pack2(s[4 * 129], s[5 * 129]); o.w = pack2(s[6 * 129], s[7 * 129]);
        *(v4u*)(WT + (size_t)(drow0 + n) * K + k0 + 8 * c) = o; }
    __syncthreads();
}
__device__ __forceinline__ void tr_job(int it, const float* W, int ldw, int K, int N, bf16_t* WT, int drow_base, const float* gain, float scale, LAS float* scr, int tid) {
    const int nblk = N / 128, kb = it / nblk, nb = it % nblk;
    tr_block(W, ldw, kb * 64, nb * 128, WT, K, drow_base + nb * 128, gain, scale, scr, tid);
}
__device__ void convert_dense_weights(const Params& p, unsigned char* lds) {
    const int tid = otid();
    LAS float* scr = (LAS float*)(LAS unsigned char*)lds;
    bf16_t* WB = (bf16_t*)(p.ws + OFF_WB);
    bf16_t* Win = WB + W_IN / 2; bf16_t* Wout = WB + W_OUT / 2; bf16_t* Wkvq = WB + W_KVQ / 2; bf16_t* Wo = WB + W_O / 2;
    constexpr int I0 = 16 * 48, I1 = 32 * 8, I2 = 16 * 16, I3 = 16 * 8, I4 = 16 * 8, NIT = I0 + I1 + I2 + I3 + I4;
    for (int it = obid(); it < NIT; it += gridDim.x) {
        int r = it;
        if (r < I0) { const int nb = r % 48; const float sc = (nb >= 8 && nb < 16) ? 0.0625f : 1.f;
            tr_job(r, p.ret_w_in, 6144, 1024, 6144, Win, 0, p.ret_norm, sc, scr, tid); continue; } r -= I0;
        if (r < I1) { tr_job(r, p.ret_w_out, 1024, 2048, 1024, Wout, 0, nullptr, 1.f, scr, tid); continue; } r -= I1;
        if (r < I2) { tr_job(r, p.w_kv, 2048, 1024, 2048, Wkvq, 0, p.kv_norm, 1.f, scr, tid); continue; } r -= I2;
        if (r < I3) { tr_job(r, p.w_q, 1024, 1024, 1024, Wkvq, 2048, p.attn_norm, 0.08838834764831845f, scr, tid); continue; } r -= I3;
        tr_job(r, p.w_o, 1024, 1024, 1024, Wo, 0, nullptr, 1.f, scr, tid);
    }
}
__device__ void convert_expert_weights(const Params& p, int L, unsigned char* lds) {
    const int tid = otid();
    LAS float* scr = (LAS float*)(LAS unsigned char*)lds;
    bf16_t* E = (bf16_t*)(p.ws + OFF_BIG + B_E);
    const float* gain = p.ffn_norm + L * 1024;
    for (int it = obid(); it < 16 * 192; it += gridDim.x) {
        const int e = it / 192; int r = it % 192;
        bf16_t* W1 = E + (size_t)e * 3 * 512 * 1024; bf16_t* W2 = W1 + 1024 * 1024;
        if (r < 128) { const int up = r >= 64; r &= 63; const int kb = r / 4, nb = r % 4;
            const float* W = (up ? p.wu : p.wg) + (size_t)(L * 16 + e) * 1024 * 512;
            tr_block(W, 512, kb * 64, nb * 128, W1, 1024, nb * 256 + up * 128, gain, 1.f, scr, tid);
        } else { r -= 128; tr_job(r, p.wd + (size_t)(L * 16 + e) * 512 * 1024, 1024, 512, 1024, W2, 0, nullptr, 1.f, scr, tid); }
    }
}

__device__ void phase_prologue(const Params& p, unsigned char* lds) {
    const int gtid = obid() * 512 + otid(), gsz = gridDim.x * 512;
    int* cnt = (int*)(p.ws + OFF_CTRL);
    if (gtid < 64 + 512) cnt[gtid] = 0;
    if (gtid < 65536) ((float*)(p.ws + OFF_KMEAN))[gtid] = 0.f;
    float* rc = (float*)(p.ws + OFF_TABRET); float* rs = rc + 8192 * 128;
    for (int i = gtid; i < 8192 * 128; i += gsz) { const int pos = i >> 7, f = i & 127;
        const float inv = (float)exp(-9.2103403719761836 * ((double)f / 128.0));
        const float ang = (float)pos * inv; double s, c; sincos_big((double)ang, s, c); rc[i] = (float)c; rs[i] = (float)s; }
    float* pc = (float*)(p.ws + OFF_TABROPE); float* ps = pc + 8192 * 16;
    for (int i = gtid; i < 8192 * 16; i += gsz) { const int pos = i >> 4, f = i & 15;
        const float inv = (float)exp(-13.122363377404328 * ((double)f / 16.0));
        const float ang = (float)pos * inv; double s, c; sincos_big((double)ang, s, c); pc[i] = (float)c; ps[i] = (float)s; }
    convert_dense_weights(p, lds);
    norm_pass<0>(p, 0, lds);
}

__device__ void phase_ret_rotary(const Params& p) {
    bf16_t* QK = (bf16_t*)(p.ws + OFF_BIG + B_QK);
    const float* rc = (const float*)(p.ws + OFF_TABRET); const float* rs = rc + 8192 * 128;
    const size_t total = (size_t)T * 8 * 128;
    for (size_t i = (size_t)obid() * 512 + otid(); i < total; i += (size_t)gridDim.x * 512) {
        const int f = (int)(i & 127), slot = (int)((i >> 7) & 7), t = (int)(i >> 10), pos = t & 8191;
        bf16_t* px = QK + (size_t)t * 2048 + slot * 256 + f;
        const float x1 = bf2f(px[0]), x2 = bf2f(px[128]), c = rc[pos * 128 + f], s = rs[pos * 128 + f];
        const float sc = slot >= 4 ? 0.0625f : 1.f;
        px[0] = f2bf((x1 * c - x2 * s) * sc); px[128] = f2bf((x2 * c + x1 * s) * sc);
    }
}

__device__ void phase_ret_scan(const Params& p) {
    const bf16_t* QK = (const bf16_t*)(p.ws + OFF_BIG + B_QK); const bf16_t* V = (const bf16_t*)(p.ws + OFF_BIG + B_V); bf16_t* O = (bf16_t*)(p.ws + OFF_BIG + B_O);
    const int wave = otid() >> 6, lane = otid() & 63;
    for (int item = obid() * 8 + wave; item < 2048; item += gridDim.x * 8) {
        const int b = item >> 10, h = (item >> 8) & 3, ep = item & 255;
        const float gamma = 1.f - exp2f(-5.f - (float)h);
        float S[4][2];
#pragma unroll
        for (int d = 0; d < 4; ++d) { S[d][0] = 0.f; S[d][1] = 0.f; }
        const bf16_t* qp = QK + (size_t)b * SEQ * 2048 + h * 256 + lane * 4;
        const bf16_t* kp = qp + 1024;
        const bf16_t* vp = V + (size_t)(h * 512 + ep * 2) * 16384 + (size_t)b * SEQ;
        bf16_t* op = O + (size_t)b * SEQ * 2048 + h * 512 + ep * 2;
#pragma unroll 4
        for (int t = 0; t < SEQ; ++t) {
            const uint2 qv = *(const uint2*)(qp + (size_t)t * 2048), kv = *(const uint2*)(kp + (size_t)t * 2048);
            const float q[4] = {bflo(qv.x), bfhi(qv.x), bflo(qv.y), bfhi(qv.y)}, k[4] = {bflo(kv.x), bfhi(kv.x), bflo(kv.y), bfhi(kv.y)};
            const float v0 = bf2f(vp[t]), v1 = bf2f(vp[16384 + t]);
            float p0 = 0.f, p1 = 0.f;
#pragma unroll
            for (int d = 0; d < 4; ++d) { S[d][0] = gamma * S[d][0] + k[d] * v0; S[d][1] = gamma * S[d][1] + k[d] * v1; p0 += q[d] * S[d][0]; p1 += q[d] * S[d][1]; }
            p0 = wsum(p0); p1 = wsum(p1);
            if (lane == 0) *(unsigned*)(op + (size_t)t * 2048) = pack2(p0, p1);
        }
    }
}

__device__ void phase_ret_gnorm(const Params& p) {
    bf16_t* O = (bf16_t*)(p.ws + OFF_BIG + B_O);
    const int wave = otid() >> 6, lane = otid() & 63;
    for (int item = obid() * 8 + wave; item < T * 4; item += gridDim.x * 8) {
        bf16_t* po = O + (size_t)item * 512 + lane * 8;
        const uint4 u = *(const uint4*)po;
        float v[8] = {bflo(u.x), bfhi(u.x), bflo(u.y), bfhi(u.y), bflo(u.z), bfhi(u.z), bflo(u.w), bfhi(u.w)};
        float ss = 0.f;
#pragma unroll
        for (int i = 0; i < 8; ++i) ss += v[i] * v[i];
        ss = wsum(ss);
        const float rstd = 1.0f / sqrtf(ss * (1.0f / 512.0f) + 1e-6f);
        uint4 o; o.x = pack2(v[0] * rstd, v[1] * rstd); o.y = pack2(v[2] * rstd, v[3] * rstd); o.z = pack2(v[4] * rstd, v[5] * rstd); o.w = pack2(v[6] * rstd, v[7] * rstd);
        *(uint4*)po = o;
    }
}

__device__ void phase_rope(const Params& p) {
    bf16_t* Kb = (bf16_t*)(p.ws + OFF_BIG + B_K); bf16_t* Qb = (bf16_t*)(p.ws + OFF_BIG + B_Q);
    const float* pc = (const float*)(p.ws + OFF_TABROPE); const float* ps = pc + 8192 * 16;
    const size_t total = (size_t)T * 2 * 8 * 16;
    for (size_t i = (size_t)obid() * 512 + otid(); i < total; i += (size_t)gridDim.x * 512) {
        const int f = (int)(i & 15), h = (int)((i >> 4) & 7), which = (int)((i >> 7) & 1), t = (int)(i >> 8), pos = t & 8191;
        bf16_t* px = (which ? Qb : Kb) + (size_t)t * 1024 + h * 128 + f;
        const float x1 = bf2f(px[0]), x2 = bf2f(px[16]), c = pc[pos * 16 + f], s = ps[pos * 16 + f];
        px[0] = f2bf(x1 * c - x2 * s); px[16] = f2bf(x2 * c + x1 * s);
    }
}
__device__ void phase_qscale(const Params& p) {
    bf16_t* Qb = (bf16_t*)(p.ws + OFF_BIG + B_Q);
    const size_t total = (size_t)T * 1024;
    const float sc = 0.08838834764831845f;
    for (size_t i = (size_t)obid() * 512 + otid(); i < total; i += (size_t)gridDim.x * 512) Qb[i] = f2bf(bf2f(Qb[i]) * sc);
}

__device__ void phase_kmean(const Params& p) {
    const bf16_t* Kb = (const bf16_t*)(p.ws + OFF_BIG + B_K); float* km = (float*)(p.ws + OFF_KMEAN);
    for (int i = obid() * 512 + otid(); i < 2 * 32 * 1024; i += gridDim.x * 512) {
        const int col = i & 1023, n = (i >> 10) & 31, b = i >> 15, h = col >> 7, d = col & 127;
        const bf16_t* pk = Kb + ((size_t)b * SEQ + n * 256) * 1024 + col;
        float s = 0.f;
        for (int j = 0; j < 256; ++j) s += bf2f(pk[(size_t)j * 1024]);
        km[(((size_t)b * 8 + h) * 32 + n) * 128 + d] = s * (1.0f / 256.0f);
    }
}

__device__ void phase_moba_naive(const Params& p, float* sm) {
    const bf16_t* Kb = (const bf16_t*)(p.ws + OFF_BIG + B_K); const bf16_t* Vb = (const bf16_t*)(p.ws + OFF_BIG + B_VB); const bf16_t* Qb = (const bf16_t*)(p.ws + OFF_BIG + B_Q);
    const float* kmean = (const float*)(p.ws + OFF_KMEAN); bf16_t* AO = (bf16_t*)(p.ws + OFF_BIG + B_AO);
    const int wave = otid() >> 6, lane = otid() & 63;
    float* qs = sm + wave * 128;
    for (int item = obid() * 8 + wave; item < T * 8; item += gridDim.x * 8) {
        const int tg = item >> 3, h = item & 7, b = tg >> 13, s = tg & 8191, blk = s >> 8;
        const unsigned qq = *(const unsigned*)(Qb + (size_t)tg * 1024 + h * 128 + lane * 2);
        qs[lane * 2] = bflo(qq); qs[lane * 2 + 1] = bfhi(qq);
        __builtin_amdgcn_wave_barrier();
        float g = -INFINITY;
        if (lane < blk) { const float* km = kmean + (((size_t)b * 8 + h) * 32 + lane) * 128; float a = 0.f; for (int d = 0; d < 128; ++d) a += qs[d] * km[d]; g = a; }
        const int nsel = blk < 3 ? blk : 3;
        int sel[3];
#pragma unroll
        for (int j = 0; j < 3; ++j) {
            sel[j] = 0;
            if (j < nsel) { const float m = wmax(g); const unsigned long long bal = __ballot(g == m); const int idx = __ffsll((long long)bal) - 1; sel[j] = idx; if (lane == idx) g = -INFINITY; }
        }
        float sc[4][4];
#pragma unroll
        for (int seg = 0; seg < 4; ++seg) {
            const int bid = seg < 3 ? sel[seg] : blk; const bool valid = seg < 3 ? (seg < nsel) : true; const int nkeys = seg < 3 ? 256 : (s - blk * 256 + 1);
#pragma unroll
            for (int kk = 0; kk < 4; ++kk) {
                const int key = kk * 64 + lane; float v = -INFINITY;
                if (valid && key < nkeys) {
                    const bf16_t* kr = Kb + ((size_t)b * SEQ + bid * 256 + key) * 1024 + h * 128; float a = 0.f;
#pragma unroll 4
                    for (int d8 = 0; d8 < 16; ++d8) { const uint4 u = *(const uint4*)(kr + d8 * 8); const float* q8 = qs + d8 * 8;
                        a += q8[0] * bflo(u.x) + q8[1] * bfhi(u.x) + q8[2] * bflo(u.y) + q8[3] * bfhi(u.y) + q8[4] * bflo(u.z) + q8[5] * bfhi(u.z) + q8[6] * bflo(u.w) + q8[7] * bfhi(u.w); }
                    v = a;
                }
                sc[seg][kk] = v;
            }
        }
        float m = -INFINITY;
#pragma unroll
        for (int seg = 0; seg < 4; ++seg)
#pragma unroll
            for (int kk = 0; kk < 4; ++kk) m = fmaxf(m, sc[seg][kk]);
        m = wmax(m);
        float l = 0.f;
#pragma unroll
        for (int seg = 0; seg < 4; ++seg)
#pragma unroll
            for (int kk = 0; kk < 4; ++kk) { const float e = expf(sc[seg][kk] - m); sc[seg][kk] = e; l += e; }
        l = wsum(l);
        float o0 = 0.f, o1 = 0.f;
#pragma unroll
        for (int seg = 0; seg < 4; ++seg) {
            const int bid = seg < 3 ? sel[seg] : blk; const bool valid = seg < 3 ? (seg < nsel) : true; const int nkeys = seg < 3 ? 256 : (s - blk * 256 + 1);
            if (valid) {
#pragma unroll
                for (int kk = 0; kk < 4; ++kk) {
                    if (kk * 64 < nkeys) {
                        const bf16_t* vr = Vb + ((size_t)b * SEQ + bid * 256 + kk * 64) * 1024 + h * 128 + lane * 2;
                        for (int src = 0; src < 64; ++src) { const float pp = __shfl(sc[seg][kk], src); const unsigned vv = *(const unsigned*)(vr + (size_t)src * 1024); o0 += pp * bflo(vv); o1 += pp * bfhi(vv); }
                    }
                }
            }
        }
        const float il = 1.0f / l;
        *(unsigned*)(AO + (size_t)tg * 1024 + h * 128 + lane * 2) = pack2(o0 * il, o1 * il);
        __builtin_amdgcn_wave_barrier();
    }
}

typedef short bf16x8_t __attribute__((ext_vector_type(8)));
typedef short s16x4_t __attribute__((ext_vector_type(4)));
constexpr int QCAP = 8192;
constexpr size_t X_QLIST = 0, X_ML = 16 * MiB;
constexpr int CT_QCNT = 64;

__device__ void phase_kmean2(const Params& p) {
    const bf16_t* Kb = (const bf16_t*)(p.ws + OFF_BIG + B_K); bf16_t* kh = (bf16_t*)(p.ws + OFF_KMEAN); bf16_t* kl = kh + 2 * 8 * 32 * 128;
    for (int i = obid() * 512 + otid(); i < 2 * 32 * 1024; i += gridDim.x * 512) {
        const int col = i & 1023, n = (i >> 10) & 31, b = i >> 15, h = col >> 7, d = col & 127;
        const bf16_t* pk = Kb + ((size_t)b * SEQ + n * 256) * 1024 + col;
        float s = 0.f;
#pragma unroll 8
        for (int j = 0; j < 256; ++j) s += bf2f(pk[(size_t)j * 1024]);
        s *= (1.0f / 256.0f);
        const bf16_t hi = f2bf(s); const size_t o = (((size_t)b * 8 + h) * 32 + n) * 128 + d;
        kh[o] = hi; kl[o] = f2bf(s - bf2f(hi));
    }
}

__device__ void phase_moba_gate(const Params& p, unsigned char* lds) {
    const int tid = otid(), wave = tid >> 6, lane = tid & 63, g = lane >> 4, i = lane & 15;
    LAS int* lcnt = (LAS int*)(LAS unsigned char*)lds; LAS int* lbase = lcnt + 32; LAS unsigned* lsel = (LAS unsigned*)(lcnt + 64);
    const bf16_t* Qb = (const bf16_t*)(p.ws + OFF_BIG + B_Q); const float* kms = (const float*)(p.ws + OFF_KMEAN);
    int* qcnt = (int*)(p.ws + OFF_CTRL) + CT_QCNT; unsigned* qlist = (unsigned*)(p.ws + OFF_XN + X_QLIST);
    for (int unit = obid(); unit < 256; unit += gridDim.x) {
        const int b = unit >> 7, h = (unit >> 4) & 7, s0 = (unit & 15) * 512;
        if (tid < 32) lcnt[tid] = 0;
        __syncthreads();
        bf16x8_t ah[2][4], al[2][4];
#pragma unroll
        for (int nt = 0; nt < 2; ++nt)
#pragma unroll
            for (int ks = 0; ks < 4; ++ks) { const float* src = kms + (((size_t)b * 8 + h) * 32 + nt * 16 + i) * 128 + ks * 32 + 8 * g;
                const v4f x0 = *(const v4f*)src * (1.0f / 256.0f), x1 = *(const v4f*)(src + 4) * (1.0f / 256.0f);
                union { bf16x8_t v; bf16_t s[8]; } hh, ll;
#pragma unroll
                for (int e = 0; e < 4; ++e) { hh.s[e] = f2bf(x0[e]); ll.s[e] = f2bf(x0[e] - bf2f(hh.s[e])); hh.s[4 + e] = f2bf(x1[e]); ll.s[4 + e] = f2bf(x1[e] - bf2f(hh.s[4 + e])); }
                ah[nt][ks] = hh.v; al[nt][ks] = ll.v; }
#pragma unroll 1
        for (int it = 0; it < 4; ++it) {
            const int tl = wave * 64 + it * 16 + i, s = s0 + tl, tg = b * SEQ + s, blk = s >> 8;
            v4f acc[2] = {{0.f, 0.f, 0.f, 0.f}, {0.f, 0.f, 0.f, 0.f}};
#pragma unroll
            for (int ks = 0; ks < 4; ++ks) { const bf16x8_t bq = *(const bf16x8_t*)(Qb + (size_t)tg * 1024 + h * 128 + ks * 32 + 8 * g);
#pragma unroll
                for (int nt = 0; nt < 2; ++nt) { acc[nt] = __builtin_amdgcn_mfma_f32_16x16x32_bf16(ah[nt][ks], bq, acc[nt], 0, 0, 0); acc[nt] = __builtin_amdgcn_mfma_f32_16x16x32_bf16(al[nt][ks], bq, acc[nt], 0, 0, 0); } }
            float gv[8];
#pragma unroll
            for (int q = 0; q < 8; ++q) { const int n = (q >> 2) * 16 + 4 * g + (q & 3); gv[q] = n < blk ? acc[q >> 2][q & 3] : -INFINITY; }
            const int nsel = blk < 3 ? blk : 3;
#pragma unroll
            for (int j = 0; j < 3; ++j) {
                float bm = -INFINITY; int bn = 64;
#pragma unroll
                for (int q = 0; q < 8; ++q) { const int n = (q >> 2) * 16 + 4 * g + (q & 3); if (gv[q] > bm) { bm = gv[q]; bn = n; } }
#pragma unroll
                for (int off = 16; off <= 32; off <<= 1) { const float om = __shfl_xor(bm, off); const int on = __shfl_xor(bn, off); if (om > bm || (om == bm && on < bn)) { bm = om; bn = on; } }
#pragma unroll
                for (int q = 0; q < 8; ++q) { const int n = (q >> 2) * 16 + 4 * g + (q & 3); if (n == bn) gv[q] = -INFINITY; }
                if (g == 0 && j < nsel) { const int off = atomicAdd((int*)&lcnt[bn], 1); lsel[tl * 3 + j] = (unsigned)bn | ((unsigned)off << 8); }
            }
        }
        __syncthreads();
        if (tid < 32) { const int c = lcnt[tid]; lbase[tid] = c ? atomicAdd(qcnt + (b * 8 + h) * 32 + tid, c) : 0; }
        __syncthreads();
        { const int s = s0 + tid, blk = s >> 8, nsel = blk < 3 ? blk : 3;
            for (int j = 0; j < nsel; ++j) { const unsigned e = lsel[tid * 3 + j]; const int sel = e & 255, off = e >> 8;
                qlist[((size_t)(b * 8 + h) * 32 + sel) * QCAP + lbase[sel] + off] = (unsigned)(b * SEQ + s) | ((unsigned)j << 16); } }
        __syncthreads();
    }
}

__device__ __forceinline__ void moba_stage_kv(const bf16_t* Kb, const bf16_t* Vb, int b, int h, int n, LAS unsigned char* Ks, LAS unsigned char* Vs, int tid) {
    const size_t rowbase = ((size_t)b * SEQ + n * 256) * 1024 + h * 128;
#pragma unroll
    for (int it = 0; it < 8; ++it) { const int idx = it * 512 + tid, row = idx >> 4, ch = idx & 15;
        const v4u kv = *(const v4u*)(Kb + rowbase + (size_t)row * 1024 + ch * 8), vv = *(const v4u*)(Vb + rowbase + (size_t)row * 1024 + ch * 8);
        *(LAS v4u*)(Ks + row * 256 + ((ch ^ (row & 15)) << 4)) = kv; *(LAS v4u*)(Vs + row * 256 + ((ch ^ ((row & 7) << 1)) << 4)) = vv; }
}

__device__ __forceinline__ void moba_wave_attn(const bf16_t* qrow, LAS unsigned char* Ks, LAS unsigned char* Vs, int g, int i, bool own, int t_local, int nkt, v4f (&o)[8], float& m_out, float& l_out) {
    bf16x8_t bq[4];
#pragma unroll
    for (int ks = 0; ks < 4; ++ks) bq[ks] = *(const bf16x8_t*)(qrow + ks * 32 + 8 * g);
    v4f st[16];
#pragma unroll
    for (int kt = 0; kt < 16; ++kt) {
        st[kt] = (v4f){0.f, 0.f, 0.f, 0.f};
        if (kt < nkt) {
            const int row = kt * 16 + i;
#pragma unroll
            for (int ks = 0; ks < 4; ++ks) { const bf16x8_t a = *(const LAS bf16x8_t*)(Ks + row * 256 + (((ks * 4 + g) ^ (row & 15)) << 4)); st[kt] = __builtin_amdgcn_mfma_f32_16x16x32_bf16(a, bq[ks], st[kt], 0, 0, 0); }
        }
    }
    float m = -INFINITY;
#pragma unroll
    for (int kt = 0; kt < 16; ++kt)
#pragma unroll
        for (int r = 0; r < 4; ++r) { const int key = kt * 16 + 4 * g + r; const bool ok = (kt < nkt) && (!own || key <= t_local); st[kt][r] = ok ? st[kt][r] : -INFINITY; m = fmaxf(m, st[kt][r]); }
    m = fmaxf(m, __shfl_xor(m, 16)); m = fmaxf(m, __shfl_xor(m, 32));
    float l = 0.f;
#pragma unroll
    for (int kt = 0; kt < 16; ++kt)
#pragma unroll
        for (int r = 0; r < 4; ++r) { const float e = __expf(st[kt][r] - m); st[kt][r] = e; l += e; }
    l += __shfl_xor(l, 16); l += __shfl_xor(l, 32);
#pragma unroll
    for (int dt = 0; dt < 8; ++dt) o[dt] = (v4f){0.f, 0.f, 0.f, 0.f};
    const int q = i >> 2, pp = i & 3;
#pragma unroll
    for (int k2 = 0; k2 < 8; ++k2) {
        if (2 * k2 < nkt) {
            union { bf16x8_t v; unsigned u[4]; } pb;
            pb.u[0] = pg8::cvt_pk_bf16(st[2 * k2][0], st[2 * k2][1]); pb.u[1] = pg8::cvt_pk_bf16(st[2 * k2][2], st[2 * k2][3]);
            pb.u[2] = pg8::cvt_pk_bf16(st[2 * k2 + 1][0], st[2 * k2 + 1][1]); pb.u[3] = pg8::cvt_pk_bf16(st[2 * k2 + 1][2], st[2 * k2 + 1][3]);
            const int r0 = (2 * k2) * 16 + 4 * g + q, r1 = r0 + 16;
#pragma unroll
            for (int dt = 0; dt < 8; ++dt) {
                const int ch = dt * 2 + (pp >> 1);
                const s16x4_t a0 = __builtin_amdgcn_ds_read_tr16_b64_v4i16((LAS s16x4_t*)(Vs + r0 * 256 + ((ch ^ ((r0 & 7) << 1)) << 4) + (pp & 1) * 8));
                const s16x4_t a1 = __builtin_amdgcn_ds_read_tr16_b64_v4i16((LAS s16x4_t*)(Vs + r1 * 256 + ((ch ^ ((r1 & 7) << 1)) << 4) + (pp & 1) * 8));
                const bf16x8_t a = {a0[0], a0[1], a0[2], a0[3], a1[0], a1[1], a1[2], a1[3]};
                o[dt] = __builtin_amdgcn_mfma_f32_16x16x32_bf16(a, pb.v, o[dt], 0, 0, 0);
            }
        }
    }
    m_out = m; l_out = l;
}

__device__ void phase_moba_sel(const Params& p, unsigned char* lds) {
    const int tid = otid(), wave = __builtin_amdgcn_readfirstlane(tid >> 6), lane = tid & 63, g = lane >> 4, i = lane & 15;
    LAS unsigned char* Ks = (LAS unsigned char*)lds; LAS unsigned char* Vs = Ks + 65536; LAS int* pre = (LAS int*)(Ks + 131072);
    const bf16_t* Kb = (const bf16_t*)(p.ws + OFF_BIG + B_K); const bf16_t* Vb = (const bf16_t*)(p.ws + OFF_BIG + B_VB); const bf16_t* Qb = (const bf16_t*)(p.ws + OFF_BIG + B_Q);
    bf16_t* PART = (bf16_t*)(p.ws + OFF_BIG + B_PART); float* ML = (float*)(p.ws + OFF_XN + X_ML);
    const int* qcnt = (const int*)(p.ws + OFF_CTRL) + CT_QCNT; const unsigned* qlist = (const unsigned*)(p.ws + OFF_XN + X_QLIST);
    __syncthreads();
    pre[516 + tid] = qcnt[tid];
    __syncthreads();
    if (tid == 0) { int s = 0; for (int l = 0; l < 512; ++l) { pre[l] = s; s += (pre[516 + l] + 127) >> 7; } pre[512] = s; }
    __syncthreads();
    const int NT = pre[512], G = (int)gridDim.x, c = obid();
    const int t_begin = (int)(((long)NT * c) / G), t_end = (int)(((long)NT * (c + 1)) / G);
    int li = 0, cur = -1;
    for (int tile = t_begin; tile < t_end; ++tile) {
        while (tile >= pre[li + 1]) ++li;
        const int b = li >> 8, h = (li >> 5) & 7, n = li & 31;
        if (li != cur) { __syncthreads(); moba_stage_kv(Kb, Vb, b, h, n, Ks, Vs, tid); __syncthreads(); cur = li; }
        const int cnt = pre[516 + li], row = (tile - pre[li]) * 128 + wave * 16 + i; const bool valid = row < cnt;
        const unsigned e = qlist[(size_t)li * QCAP + (valid ? row : 0)]; const int tg = e & 0xffff, j = e >> 16;
        v4f o[8]; float m, l;
        moba_wave_attn(Qb + (size_t)tg * 1024 + h * 128, Ks, Vs, g, i, false, 0, 16, o, m, l);
        if (valid) {
            bf16_t* po = PART + ((size_t)(tg * 8 + h) * 3 + j) * 128 + 4 * g;
#pragma unroll
            for (int dt = 0; dt < 8; ++dt) *(uint2*)(po + dt * 16) = make_uint2(pg8::cvt_pk_bf16(o[dt][0], o[dt][1]), pg8::cvt_pk_bf16(o[dt][2], o[dt][3]));
            if (g == 0) *(float2*)(ML + ((size_t)(tg * 8 + h) * 3 + j) * 2) = make_float2(m, l);
        }
    }
}

__device__ void phase_moba_own(const Params& p, unsigned char* lds) {
    const int tid = otid(), wave = __builtin_amdgcn_readfirstlane(tid >> 6), lane = tid & 63, g = lane >> 4, i = lane & 15;
    LAS unsigned char* Ks = (LAS unsigned char*)lds; LAS unsigned char* Vs = Ks + 65536;
    const bf16_t* Kb = (const bf16_t*)(p.ws + OFF_BIG + B_K); const bf16_t* Vb = (const bf16_t*)(p.ws + OFF_BIG + B_VB); const bf16_t* Qb = (const bf16_t*)(p.ws + OFF_BIG + B_Q);
    const bf16_t* PART = (const bf16_t*)(p.ws + OFF_BIG + B_PART); const float* ML = (const float*)(p.ws + OFF_XN + X_ML); bf16_t* AO = (bf16_t*)(p.ws + OFF_BIG + B_AO);
    for (int unit = obid(); unit < 512; unit += gridDim.x) {
        const int b = unit >> 8, h = (unit >> 5) & 7, blk = unit & 31, nsel = blk < 3 ? blk : 3;
        __syncthreads(); moba_stage_kv(Kb, Vb, b, h, blk, Ks, Vs, tid); __syncthreads();
#pragma unroll 1
        for (int tile = 0; tile < 2; ++tile) {
            const int t_local = tile * 128 + wave * 16 + i, tg = b * SEQ + blk * 256 + t_local, nkt = tile * 8 + wave + 1;
            v4f o[8]; float m, l;
            moba_wave_attn(Qb + (size_t)tg * 1024 + h * 128, Ks, Vs, g, i, true, t_local, nkt, o, m, l);
            float mj[3], lj[3], M = m;
#pragma unroll
            for (int j = 0; j < 3; ++j) { mj[j] = -INFINITY; lj[j] = 0.f; if (j < nsel) { const float2 v = *(const float2*)(ML + ((size_t)(tg * 8 + h) * 3 + j) * 2); mj[j] = v.x; lj[j] = v.y; } M = fmaxf(M, mj[j]); }
            const float w0 = __expf(m - M); float den = l * w0; float wj[3];
#pragma unroll
            for (int j = 0; j < 3; ++j) { wj[j] = (j < nsel) ? __expf(mj[j] - M) : 0.f; den += lj[j] * wj[j]; }
            const float inv = 1.0f / den;
#pragma unroll
            for (int dt = 0; dt < 8; ++dt) {
                v4f acc = o[dt] * w0;
#pragma unroll
                for (int j = 0; j < 3; ++j) if (j < nsel) { const uint2 u = *(const uint2*)(PART + ((size_t)(tg * 8 + h) * 3 + j) * 128 + dt * 16 + 4 * g);
                    acc[0] += bflo(u.x) * wj[j]; acc[1] += bfhi(u.x) * wj[j]; acc[2] += bflo(u.y) * wj[j]; acc[3] += bfhi(u.y) * wj[j]; }
                acc = acc * inv;
                *(uint2*)(AO + (size_t)tg * 1024 + h * 128 + dt * 16 + 4 * g) = make_uint2(pg8::cvt_pk_bf16(acc[0], acc[1]), pg8::cvt_pk_bf16(acc[2], acc[3]));
            }
        }
    }
}

constexpr int RL = 512;
constexpr size_t ST_SLOT = (size_t)512 * 256;
__device__ __forceinline__ float ret_lg(int h) { return log2f(1.f - exp2f(-5.f - (float)h)); }

__device__ void phase_ret_kv(const Params& p, unsigned char* lds) {
    const int tid = otid(), wave = __builtin_amdgcn_readfirstlane(tid >> 6), lane = tid & 63, g = lane >> 4, i = lane & 15, q = i >> 2, pp = i & 3;
    const int we = wave >> 2, wd = wave & 3;
    LAS unsigned char* Ks = (LAS unsigned char*)lds;
    const bf16_t* QK = (const bf16_t*)(p.ws + OFF_BIG + B_QK); const bf16_t* Vt = (const bf16_t*)(p.ws + OFF_BIG + B_V); bf16_t* ST = (bf16_t*)(p.ws + OFF_BIG + B_ST);
    for (int unit = obid(); unit < 240; unit += gridDim.x) {
        const int eh = unit & 1, s = (unit >> 1) % 15, bh = (unit >> 1) / 15, b = bh >> 2, h = bh & 3;
        const float lg = ret_lg(h);
        v4f acc[4][8];
#pragma unroll
        for (int m = 0; m < 4; ++m)
#pragma unroll
            for (int n = 0; n < 8; ++n) acc[m][n] = (v4f){0.f, 0.f, 0.f, 0.f};
        const bf16_t* krow = QK + ((size_t)b * SEQ + s * RL) * 2048 + 1024 + h * 256;
        const bf16_t* vrow = Vt + (size_t)(h * 512 + eh * 256 + we * 128 + i) * 16384 + (size_t)b * SEQ + s * RL + 8 * g;
#pragma unroll 1
        for (int st = 0; st < 8; ++st) {
            __syncthreads();
#pragma unroll
            for (int it = 0; it < 4; ++it) { const int idx = it * 512 + tid, row = idx >> 5, ch = idx & 31;
                const v4u kv = *(const v4u*)(krow + (size_t)(st * 64 + row) * 2048 + ch * 8);
                const float w = exp2f((float)(RL - 1 - (st * 64 + row)) * lg);
                v4u o; o.x = pg8::cvt_pk_bf16(bflo(kv.x) * w, bfhi(kv.x) * w); o.y = pg8::cvt_pk_bf16(bflo(kv.y) * w, bfhi(kv.y) * w); o.z = pg8::cvt_pk_bf16(bflo(kv.z) * w, bfhi(kv.z) * w); o.w = pg8::cvt_pk_bf16(bflo(kv.w) * w, bfhi(kv.w) * w);
                const int f = ((row & 3) | ((row >> 1) & 4)) << 1;
                *(LAS v4u*)(Ks + row * 512 + ((ch ^ f) << 4)) = o; }
            __syncthreads();
#pragma unroll
            for (int kk = 0; kk < 2; ++kk) {
                bf16x8_t af[4];
#pragma unroll
                for (int m = 0; m < 4; ++m) {
                    const int r0 = kk * 32 + 8 * g + q, r1 = r0 + 4, ch = (wd * 64 + m * 16) / 8 + (pp >> 1);
                    const int f0 = ((r0 & 3) | ((r0 >> 1) & 4)) << 1, f1 = ((r1 & 3) | ((r1 >> 1) & 4)) << 1;
                    const s16x4_t a0 = __builtin_amdgcn_ds_read_tr16_b64_v4i16((LAS s16x4_t*)(Ks + r0 * 512 + ((ch ^ f0) << 4) + (pp & 1) * 8));
                    const s16x4_t a1 = __builtin_amdgcn_ds_read_tr16_b64_v4i16((LAS s16x4_t*)(Ks + r1 * 512 + ((ch ^ f1) << 4) + (pp & 1) * 8));
                    af[m] = (bf16x8_t){a0[0], a0[1], a0[2], a0[3], a1[0], a1[1], a1[2], a1[3]};
                }
#pragma unroll
                for (int nh = 0; nh < 2; ++nh) { bf16x8_t bf[4];
#pragma unroll
                    for (int n = 0; n < 4; ++n) bf[n] = *(const bf16x8_t*)(vrow + (size_t)(16 * (nh * 4 + n)) * 16384 + st * 64 + kk * 32);
#pragma unroll
                    for (int m = 0; m < 4; ++m)
#pragma unroll
                        for (int n = 0; n < 4; ++n) acc[m][nh * 4 + n] = __builtin_amdgcn_mfma_f32_16x16x32_bf16(af[m], bf[n], acc[m][nh * 4 + n], 0, 0, 0); }
            }
        }
        bf16_t* out = ST + ((size_t)bh * 15 + s) * ST_SLOT;
#pragma unroll
        for (int m = 0; m < 4; ++m)
#pragma unroll
            for (int n = 0; n < 8; ++n) { const int e = eh * 256 + we * 128 + n * 16 + i, d = wd * 64 + m * 16 + 4 * g;
                *(uint2*)(out + (size_t)e * 256 + d) = make_uint2(pg8::cvt_pk_bf16(acc[m][n][0], acc[m][n][1]), pg8::cvt_pk_bf16(acc[m][n][2], acc[m][n][3])); }
    }
}

__device__ void phase_ret_scan2(const Params& p) {
    bf16_t* ST = (bf16_t*)(p.ws + OFF_BIG + B_ST);
    for (int gid = obid() * 512 + otid(); gid < 8 * 16384; gid += gridDim.x * 512) {
        const int bh = gid >> 14, h = bh & 3; const size_t off = (size_t)(gid & 16383) * 8;
        const float cd = exp2f((float)RL * ret_lg(h));
        float S[8];
#pragma unroll
        for (int k = 0; k < 8; ++k) S[k] = 0.f;
        bf16_t* base = ST + (size_t)bh * 15 * ST_SLOT + off;
        v4u uu[15];
#pragma unroll
        for (int s = 0; s < 15; ++s) uu[s] = *(const v4u*)(base + s * ST_SLOT);
#pragma unroll
        for (int s = 0; s < 15; ++s) { const v4u u = uu[s];
            S[0] = S[0] * cd + bflo(u.x); S[1] = S[1] * cd + bfhi(u.x); S[2] = S[2] * cd + bflo(u.y); S[3] = S[3] * cd + bfhi(u.y);
            S[4] = S[4] * cd + bflo(u.z); S[5] = S[5] * cd + bfhi(u.z); S[6] = S[6] * cd + bflo(u.w); S[7] = S[7] * cd + bfhi(u.w);
            v4u o; o.x = pg8::cvt_pk_bf16(S[0], S[1]); o.y = pg8::cvt_pk_bf16(S[2], S[3]); o.z = pg8::cvt_pk_bf16(S[4], S[5]); o.w = pg8::cvt_pk_bf16(S[6], S[7]);
            *(v4u*)(base + s * ST_SLOT) = o;
        }
    }
}

__device__ void phase_ret_out(const Params& p, unsigned char* lds) {
    const int tid = otid(), wave = __builtin_amdgcn_readfirstlane(tid >> 6), lane = tid & 63, g = lane >> 4, i = lane & 15;
    LAS unsigned char* Ks = (LAS unsigned char*)lds;
    LAS unsigned char* Ps = Ks + 65536;
    LAS float* red = (LAS float*)(Ks + 98304);
    const bf16_t* QK = (const bf16_t*)(p.ws + OFF_BIG + B_QK); const bf16_t* Vt = (const bf16_t*)(p.ws + OFF_BIG + B_V); const bf16_t* ST = (const bf16_t*)(p.ws + OFF_BIG + B_ST);
    bf16_t* O = (bf16_t*)(p.ws + OFF_BIG + B_O);
    for (int unit = obid(); unit < 256; unit += gridDim.x) {
        const int pi = unit & 1, s = (unit >> 1) & 15, bh = unit >> 5, b = bh >> 2, h = bh & 3;
        const float lg = ret_lg(h);
#pragma unroll 1
        for (int half = 0; half < 2; ++half) {
            const int a = half ? 3 - pi : pi;
            const size_t trow0 = (size_t)b * SEQ + s * RL + a * 128;
            v4f o[4][8];
#pragma unroll
            for (int mt = 0; mt < 4; ++mt)
#pragma unroll
                for (int nt = 0; nt < 8; ++nt) o[mt][nt] = (v4f){0.f, 0.f, 0.f, 0.f};
            if (s > 0) {
                const bf16_t* sp = ST + ((size_t)bh * 15 + (s - 1)) * ST_SLOT + (size_t)(wave * 64 + i) * 256 + 8 * g;
                const bf16_t* qp = QK + (trow0 + i) * 2048 + h * 256 + 8 * g;
#pragma unroll 1
                for (int ks = 0; ks < 8; ++ks) {
                    bf16x8_t af[4];
#pragma unroll
                    for (int mt = 0; mt < 4; ++mt) af[mt] = *(const bf16x8_t*)(sp + (size_t)(16 * mt) * 256 + ks * 32);
#pragma unroll
                    for (int nh = 0; nh < 2; ++nh) { bf16x8_t bfq[4];
#pragma unroll
                        for (int nt = 0; nt < 4; ++nt) bfq[nt] = *(const bf16x8_t*)(qp + (size_t)(16 * (nh * 4 + nt)) * 2048 + ks * 32);
#pragma unroll
                        for (int mt = 0; mt < 4; ++mt)
#pragma unroll
                            for (int nt = 0; nt < 4; ++nt) o[mt][nh * 4 + nt] = __builtin_amdgcn_mfma_f32_16x16x32_bf16(af[mt], bfq[nt], o[mt][nh * 4 + nt], 0, 0, 0); }
                }
#pragma unroll
                for (int nt = 0; nt < 8; ++nt) { const float sc = exp2f((float)(a * 128 + nt * 16 + i + 1) * lg);
#pragma unroll
                    for (int mt = 0; mt < 4; ++mt) o[mt][nt] = o[mt][nt] * sc; }
            }
#pragma unroll 1
            for (int j = 0; j <= a; ++j) {
                __syncthreads();
                { const bf16_t* krow = QK + ((size_t)b * SEQ + s * RL + j * 128) * 2048 + 1024 + h * 256;
#pragma unroll
                    for (int it = 0; it < 8; ++it) { const int idx = it * 512 + tid, row = idx >> 5, ch = idx & 31;
                        *(LAS v4u*)(Ks + row * 512 + ((ch ^ (row & 15)) << 4)) = *(const v4u*)(krow + (size_t)row * 2048 + ch * 8); } }
                __syncthreads();
                {
                    const bf16_t* qp = QK + (trow0 + wave * 16 + i) * 2048 + h * 256 + 8 * g;
                    const int prow = wave * 16 + i, tq = a * 128 + prow;
#pragma unroll 1
                    for (int kh = 0; kh < 2; ++kh) {
                        v4f st[4];
#pragma unroll
                        for (int kt = 0; kt < 4; ++kt) st[kt] = (v4f){0.f, 0.f, 0.f, 0.f};
#pragma unroll 2
                        for (int ks = 0; ks < 8; ++ks) { const bf16x8_t bq = *(const bf16x8_t*)(qp + ks * 32);
#pragma unroll
                            for (int kt = 0; kt < 4; ++kt) { const int row = (kh * 4 + kt) * 16 + i; const bf16x8_t ak = *(const LAS bf16x8_t*)(Ks + row * 512 + (((ks * 4 + g) ^ (row & 15)) << 4));
                                st[kt] = __builtin_amdgcn_mfma_f32_16x16x32_bf16(ak, bq, st[kt], 0, 0, 0); } }
#pragma unroll
                        for (int kt = 0; kt < 4; ++kt) { float v[4]; const int ktt = kh * 4 + kt;
#pragma unroll
                            for (int r = 0; r < 4; ++r) { const int dist = tq - (j * 128 + ktt * 16 + 4 * g + r); v[r] = dist >= 0 ? st[kt][r] * exp2f((float)dist * lg) : 0.f; }
                            const int ch = 2 * ktt + (g >> 1);
                            pg8::u32x2 pw; pw.x = pg8::cvt_pk_bf16(v[0], v[1]); pw.y = pg8::cvt_pk_bf16(v[2], v[3]); *(LAS pg8::u32x2*)(Ps + prow * 256 + ((ch ^ (prow & 15)) << 4) + (g & 1) * 8) = pw; }
                    }
                }
                __syncthreads();
                const bf16_t* vp = Vt + (size_t)(h * 512 + wave * 64 + i) * 16384 + (size_t)b * SEQ + s * RL + j * 128 + 8 * g;
#pragma unroll 1
                for (int ks = 0; ks < 4; ++ks) {
                    bf16x8_t af[4];
#pragma unroll
                    for (int mt = 0; mt < 4; ++mt) af[mt] = *(const bf16x8_t*)(vp + (size_t)(16 * mt) * 16384 + ks * 32);
#pragma unroll
                    for (int nh = 0; nh < 2; ++nh) { bf16x8_t bp[4];
#pragma unroll
                        for (int nt = 0; nt < 4; ++nt) { const int row = (nh * 4 + nt) * 16 + i; bp[nt] = *(const LAS bf16x8_t*)(Ps + row * 256 + (((ks * 4 + g) ^ (row & 15)) << 4)); }
#pragma unroll
                        for (int mt = 0; mt < 4; ++mt)
#pragma unroll
                            for (int nt = 0; nt < 4; ++nt) o[mt][nh * 4 + nt] = __builtin_amdgcn_mfma_f32_16x16x32_bf16(af[mt], bp[nt], o[mt][nh * 4 + nt], 0, 0, 0); }
                }
            }
            float ssq[8];
#pragma unroll
            for (int nt = 0; nt < 8; ++nt) { float a2 = 0.f;
#pragma unroll
                for (int mt = 0; mt < 4; ++mt)
#pragma unroll
                    for (int r = 0; r < 4; ++r) a2 += o[mt][nt][r] * o[mt][nt][r];
                a2 += __shfl_xor(a2, 16); a2 += __shfl_xor(a2, 32); ssq[nt] = a2; }
            __syncthreads();
            if (g == 0) {
#pragma unroll
                for (int nt = 0; nt < 8; ++nt) red[wave * 128 + nt * 16 + i] = ssq[nt]; }
            __syncthreads();
#pragma unroll
            for (int nt = 0; nt < 8; ++nt) { float tot = 0.f;
#pragma unroll
                for (int w = 0; w < 8; ++w) tot += red[w * 128 + nt * 16 + i];
                const float rstd = 1.0f / sqrtf(tot * (1.0f / 512.0f) + 1e-6f);
                bf16_t* po = O + (trow0 + nt * 16 + i) * 2048 + h * 512 + wave * 64 + 4 * g;
#pragma unroll
                for (int mt = 0; mt < 4; ++mt) *(uint2*)(po + mt * 16) = make_uint2(pg8::cvt_pk_bf16(o[mt][nt][0] * rstd, o[mt][nt][1] * rstd), pg8::cvt_pk_bf16(o[mt][nt][2] * rstd, o[mt][nt][3] * rstd)); }
        }
    }
}

template <class Epi>
__device__ __forceinline__ void dense_gemm(unsigned char* lds, const bf16_t* A, const bf16_t* Bt, int N, int K, const Epi& E, int M = T) {
    pg8::Gemm g{A, Bt, M, N, K}; pg8::StaticOrder S; S.init(M, N, (int)gridDim.x, obid());
    pg8::gemm_phase<Epi, pg8::StaticOrder, true, true>((LAS unsigned char*)lds, g, S, E);
}

template <int STAGE>
__device__ __forceinline__ void expert_gemm(const Params& p, int L, unsigned char* lds) {
    Route R = get_route(p, L);
    LAS int* tab = (LAS int*)((LAS unsigned char*)lds + 131072);
    __syncthreads();
    if (otid() == 0) { int s = 0, b = 0; for (int e = 0; e < 16; ++e) { const int c = R.cnt[e]; tab[e] = s; tab[32 + e] = c; tab[48 + e] = b; s += ((c + 255) >> 8) * 4; b += (c + 255) & ~255; } tab[16] = s; }
    __syncthreads();
    const bf16_t* E = (const bf16_t*)(p.ws + OFF_BIG + B_E);
    bf16_t* HG = (bf16_t*)(p.ws + OFF_BIG + B_HG); bf16_t* YG = (bf16_t*)(p.ws + OFF_BIG + B_YG);
    if (STAGE == 1) {
        pg8::GroupedOrder<1> S{tab, (int)gridDim.x, obid(), R.list, (const char*)E};
        pg8::EpiExp1 Ep{HG, R.cwl, tab};
        pg8::gemm_phase_g<pg8::EpiExp1, pg8::GroupedOrder<1>, true>((LAS unsigned char*)lds, (const char*)(p.ws + OFF_XN), 1024, S, Ep);
    } else {
        pg8::GroupedOrder<2> S{tab, (int)gridDim.x, obid(), nullptr, (const char*)E + (2u << 20)};
        pg8::EpiExp2 Ep{YG};
        pg8::gemm_phase_g<pg8::EpiExp2, pg8::GroupedOrder<2>, true>((LAS unsigned char*)lds, (const char*)HG, 512, S, Ep);
    }
}

constexpr int NPHASE = 20;
__device__ __forceinline__ void run_phase(const Params& p, int ph, unsigned char* lds) {
    float* sm = (float*)lds;
    unsigned char* big = p.ws + OFF_BIG;
    const bf16_t* XN = (const bf16_t*)(p.ws + OFF_XN);
    const bf16_t* WB = (const bf16_t*)(p.ws + OFF_WB);
    switch (ph) {
    case 0: phase_prologue(p, lds); break;
    case 1: { pg8::EpiInproj E{(bf16_t*)(big + B_QK), (const float*)(p.ws + OFF_TABRET), (const float*)(p.ws + OFF_TABRET) + 8192 * 128};
        dense_gemm(lds, XN, WB + W_IN / 2, 2048, 1024, E);
        pg8::EpiVt E2{(bf16_t*)(big + B_V)};
        dense_gemm(lds, WB + W_IN / 2 + (size_t)2048 * 1024, XN, 16384, 1024, E2, 2048); } break;
    case 2: phase_ret_kv(p, lds); break;
    case 3: phase_ret_scan2(p); break;
    case 4: phase_ret_out(p, lds); break;
    case 5: { pg8::EpiG E{(bf16_t*)(big + B_O)}; dense_gemm(lds, XN, WB + W_IN / 2 + (size_t)4096 * 1024, 2048, 1024, E); } break;
    case 6: { pg8::EpiResid E{p.x, p.out}; dense_gemm(lds, (const bf16_t*)(big + B_O), WB + W_OUT / 2, 1024, 2048, E); } break;
    case 7: convert_expert_weights(p, 0, lds); __syncthreads(); norm_pass<1>(p, 0, lds); break;
    case 8: expert_gemm<1>(p, 0, lds); break;
    case 9: expert_gemm<2>(p, 0, lds); break;
    case 10: norm_pass<2>(p, 0, lds); break;
    case 11: { pg8::EpiKVQ E{(bf16_t*)(big + B_K), (bf16_t*)(big + B_VB), (bf16_t*)(big + B_Q), (const float*)(p.ws + OFF_TABROPE), (const float*)(p.ws + OFF_TABROPE) + 8192 * 16, (float*)(p.ws + OFF_KMEAN)};
        dense_gemm(lds, XN, WB + W_KVQ / 2, 3072, 1024, E); } break;
    case 12: phase_moba_gate(p, lds); break;
    case 13: phase_moba_sel(p, lds); break;
    case 14: phase_moba_own(p, lds); break;
    case 15: { pg8::EpiResid E{p.out, p.out}; dense_gemm(lds, (const bf16_t*)(big + B_AO), WB + W_O / 2, 1024, 1024, E); } break;
    case 16: convert_expert_weights(p, 1, lds); __syncthreads(); norm_pass<1>(p, 1, lds); break;
    case 17: expert_gemm<1>(p, 1, lds); break;
    case 18: expert_gemm<2>(p, 1, lds); break;
    case 19: norm_pass<3>(p, 1, lds); break;
    default: break;
    }
}
constexpr int LAST_PHASE = 19;

#if MK_SINGLE
#define XB_TMO      128
#define XB_XCNT(j)  (256  + 64 * (j))
#define XB_XSUB(j)  (1280 + 64 * (j))
#define XB_XGEN(j)  (2304 + 64 * (j))
#define XB_TOP      3328
#define XB_TOPGEN   3392
#define XCD_BAR_WORDS 3456
#define XB_SPIN_CAP (1u << 18)

__device__ __forceinline__ unsigned xb_ld(unsigned* p)              { return __hip_atomic_load(p, __ATOMIC_RELAXED, __HIP_MEMORY_SCOPE_AGENT); }
__device__ __forceinline__ unsigned xb_add(unsigned* p, unsigned v) { return __hip_atomic_fetch_add(p, v, __ATOMIC_RELAXED, __HIP_MEMORY_SCOPE_AGENT); }
__device__ __forceinline__ unsigned xb_xcc_id() { return (unsigned)__builtin_amdgcn_s_getreg((3 << 11) | 20) & 0xFu; }
#define XB_SPIN(cond, bar) do { unsigned _sp = 0; while (cond) { __builtin_amdgcn_s_sleep(1); \
    if ((++_sp & 255u) == 0u) { if (xb_ld(&(bar)[XB_TMO])) break; if (_sp > XB_SPIN_CAP) { atomicAdd(&(bar)[XB_TMO], 1u); break; } } } } while (0)

struct XcdBarrier {
    unsigned* bar; unsigned x;
    volatile LAS unsigned* st;
};

__device__ __forceinline__ XcdBarrier xcd_barrier_post(unsigned* bar, volatile LAS unsigned* st) {
    XcdBarrier b; b.bar = bar; b.x = xb_xcc_id(); b.st = st;
    if (threadIdx.x == 0) (void)xb_add(&bar[XB_XCNT(b.x)], 1u);
    return b;
}
__device__ __forceinline__ void xcd_barrier_complete(unsigned* bar, unsigned x, unsigned& nloc, unsigned& nx) {
    const unsigned G = gridDim.x * gridDim.y * gridDim.z;
    unsigned sum, cnt, mine, sp = 0u;
    for (;;) {
        sum = 0u; cnt = 0u; mine = 0u;
#pragma unroll
        for (unsigned j = 0; j < 16; ++j) { const unsigned c = xb_ld(&bar[XB_XCNT(j)]); sum += c; cnt += (c > 0u) ? 1u : 0u; mine = (j == x) ? c : mine; }
        if (sum == G) break;
        __builtin_amdgcn_s_sleep(1);
        if ((++sp & 255u) == 0u) { if (xb_ld(&bar[XB_TMO])) break; if (sp > XB_SPIN_CAP) { atomicAdd(&bar[XB_TMO], 1u); break; } }
    }
    nloc = mine > 0u ? mine : 1u; nx = cnt > 0u ? cnt : 1u;
}

__device__ __forceinline__ void xcd_barrier(const XcdBarrier& b) {
    asm volatile("s_waitcnt vmcnt(0)" ::: "memory");
    __syncthreads();
    if (threadIdx.x == 0) {
        unsigned* bar = b.bar;
        __builtin_amdgcn_s_waitcnt(0);
        unsigned nloc = b.st[0], nx = b.st[1];
        if (nloc == 0u) { xcd_barrier_complete(bar, b.x, nloc, nx); b.st[0] = nloc; b.st[1] = nx; }
        const unsigned old = xb_add(&bar[XB_XSUB(b.x)], 1u);
        const unsigned gen = old / nloc;
        if (old + 1u == (gen + 1u) * nloc) {
            __builtin_amdgcn_fence(__ATOMIC_RELEASE, "agent");
            asm volatile("s_waitcnt vmcnt(0)" ::: "memory");
            const unsigned og = xb_add(&bar[XB_TOP], 1u);
            const unsigned tg = og / nx;
            if (og + 1u == (tg + 1u) * nx) xb_add(&bar[XB_TOPGEN], 1u);
            else XB_SPIN(xb_ld(&bar[XB_TOPGEN]) == tg, bar);
            __builtin_amdgcn_fence(__ATOMIC_ACQUIRE, "agent");
            xb_add(&bar[XB_XGEN(b.x)], 1u);
            asm volatile("s_waitcnt vmcnt(0)" ::: "memory");
        } else {
            XB_SPIN(xb_ld(&bar[XB_XGEN(b.x)]) == gen, bar);
            __builtin_amdgcn_fence(__ATOMIC_ACQUIRE, "agent");
            asm volatile("s_waitcnt vmcnt(0)" ::: "memory");
        }
    }
    __syncthreads();
}

constexpr size_t CTRL_BAR_OFF = 65536;
constexpr int PARAM_LDS_OFF = LDS_BYTES - 256;
constexpr int BARST_LDS_OFF = LDS_BYTES - 512;
__device__ __forceinline__ Params get_params(unsigned char* lds) {
    const LAS unsigned* w = (const LAS unsigned*)((LAS unsigned char*)lds + PARAM_LDS_OFF);
    union { Params p; unsigned u[sizeof(Params) / 4]; } x;
#pragma unroll
    for (int k = 0; k < (int)(sizeof(Params) / 4); ++k) x.u[k] = __builtin_amdgcn_readfirstlane(w[k]);
    return x.p;
}
template <int PH> __device__ __forceinline__ void run_all(unsigned char* lds, cg::grid_group& grid, const XcdBarrier& bar) {
#ifdef MK_REP_PHASE
    if constexpr (PH == MK_REP_PHASE) { for (int rep = 0; rep < MK_REP_N; ++rep) { const Params q0 = get_params(lds); run_phase(q0, PH, lds); xcd_barrier(bar); } }
#endif
    { const Params q = get_params(lds); run_phase(q, PH, lds); }
    if constexpr (PH < LAST_PHASE) {
        if constexpr (PH == 0) grid.sync(); else xcd_barrier(bar);
        run_all<PH + 1>(lds, grid, bar);
    }
}
__global__ void __launch_bounds__(512) mega(Params p) {
    extern __shared__ __attribute__((aligned(16))) unsigned char lds[];
    cg::grid_group grid = cg::this_grid();
    if (threadIdx.x == 0) { union { Params p; unsigned u[sizeof(Params) / 4]; } x; x.p = p; LAS unsigned* w = (LAS unsigned*)((LAS unsigned char*)lds + PARAM_LDS_OFF);
#pragma unroll
        for (int k = 0; k < (int)(sizeof(Params) / 4); ++k) w[k] = x.u[k];
        LAS unsigned* st = (LAS unsigned*)((LAS unsigned char*)lds + BARST_LDS_OFF); st[0] = 0u; st[1] = 0u; }
    __syncthreads();
    const XcdBarrier bar = xcd_barrier_post((unsigned*)(p.ws + OFF_CTRL + CTRL_BAR_OFF), (volatile LAS unsigned*)((LAS unsigned char*)lds + BARST_LDS_OFF));
    run_all<0>(lds, grid, bar);
}
#else
template <int PH> __global__ void __launch_bounds__(512) phase_kernel(Params p) {
    extern __shared__ __attribute__((aligned(16))) unsigned char lds[];
    run_phase(p, PH, lds);
}
template <int PH> static void launch_phases(const Params& p, int grid, hipStream_t stream) {
    if constexpr (PH <= LAST_PHASE) {
        static bool attr = false;
        if (!attr) { (void)hipFuncSetAttribute((const void*)phase_kernel<PH>, hipFuncAttributeMaxDynamicSharedMemorySize, LDS_BYTES); attr = true; }
        phase_kernel<PH><<<grid, 512, LDS_BYTES, stream>>>(p); launch_phases<PH + 1>(p, grid, stream); }
}
#endif

extern "C" void kernel_launch(void* const* d_in, const int* in_sizes, int n_in, void* d_out, int out_size, void* d_ws, size_t ws_size, hipStream_t stream) {
    if (ws_size < WS_NEED) { fprintf(stderr, "workspace too small: %zu < %zu\n", ws_size, WS_NEED); return; }
    Params p{};
    p.x = (const float*)d_in[0]; p.ret_norm = (const float*)d_in[1]; p.ret_w_in = (const float*)d_in[2]; p.ret_w_out = (const float*)d_in[3]; p.kv_norm = (const float*)d_in[4];
    p.w_kv = (const float*)d_in[5]; p.attn_norm = (const float*)d_in[6]; p.w_q = (const float*)d_in[7]; p.w_o = (const float*)d_in[8]; p.ffn_norm = (const float*)d_in[9];
    p.rg_w = (const float*)d_in[10]; p.rg_b = (const float*)d_in[11]; p.re_w = (const float*)d_in[12]; p.re_b = (const float*)d_in[13]; p.wg = (const float*)d_in[14];
    p.wu = (const float*)d_in[15]; p.wd = (const float*)d_in[16]; p.final_norm = (const float*)d_in[17];
    p.out = (float*)d_out; p.ws = (unsigned char*)d_ws;
    static int grid_blocks = 0;
    if (!grid_blocks) {
        int dev = 0, cus = 0, per_cu = 0;
        (void)hipGetDevice(&dev);
        (void)hipDeviceGetAttribute(&cus, hipDeviceAttributeMultiprocessorCount, dev);
#if MK_SINGLE
        if (hipFuncSetAttribute((const void*)mega, hipFuncAttributeMaxDynamicSharedMemorySize, LDS_BYTES) != hipSuccess) fprintf(stderr, "hipFuncSetAttribute failed\n");
        if (hipOccupancyMaxActiveBlocksPerMultiprocessor(&per_cu, (const void*)mega, 512, LDS_BYTES) != hipSuccess || per_cu < 1) fprintf(stderr, "occupancy query: %d blocks per CU\n", per_cu);
#endif
        grid_blocks = cus;
    }
#if MK_SINGLE
    if (hipMemsetAsync((unsigned char*)d_ws + OFF_CTRL, 0, 131072, stream) != hipSuccess) fprintf(stderr, "memset failed\n");
    void* args[] = {&p};
    hipError_t e = hipLaunchCooperativeKernel((void*)mega, dim3(grid_blocks), dim3(512), args, LDS_BYTES, stream);
    if (e != hipSuccess) fprintf(stderr, "cooperative launch failed: %s (grid %d)\n", hipGetErrorString(e), grid_blocks);
#else
    launch_phases<0>(p, grid_blocks, stream);
#endif
}
```

```cpp
#include <hip/hip_runtime.h>
#include <hip/hip_cooperative_groups.h>
#include <cstdio>
#include <cstdint>
namespace cg = cooperative_groups;

#ifndef MK_SINGLE
#define MK_SINGLE 1
#endif

typedef unsigned short bf16_t;
#define LAS __attribute__((address_space(3)))
typedef float v4f __attribute__((ext_vector_type(4)));
typedef unsigned v4u __attribute__((ext_vector_type(4)));
constexpr int T = 16384, SEQ = 8192;
constexpr size_t MiB = (size_t)1 << 20;
constexpr size_t OFF_CTRL = 0, OFF_ROUTE = 1 * MiB, OFF_KMEAN = 3 * MiB + 512 * 1024, OFF_TABROPE = 4 * MiB,
                 OFF_WB = 8 * MiB, OFF_XN = 32 * MiB, OFF_BIG = 64 * MiB, OFF_EXTRA = 288 * MiB, OFF_TABRET = OFF_EXTRA, WS_NEED = 304 * MiB;
constexpr size_t W_IN = 0, W_OUT = 12 * MiB, W_KVQ = 16 * MiB, W_O = 22 * MiB;
constexpr int LDS_BYTES = 147456;
constexpr size_t B_QK = 0, B_V = 64 * MiB, B_O = 128 * MiB, B_ST = 192 * MiB;
constexpr size_t B_E = 0, B_HG = 48 * MiB, B_YG = 84 * MiB;
constexpr size_t B_K = 0, B_VB = 32 * MiB, B_Q = 64 * MiB, B_PART = 96 * MiB, B_AO = 192 * MiB;

struct Params {
    const float *x, *ret_norm, *ret_w_in, *ret_w_out, *kv_norm, *w_kv, *attn_norm, *w_q, *w_o, *ffn_norm, *rg_w, *rg_b, *re_w, *re_b, *wg, *wu, *wd, *final_norm;
    float* out; unsigned char* ws;
};

__device__ __forceinline__ int otid() { int t = threadIdx.x; asm volatile("" : "+v"(t)); return t; }
__device__ __forceinline__ int obid() { int b = blockIdx.x; asm volatile("" : "+s"(b)); return b; }
__device__ __forceinline__ bf16_t f2bf(float f) { unsigned u = __float_as_uint(f); u += 0x7fffu + ((u >> 16) & 1u); return (bf16_t)(u >> 16); }
__device__ __forceinline__ float bf2f(bf16_t h) { return __uint_as_float(((unsigned)h) << 16); }
__device__ __forceinline__ float bflo(unsigned u) { return __uint_as_float(u << 16); }
__device__ __forceinline__ float bfhi(unsigned u) { return __uint_as_float(u & 0xffff0000u); }
__device__ __forceinline__ unsigned pack2(float a, float b) { return (unsigned)f2bf(a) | ((unsigned)f2bf(b) << 16); }
__device__ __forceinline__ float wsum(float v) { for (int o = 32; o > 0; o >>= 1) v += __shfl_xor(v, o); return v; }
__device__ __forceinline__ float wmax(float v) { for (int o = 32; o > 0; o >>= 1) v = fmaxf(v, __shfl_xor(v, o)); return v; }
__device__ __forceinline__ float silu(float v) { return v / (1.f + __expf(-v)); }

__device__ void sincos_big(double a, double& s, double& c) {
    const double twopi = 6.283185307179586476925286766559;
    double k = rint(a / twopi); double r = a - k * twopi;
    double x2 = r * r, ts = r, tc = 1.0; s = r; c = 1.0;
#pragma unroll 1
    for (int n = 1; n <= 16; ++n) { tc *= -x2 / (double)((2 * n - 1) * (2 * n)); c += tc; ts *= -x2 / (double)((2 * n) * (2 * n + 1)); s += ts; }
}

struct Route { int* cnt; int *e0, *e1, *p0, *p1; float *w0, *w1; int* list; float* cwl; };
__device__ __forceinline__ Route get_route(const Params& p, int L) {
    Route r; r.cnt = (int*)(p.ws + OFF_CTRL) + L * 16;
    unsigned char* b = p.ws + OFF_ROUTE;
    r.e0 = (int*)b; r.e1 = r.e0 + T; r.p0 = r.e1 + T; r.p1 = r.p0 + T; r.w0 = (float*)(r.p1 + T); r.w1 = r.w0 + T; r.list = (int*)(b + 512 * 1024); r.cwl = (float*)(b + 1536 * 1024);
    return r;
}
__device__ __forceinline__ int expert_base(const int* cnt, int e) { int s = 0; for (int i = 0; i < e; ++i) s += (cnt[i] + 255) & ~255; return s; }

template <int MODE>
__device__ void norm_pass(const Params& p, int L, unsigned char* lds) {
    const int wave = otid() >> 6, lane = otid() & 63;
    LAS float* wr = (LAS float*)(LAS unsigned char*)lds;
    LAS int* ebase = (LAS int*)(LAS unsigned char*)lds;
    if (MODE >= 2) { __syncthreads(); if (otid() < 16) ebase[otid()] = expert_base(get_route(p, L).cnt, otid()); __syncthreads(); }
    LAS int* lcnt = (LAS int*)((LAS unsigned char*)lds + 81920);
    LAS int* rec = lcnt + 64;
    int nrec = 0;
    if (MODE == 1) {
        if (otid() < 16) lcnt[otid()] = 0;
        for (int i = otid(); i < 1024 * 5; i += 512) { const int k = i / 5, part = i % 5;
            float4 w = part == 0 ? *(const float4*)(p.rg_w + ((size_t)L * 1024 + k) * 4) : *(const float4*)(p.re_w + (((size_t)L * 4 + part - 1) * 1024 + k) * 4);
            const float g = p.ffn_norm[L * 1024 + k]; w.x *= g; w.y *= g; w.z *= g; w.w *= g;
            v4f w4 = {w.x, w.y, w.z, w.w}; *(LAS v4f*)(wr + k * 20 + part * 4) = w4; }
        __syncthreads();
    }
    bf16_t* XN = (bf16_t*)(p.ws + OFF_XN);
    const bf16_t* YG = (const bf16_t*)(p.ws + OFF_BIG + B_YG);
    Route R = get_route(p, L);
    for (int t = obid() * 8 + wave; t < T; t += gridDim.x * 8) {
        const float* src = (MODE == 0 ? p.x : p.out) + (size_t)t * 1024;
        float4 v[4];
#pragma unroll
        for (int j = 0; j < 4; ++j) v[j] = *(const float4*)(src + j * 256 + lane * 4);
        if (MODE >= 2) {
            const int r0 = ebase[R.e0[t]] + R.p0[t], r1 = ebase[R.e1[t]] + R.p1[t];
#pragma unroll
            for (int j = 0; j < 4; ++j) {
                uint2 a = *(const uint2*)(YG + (size_t)r0 * 1024 + j * 256 + lane * 4), b = *(const uint2*)(YG + (size_t)r1 * 1024 + j * 256 + lane * 4);
                v[j].x += bflo(a.x) + bflo(b.x); v[j].y += bfhi(a.x) + bfhi(b.x); v[j].z += bflo(a.y) + bflo(b.y); v[j].w += bfhi(a.y) + bfhi(b.y);
            }
        }
        float ss = 0.f;
#pragma unroll
        for (int j = 0; j < 4; ++j) ss += v[j].x * v[j].x + v[j].y * v[j].y + v[j].z * v[j].z + v[j].w * v[j].w;
        ss = wsum(ss);
        const float rstd = 1.0f / sqrtf(ss * (1.0f / 1024.0f) + 1e-6f);
        if (MODE == 2) {
#pragma unroll
            for (int j = 0; j < 4; ++j) *(float4*)(p.out + (size_t)t * 1024 + j * 256 + lane * 4) = v[j];
        }
        if (MODE == 3) {
#pragma unroll
            for (int j = 0; j < 4; ++j) { float4 g = *(const float4*)(p.final_norm + j * 256 + lane * 4);
                float4 o; o.x = v[j].x * rstd * g.x; o.y = v[j].y * rstd * g.y; o.z = v[j].z * rstd * g.z; o.w = v[j].w * rstd * g.w;
                *(float4*)(p.out + (size_t)t * 1024 + j * 256 + lane * 4) = o; }
        } else {
#pragma unroll
            for (int j = 0; j < 4; ++j) { uint2 o; o.x = pack2(v[j].x * rstd, v[j].y * rstd); o.y = pack2(v[j].z * rstd, v[j].w * rstd);
                *(uint2*)(XN + (size_t)t * 1024 + j * 256 + lane * 4) = o; }
        }
        if (MODE == 1) {
            float acc[20];
#pragma unroll
            for (int i = 0; i < 20; ++i) acc[i] = 0.f;
            const LAS float* wl = wr + lane * 80;
            const float tv[4][4] = {{v[0].x * rstd, v[0].y * rstd, v[0].z * rstd, v[0].w * rstd}, {v[1].x * rstd, v[1].y * rstd, v[1].z * rstd, v[1].w * rstd},
                                    {v[2].x * rstd, v[2].y * rstd, v[2].z * rstd, v[2].w * rstd}, {v[3].x * rstd, v[3].y * rstd, v[3].z * rstd, v[3].w * rstd}};
#pragma unroll
            for (int j = 0; j < 4; ++j) {
                asm volatile("" ::: "memory");
                const float tk[4] = {tv[j][0], tv[j][1], tv[j][2], tv[j][3]};
#pragma unroll
                for (int c = 0; c < 4; ++c) {
#pragma unroll
                    for (int q = 0; q < 5; ++q) { const v4f w = *(const LAS v4f*)(wl + j * 5120 + c * 20 + q * 4);
                        acc[q * 4 + 0] += tk[c] * w[0]; acc[q * 4 + 1] += tk[c] * w[1]; acc[q * 4 + 2] += tk[c] * w[2]; acc[q * 4 + 3] += tk[c] * w[3]; }
                }
            }
#pragma unroll
            for (int i = 0; i < 20; ++i) acc[i] = wsum(acc[i]);
            float lg[4];
#pragma unroll
            for (int g = 0; g < 4; ++g) lg[g] = acc[g] + p.rg_b[L * 4 + g];
            int gi = 0; float gm = lg[0];
#pragma unroll
            for (int g = 1; g < 4; ++g) if (lg[g] > gm) { gm = lg[g]; gi = g; }
            float den = 0.f;
#pragma unroll
            for (int g = 0; g < 4; ++g) den += expf(lg[g] - gm);
            const float gval = 1.0f / den;
            float el[4] = {0.f, 0.f, 0.f, 0.f};
#pragma unroll
            for (int g = 0; g < 4; ++g) if (g == gi) {
#pragma unroll
                for (int e = 0; e < 4; ++e) el[e] = acc[4 + g * 4 + e] + p.re_b[(L * 4 + g) * 4 + e]; }
            int i0 = 0; float v0 = el[0];
#pragma unroll
            for (int e = 1; e < 4; ++e) if (el[e] > v0) { v0 = el[e]; i0 = e; }
            int i1 = -1; float v1 = -INFINITY;
#pragma unroll
            for (int e = 0; e < 4; ++e) if (e != i0 && el[e] > v1) { v1 = el[e]; i1 = e; }
            const float ex = expf(v1 - v0); const float ew0 = 1.0f / (1.0f + ex), ew1 = ex / (1.0f + ex);
            if (lane == 0) {
                const int ea = gi * 4 + i0, eb = gi * 4 + i1;
                const int la = __hip_atomic_fetch_add(lcnt + ea, 1, __ATOMIC_RELAXED, __HIP_MEMORY_SCOPE_WORKGROUP), lb = __hip_atomic_fetch_add(lcnt + eb, 1, __ATOMIC_RELAXED, __HIP_MEMORY_SCOPE_WORKGROUP);
                LAS int* rc = rec + (nrec * 8 + wave) * 8;
                rc[0] = t; rc[1] = ea; rc[2] = eb; rc[3] = la; rc[4] = lb; rc[5] = __float_as_int(gval * ew0); rc[6] = __float_as_int(gval * ew1);
            }
            ++nrec;
        }
    }
    if (MODE == 1) {
        __syncthreads();
        if (otid() < 16) { const int c = lcnt[otid()]; lcnt[16 + otid()] = c ? atomicAdd(R.cnt + otid(), c) : 0; }
        __syncthreads();
        for (int r = otid(); r < nrec * 8; r += 512) { const LAS int* rc = rec + r * 8;
            const int t = rc[0], ea = rc[1], eb = rc[2], pa = lcnt[16 + ea] + rc[3], pb = lcnt[16 + eb] + rc[4]; const float wa = __int_as_float(rc[5]), wb = __int_as_float(rc[6]);
            R.list[ea * T + pa] = t; R.list[eb * T + pb] = t; R.cwl[ea * T + pa] = wa; R.cwl[eb * T + pb] = wb;
            R.e0[t] = ea; R.e1[t] = eb; R.p0[t] = pa; R.p1[t] = pb; R.w0[t] = wa; R.w1[t] = wb; }
    }
}

template <int NB, class AF, class BF, class EF>
__device__ __forceinline__ void gemm_tile_naive(int K, const AF& af, const BF& bf, const EF& ef, float* sm) {
    float (*As)[132] = (float (*)[132])sm;
    float (*Bs)[16][68] = (float (*)[16][68])(sm + 16 * 132);
    const int tid = otid(), ty = tid >> 4, tx = tid & 15;
    float acc[NB][4][4];
#pragma unroll
    for (int n = 0; n < NB; ++n)
#pragma unroll
        for (int i = 0; i < 4; ++i)
#pragma unroll
            for (int j = 0; j < 4; ++j) acc[n][i][j] = 0.f;
    const int ar = tid >> 2, ak = (tid & 3) * 4, bk = tid >> 5, bc = (tid & 31) * 2;
    for (int k0 = 0; k0 < K; k0 += 16) {
        const float4 a = af(ar, k0 + ak);
        float2 b[NB];
#pragma unroll
        for (int n = 0; n < NB; ++n) b[n] = bf(n, k0 + bk, bc);
        __syncthreads();
        As[ak + 0][ar] = a.x; As[ak + 1][ar] = a.y; As[ak + 2][ar] = a.z; As[ak + 3][ar] = a.w;
#pragma unroll
        for (int n = 0; n < NB; ++n) { Bs[n][bk][bc] = b[n].x; Bs[n][bk][bc + 1] = b[n].y; }
        __syncthreads();
#pragma unroll
        for (int kk = 0; kk < 16; ++kk) {
            const float4 av = *(const float4*)&As[kk][ty * 4];
            const float a4[4] = {av.x, av.y, av.z, av.w};
#pragma unroll
            for (int n = 0; n < NB; ++n) { const float4 bv = *(const float4*)&Bs[n][kk][tx * 4]; const float b4[4] = {bv.x, bv.y, bv.z, bv.w};
#pragma unroll
                for (int i = 0; i < 4; ++i)
#pragma unroll
                    for (int j = 0; j < 4; ++j) acc[n][i][j] += a4[i] * b4[j]; }
        }
    }
#pragma unroll
    for (int i = 0; i < 4; ++i)
#pragma unroll
        for (int j = 0; j < 4; ++j) ef(ty * 4 + i, tx * 4 + j, acc[0][i][j], NB == 2 ? acc[NB - 1][i][j] : 0.f);
}

__device__ __forceinline__ float4 ld_bf4(const bf16_t* p) { const uint2 u = *(const uint2*)p; return make_float4(bflo(u.x), bfhi(u.x), bflo(u.y), bfhi(u.y)); }

template <class EF>
__device__ void gemm_dense_naive(const bf16_t* A, int lda, int K, int N, const float* B0, int ldb0, const float* gain0, int nsplit, const float* B1, int ldb1, const float* gain1, const EF& ef, float* sm) {
    const int ntn = N / 64, ntm = T / 128;
    for (int tile = obid(); tile < ntn * ntm; tile += gridDim.x) {
        const int tm = tile / ntn, tn = tile % ntn, m0 = tm * 128, n0 = tn * 64;
        const float* B; int ldb; const float* gain; int nb0;
        if (n0 < nsplit) { B = B0; ldb = ldb0; gain = gain0; nb0 = n0; } else { B = B1; ldb = ldb1; gain = gain1; nb0 = n0 - nsplit; }
        auto af = [&](int r, int k) { return ld_bf4(A + (size_t)(m0 + r) * lda + k); };
        auto bf = [&](int, int k, int c) { float2 w = *(const float2*)(B + (size_t)k * ldb + nb0 + c); const float g = gain ? gain[k] : 1.f; w.x *= g; w.y *= g; return w; };
        auto e2 = [&](int r, int c, float v, float) { ef(m0 + r, n0 + c, v); };
        gemm_tile_naive<1>(K, af, bf, e2, sm);
    }
}

template <int STAGE>
__device__ void gemm_expert_naive(const Params& p, int L, float* sm) {
    Route R = get_route(p, L);
    const bf16_t* XN = (const bf16_t*)(p.ws + OFF_XN);
    bf16_t* HG = (bf16_t*)(p.ws + OFF_BIG + B_HG); bf16_t* YG = (bf16_t*)(p.ws + OFF_BIG + B_YG);
    const int ntn = STAGE == 1 ? 512 / 64 : 1024 / 64;
    int* tstart = (int*)(sm + 6000);
    __syncthreads();
    if (otid() == 0) { int s = 0; for (int e = 0; e < 16; ++e) { tstart[e] = s; s += ((R.cnt[e] + 127) >> 7) * ntn; } tstart[16] = s; }
    __syncthreads();
    for (int tile = obid(); tile < tstart[16]; tile += gridDim.x) {
        int e = 0;
#pragma unroll 1
        for (int i = 1; i < 16; ++i) if (tile >= tstart[i]) e = i;
        const int lt = tile - tstart[e], tm = lt / ntn, tn = lt % ntn, m0 = tm * 128, n0 = tn * 64, cnt = R.cnt[e], base = expert_base(R.cnt, e);
        const int* list = R.list + e * T;
        if (STAGE == 1) {
            const float* Wg = p.wg + ((size_t)(L * 16 + e)) * 1024 * 512; const float* Wu = p.wu + ((size_t)(L * 16 + e)) * 1024 * 512; const float* gain = p.ffn_norm + L * 1024;
            auto af = [&](int r, int k) { const int rr = m0 + r; if (rr >= cnt) return make_float4(0.f, 0.f, 0.f, 0.f); return ld_bf4(XN + (size_t)list[rr] * 1024 + k); };
            auto bf = [&](int n, int k, int c) { float2 w = *(const float2*)((n == 0 ? Wg : Wu) + (size_t)k * 512 + n0 + c); const float g = gain[k]; w.x *= g; w.y *= g; return w; };
            auto ef = [&](int r, int c, float g, float u) { const int rr = m0 + r; if (rr >= cnt) return; const int tok = list[rr]; const float cw = (R.e0[tok] == e) ? R.w0[tok] : R.w1[tok];
                HG[(size_t)(base + rr) * 512 + n0 + c] = f2bf(silu(g) * u * cw); };
            gemm_tile_naive<2>(1024, af, bf, ef, sm);
        } else {
            const float* Wd = p.wd + ((size_t)(L * 16 + e)) * 512 * 1024;
            auto af = [&](int r, int k) { const int rr = m0 + r; if (rr >= cnt) return make_float4(0.f, 0.f, 0.f, 0.f); return ld_bf4(HG + (size_t)(base + rr) * 512 + k); };
            auto bf = [&](int, int k, int c) { return *(const float2*)(Wd + (size_t)k * 1024 + n0 + c); };
            auto ef = [&](int r, int c, float v, float) { const int rr = m0 + r; if (rr >= cnt) return; YG[(size_t)(base + rr) * 1024 + n0 + c] = f2bf(v); };
            gemm_tile_naive<1>(512, af, bf, ef, sm);
        }
    }
}


namespace pg8 {
#define PG8_LAS __attribute__((address_space(3)))
typedef unsigned short bf16_t;
typedef short bf16x8 __attribute__((ext_vector_type(8)));
typedef float f32x4 __attribute__((ext_vector_type(4)));
typedef unsigned u32x4 __attribute__((ext_vector_type(4)));
constexpr int BM = 256, BK = 64, HALF = 128, HTB = HALF * BK * 2  , STAGE_BYTES = 8 * HTB, NXCD = 8, WGM = 8;

__host__ __device__ __forceinline__ int lds_byte(int r, int c) { const int st = (r >> 4) * 2 + (c >> 5), rr = r & 15, cc = c & 31, ob = rr * 64 + cc * 2; return st * 1024 + (ob ^ (((ob >> 9) & 1) << 5)); }
__host__ __device__ __forceinline__ void stage_rc(int b, int& R, int& C) { const int st = b / 1024, sb = b % 1024, swz = sb ^ (((sb >> 9) & 1) << 5); R = (st >> 1) * 16 + swz / 64; C = (st & 1) * 32 + (swz % 64) / 2; }
__host__ __device__ __forceinline__ int perm32(int rho) { const int n = rho >> 4, i = rho & 15; return 8 * (i >> 2) + 4 * n + (i & 3); }

struct Unit { int pm, pn; };
struct Gemm { const bf16_t* A; const bf16_t* Bt; int M, N, K; };

struct StaticOrder {
    int nM, nN, nwg, G, c;
    __host__ __device__ void init(int M, int N, int G_, int c_) { nM = M / BM; nN = N / BM; nwg = nM * nN; G = G_; c = c_; }
    __host__ __device__ bool next(int i, Unit& u) const {
        const long L = (long)i * G + c; if (L >= nwg) return false;
        int wgid = (int)L; { const int q = nwg / NXCD, r = nwg % NXCD, xcd = wgid % NXCD, off = wgid / NXCD; wgid = (xcd < r ? xcd * (q + 1) : r * (q + 1) + (xcd - r) * q) + off; }
        const int nig = WGM * nN, gid = wgid / nig, fm = gid * WGM, gsz = (nM - fm) < WGM ? (nM - fm) : WGM;
        u.pm = fm + ((wgid % nig) % gsz); u.pn = (wgid % nig) / gsz; return true;
    }
    __device__ __forceinline__ void a_ready(const Unit&) const {}
    __device__ __forceinline__ void done(const Unit&) const {}
};


__device__ __forceinline__ unsigned cvt_pk_bf16(float lo, float hi) { unsigned r; asm volatile("v_cvt_pk_bf16_f32 %0, %1, %2" : "=v"(r) : "v"(lo), "v"(hi)); return r; }
__device__ __forceinline__ u32x4 pk8(const f32x4& a, const f32x4& b) { u32x4 w; w.x = cvt_pk_bf16(a[0], a[1]); w.y = cvt_pk_bf16(a[2], a[3]); w.z = cvt_pk_bf16(b[0], b[1]); w.w = cvt_pk_bf16(b[2], b[3]); return w; }
typedef unsigned u32x2 __attribute__((ext_vector_type(2)));
__device__ __forceinline__ u32x2 pk4(const f32x4& a) { u32x2 w; w.x = cvt_pk_bf16(a[0], a[1]); w.y = cvt_pk_bf16(a[2], a[3]); return w; }
__device__ __forceinline__ float fsilu(float v) { return v * __builtin_amdgcn_rcpf(1.f + __expf(-v)); }

struct EpiInproj {
    static constexpr bool PERM = true, AFTER_DRAIN = false;
    bf16_t* QK; const float* rc; const float* rs;
    __device__ __forceinline__ void operator()(const f32x4 (&acc)[2][2][4][2], const Unit& u, int wr, int wc, int fr, int fq) const {
        const int row0 = u.pm * BM + wr * 64 + fr;
        {
            const int f0 = wc * 32 + 8 * fq;
#pragma unroll
            for (int ai = 0; ai < 2; ++ai)
#pragma unroll
                for (int m = 0; m < 4; ++m) { const int r = row0 + ai * HALF + m * 16, pos = r & 8191;
                    const f32x4 c0 = *(const f32x4*)(rc + pos * 128 + f0), c1 = *(const f32x4*)(rc + pos * 128 + f0 + 4), s0 = *(const f32x4*)(rs + pos * 128 + f0), s1 = *(const f32x4*)(rs + pos * 128 + f0 + 4);
                    const f32x4 x1a = acc[ai][0][m][0], x1b = acc[ai][0][m][1], x2a = acc[ai][1][m][0], x2b = acc[ai][1][m][1];
                    bf16_t* p = QK + (size_t)r * 2048 + u.pn * 256 + f0;
                    *(u32x4*)p = pk8(x1a * c0 - x2a * s0, x1b * c1 - x2b * s1);
                    *(u32x4*)(p + 128) = pk8(x2a * c0 + x1a * s0, x2b * c1 + x1b * s1); }
        }
    }
};
struct EpiVt {
    static constexpr bool PERM = true, AFTER_DRAIN = false;
    bf16_t* Vt;
    __device__ __forceinline__ void operator()(const f32x4 (&acc)[2][2][4][2], const Unit& u, int wr, int wc, int fr, int fq) const {
        const int row0 = u.pm * BM + wr * 64 + fr;
#pragma unroll
        for (int ai = 0; ai < 2; ++ai)
#pragma unroll
            for (int m = 0; m < 4; ++m) { bf16_t* p = Vt + (size_t)(row0 + ai * HALF + m * 16) * 16384 + u.pn * BM + wc * 32 + 8 * fq;
#pragma unroll
                for (int bj = 0; bj < 2; ++bj) *(u32x4*)(p + bj * HALF) = pk8(acc[ai][bj][m][0], acc[ai][bj][m][1]); }
    }
};
struct EpiStore2048 {
    static constexpr bool PERM = true, AFTER_DRAIN = false;
    bf16_t* D;
    __device__ __forceinline__ void operator()(const f32x4 (&acc)[2][2][4][2], const Unit& u, int wr, int wc, int fr, int fq) const {
        const int row0 = u.pm * BM + wr * 64 + fr;
#pragma unroll
        for (int ai = 0; ai < 2; ++ai)
#pragma unroll
            for (int m = 0; m < 4; ++m) { bf16_t* p = D + (size_t)(row0 + ai * HALF + m * 16) * 2048 + u.pn * BM + wc * 32 + 8 * fq;
#pragma unroll
                for (int bj = 0; bj < 2; ++bj) *(u32x4*)(p + bj * HALF) = pk8(acc[ai][bj][m][0], acc[ai][bj][m][1]); }
    }
};
struct EpiG {
    static constexpr bool PERM = true, AFTER_DRAIN = false;
    bf16_t* O;
    __device__ __forceinline__ void operator()(const f32x4 (&acc)[2][2][4][2], const Unit& u, int wr, int wc, int fr, int fq) const {
        const int row0 = u.pm * BM + wr * 64 + fr;
#pragma unroll
        for (int ai = 0; ai < 2; ++ai)
#pragma unroll
            for (int m = 0; m < 4; ++m) { const int r = row0 + ai * HALF + m * 16; bf16_t* p = O + (size_t)r * 2048 + u.pn * 256 + wc * 32 + 8 * fq;
#pragma unroll
                for (int bj = 0; bj < 2; ++bj) { const u32x4 o = *(const u32x4*)(p + bj * HALF); const f32x4 g0 = acc[ai][bj][m][0], g1 = acc[ai][bj][m][1];
                    f32x4 y0, y1; y0[0] = fsilu(g0[0]) * bflo(o.x); y0[1] = fsilu(g0[1]) * bfhi(o.x); y0[2] = fsilu(g0[2]) * bflo(o.y); y0[3] = fsilu(g0[3]) * bfhi(o.y);
                    y1[0] = fsilu(g1[0]) * bflo(o.z); y1[1] = fsilu(g1[1]) * bfhi(o.z); y1[2] = fsilu(g1[2]) * bflo(o.w); y1[3] = fsilu(g1[3]) * bfhi(o.w);
                    *(u32x4*)(p + bj * HALF) = pk8(y0, y1); } }
    }
};
struct EpiResid {
    static constexpr bool PERM = false, AFTER_DRAIN = false;
    const float* base; float* out;
    __device__ __forceinline__ void operator()(const f32x4 (&acc)[2][2][4][2], const Unit& u, int wr, int wc, int fr, int fq) const {
        const int row0 = u.pm * BM + wr * 64 + fr, col0 = u.pn * BM + wc * 32 + 4 * fq;
#pragma unroll
        for (int ai = 0; ai < 2; ++ai)
#pragma unroll
            for (int m = 0; m < 4; ++m) { const size_t off = (size_t)(row0 + ai * HALF + m * 16) * 1024 + col0;
#pragma unroll
                for (int bj = 0; bj < 2; ++bj)
#pragma unroll
                    for (int n = 0; n < 2; ++n) { const f32x4 b = *(const f32x4*)(base + off + bj * HALF + n * 16); *(f32x4*)(out + off + bj * HALF + n * 16) = b + acc[ai][bj][m][n]; } }
    }
};
struct EpiKVQ {
    static constexpr bool PERM = false, AFTER_DRAIN = false;
    bf16_t *K, *Vb, *Q; const float* pc; const float* ps; float* kms;
    __device__ __forceinline__ void operator()(const f32x4 (&acc)[2][2][4][2], const Unit& u, int wr, int wc, int fr, int fq) const {
        const int which = u.pn >> 2; bf16_t* dst = K + (size_t)which * (16u << 20);
        const int row0 = u.pm * BM + wr * 64 + fr, col0 = (u.pn & 3) * BM + wc * 32 + 4 * fq;
        const bool rot = (which != 1) && (wc == 0);
        f32x4 cs[2][2];
#pragma unroll
        for (int bj = 0; bj < 2; ++bj) { cs[bj][0] = (f32x4){0.f, 0.f, 0.f, 0.f}; cs[bj][1] = (f32x4){0.f, 0.f, 0.f, 0.f}; }
#pragma unroll
        for (int ai = 0; ai < 2; ++ai)
#pragma unroll
            for (int m = 0; m < 4; ++m) { const int r = row0 + ai * HALF + m * 16, pos = r & 8191;
                f32x4 c = {1.f, 1.f, 1.f, 1.f}, s = {0.f, 0.f, 0.f, 0.f};
                if (rot) { c = *(const f32x4*)(pc + pos * 16 + 4 * fq); s = *(const f32x4*)(ps + pos * 16 + 4 * fq); }
#pragma unroll
                for (int bj = 0; bj < 2; ++bj) { f32x4 v0 = acc[ai][bj][m][0], v1 = acc[ai][bj][m][1];
                    if (rot) { const f32x4 y0 = v0 * c - v1 * s, y1 = v1 * c + v0 * s; v0 = y0; v1 = y1; }
                    cs[bj][0] += v0; cs[bj][1] += v1;
                    bf16_t* p = dst + (size_t)r * 1024 + col0 + bj * HALF;
                    *(u32x2*)p = pk4(v0); *(u32x2*)(p + 16) = pk4(v1); } }
        if (which == 0) {
#pragma unroll
            for (int bj = 0; bj < 2; ++bj)
#pragma unroll
                for (int n = 0; n < 2; ++n)
#pragma unroll
                    for (int j = 0; j < 4; ++j) { float v = cs[bj][n][j]; v += __shfl_xor(v, 1); v += __shfl_xor(v, 2); v += __shfl_xor(v, 4); v += __shfl_xor(v, 8); cs[bj][n][j] = v; }
            if (fr == 0) { const int b = u.pm >> 5, blk = u.pm & 31;
#pragma unroll
                for (int bj = 0; bj < 2; ++bj)
#pragma unroll
                    for (int n = 0; n < 2; ++n) { const int h = (u.pn & 3) * 2 + bj; float* d = kms + (((size_t)b * 8 + h) * 32 + blk) * 128 + wc * 32 + 16 * n + 4 * fq;
#pragma unroll
                        for (int j = 0; j < 4; ++j) atomicAdd(d + j, cs[bj][n][j]); } }
        }
    }
};
template <class Epi, class Sched, bool ALIGN_EPI = false, bool SP2 = false>
__device__ __forceinline__ void gemm_phase(PG8_LAS unsigned char* lds, const Gemm g, const Sched& S, const Epi& E) {
    const int tid = otid(), wid = __builtin_amdgcn_readfirstlane(tid >> 6), lane = tid & 63, wr = wid >> 2, wc = wid & 3, fr = lane & 15, fq = lane >> 4;
    const int K = g.K, nt = K / BK;
    unsigned voffA[2], voffB[2];
#pragma unroll
    for (int i = 0; i < 2; ++i) { int R, C; stage_rc(tid * 16 + i * 8192, R, C); const int Rb = Epi::PERM ? ((R & ~31) + perm32(R & 31)) : R;
        voffA[i] = (unsigned)(R * K + C) * 2u; voffB[i] = (unsigned)(Rb * K + C) * 2u; }
    const size_t kstep = (size_t)(BK * 2);
    const size_t hstep = (size_t)HALF * K * 2;
    const size_t tstep = 2 * hstep;
    const unsigned ldsw = (unsigned)wid * 1024u;
    const int aoff = lds_byte(wr * 64 + fr, fq * 8), boff = lds_byte(wc * 32 + fr, fq * 8);
#define PG8_SA(b, h) (((b) * 2 + (h)) * HTB)
#define PG8_SB(b, h) ((4 + (b) * 2 + (h)) * HTB)
#define PG8_STAGE(bufoff, gbase, voff) do { _Pragma("unroll") for (int _i = 0; _i < 2; ++_i) \
        __builtin_amdgcn_global_load_lds((const unsigned*)((const char*)(gbase) + (voff)[_i]), (PG8_LAS unsigned*)(lds + (bufoff) + ldsw + _i * 8192), 16, 0, 0); } while (0)
#define PG8_LDA(dst, b, h) do { _Pragma("unroll") for (int m = 0; m < 4; ++m) _Pragma("unroll") for (int k = 0; k < 2; ++k) dst[m][k] = *(const PG8_LAS bf16x8*)(lds + PG8_SA(b, h) + aoff + m * 2048 + k * 1024); } while (0)
#define PG8_LDB(dst, b, h) do { _Pragma("unroll") for (int n = 0; n < 2; ++n) _Pragma("unroll") for (int k = 0; k < 2; ++k) dst[n][k] = *(const PG8_LAS bf16x8*)(lds + PG8_SB(b, h) + boff + n * 2048 + k * 1024); } while (0)
#define PG8_MMA(ai, bj, At, Bt) do { __builtin_amdgcn_s_setprio(1); _Pragma("unroll") for (int m = 0; m < 4; ++m) _Pragma("unroll") for (int n = 0; n < 2; ++n) _Pragma("unroll") for (int k = 0; k < 2; ++k) \
        acc[ai][bj][m][n] = __builtin_amdgcn_mfma_f32_16x16x32_bf16(Bt[n][k], At[m][k], acc[ai][bj][m][n], 0, 0, 0); __builtin_amdgcn_s_setprio(0); } while (0)
#define PG8_WAIT_V(n) asm volatile("s_waitcnt vmcnt(" #n ")" ::: "memory")
#define PG8_WAIT_L(n) asm volatile("s_waitcnt lgkmcnt(" #n ")" ::: "memory")
#define PG8_BAR __builtin_amdgcn_s_barrier()
#define PG8_SCHED __builtin_amdgcn_sched_barrier(0)
    Unit cur, nxt; int ui = 0;
    if (!S.next(0, cur)) return;
    f32x4 acc[2][2][4][2];
#pragma unroll
    for (int a = 0; a < 2; ++a)
#pragma unroll
        for (int b = 0; b < 2; ++b)
#pragma unroll
            for (int m = 0; m < 4; ++m)
#pragma unroll
                for (int n = 0; n < 2; ++n) acc[a][b][m][n] = (f32x4){0.f, 0.f, 0.f, 0.f};
    bf16x8 At[4][2], B0[2][2], B1[2][2];
    const char* cA = (const char*)g.A + (size_t)cur.pm * tstep; const char* cB = (const char*)g.Bt + (size_t)cur.pn * tstep;
    S.a_ready(cur);
    if constexpr (SP2) {
        PG8_STAGE(PG8_SB(0, 0), cB, voffB); PG8_STAGE(PG8_SB(0, 1), cB + hstep, voffB); PG8_STAGE(PG8_SA(0, 0), cA, voffA); PG8_STAGE(PG8_SA(0, 1), cA + hstep, voffA);
        if (wr == 1) PG8_BAR;
        PG8_WAIT_V(2); PG8_BAR;
        PG8_STAGE(PG8_SB(1, 0), cB + kstep, voffB); PG8_STAGE(PG8_SA(1, 0), cA + kstep, voffA); PG8_STAGE(PG8_SB(1, 1), cB + hstep + kstep, voffB);
        PG8_WAIT_V(6); PG8_BAR;
    } else {
        PG8_STAGE(PG8_SB(0, 0), cB, voffB); PG8_STAGE(PG8_SA(0, 0), cA, voffA); PG8_STAGE(PG8_SB(0, 1), cB + hstep, voffB); PG8_STAGE(PG8_SA(0, 1), cA + hstep, voffA);
        if (wr == 1) PG8_BAR;
        PG8_WAIT_V(4); PG8_BAR;
        PG8_STAGE(PG8_SB(1, 0), cB + kstep, voffB); PG8_STAGE(PG8_SA(1, 0), cA + kstep, voffA); PG8_STAGE(PG8_SB(1, 1), cB + hstep + kstep, voffB);
        PG8_WAIT_V(6); PG8_BAR;
    }
    for (;;) {
        const bool has_next = S.next(ui + 1, nxt);
        const char* nA = has_next ? (const char*)g.A + (size_t)nxt.pm * tstep : cA; const char* nB = has_next ? (const char*)g.Bt + (size_t)nxt.pn * tstep : cB;
        for (int t = 0; t < nt; t += 2) {
            const bool last = (t == nt - 2);
            const char* a1 = cA + (size_t)(t + 1) * kstep;
            const char* a2 = last ? nA : cA + (size_t)(t + 2) * kstep; const char* b2 = last ? nB : cB + (size_t)(t + 2) * kstep;
            const char* a3 = a2 + kstep; const char* b3 = b2 + kstep;
            if (last && has_next) S.a_ready(nxt);
            if constexpr (SP2) {
            PG8_LDB(B0, 0, 0); PG8_LDB(B1, 0, 1); PG8_SCHED; PG8_LDA(At, 0, 0); PG8_STAGE(PG8_SA(1, 1), a1 + hstep, voffA);
            PG8_WAIT_V(8); PG8_WAIT_L(0); PG8_BAR; PG8_MMA(0, 0, At, B0); PG8_MMA(0, 1, At, B1); PG8_BAR; PG8_SCHED;
            PG8_LDA(At, 0, 1); PG8_STAGE(PG8_SB(0, 0), b2, voffB); PG8_STAGE(PG8_SB(0, 1), b2 + hstep, voffB); PG8_STAGE(PG8_SA(0, 0), a2, voffA);
            PG8_WAIT_V(8); PG8_WAIT_L(0); PG8_BAR; PG8_MMA(1, 0, At, B0); PG8_MMA(1, 1, At, B1); PG8_BAR; PG8_SCHED;
            PG8_LDB(B0, 1, 0); PG8_LDB(B1, 1, 1); PG8_SCHED; PG8_LDA(At, 1, 0); PG8_STAGE(PG8_SA(0, 1), a2 + hstep, voffA);
            PG8_WAIT_V(8); PG8_WAIT_L(0); PG8_BAR; PG8_MMA(0, 0, At, B0); PG8_MMA(0, 1, At, B1); PG8_BAR; PG8_SCHED;
            PG8_LDA(At, 1, 1); PG8_STAGE(PG8_SB(1, 0), b3, voffB); PG8_STAGE(PG8_SB(1, 1), b3 + hstep, voffB); PG8_STAGE(PG8_SA(1, 0), a3, voffA);
            PG8_WAIT_V(8); PG8_WAIT_L(0); PG8_BAR; PG8_MMA(1, 0, At, B0); PG8_MMA(1, 1, At, B1); PG8_BAR; PG8_SCHED;
            } else {
            PG8_LDB(B0, 0, 0); PG8_SCHED; PG8_LDA(At, 0, 0); PG8_STAGE(PG8_SA(1, 1), a1 + hstep, voffA);
            PG8_WAIT_L(8); PG8_BAR; PG8_WAIT_L(0); PG8_MMA(0, 0, At, B0); PG8_BAR; PG8_SCHED;
            PG8_LDB(B1, 0, 1); PG8_STAGE(PG8_SB(0, 0), b2, voffB);
            PG8_BAR; PG8_WAIT_L(0); PG8_MMA(0, 1, At, B1); PG8_BAR;
            PG8_LDA(At, 0, 1); PG8_STAGE(PG8_SA(0, 0), a2, voffA);
            PG8_BAR; PG8_WAIT_L(0); PG8_MMA(1, 0, At, B0); PG8_BAR; PG8_SCHED;
            PG8_STAGE(PG8_SB(0, 1), b2 + hstep, voffB);
            PG8_WAIT_V(6); PG8_BAR; PG8_MMA(1, 1, At, B1); PG8_BAR;
            PG8_LDB(B0, 1, 0); PG8_SCHED; PG8_LDA(At, 1, 0); PG8_STAGE(PG8_SA(0, 1), a2 + hstep, voffA);
            PG8_WAIT_L(8); PG8_BAR; PG8_WAIT_L(0); PG8_MMA(0, 0, At, B0); PG8_BAR; PG8_SCHED;
            PG8_LDB(B1, 1, 1); PG8_STAGE(PG8_SB(1, 0), b3, voffB);
            PG8_BAR; PG8_WAIT_L(0); PG8_MMA(0, 1, At, B1); PG8_BAR;
            PG8_LDA(At, 1, 1); PG8_STAGE(PG8_SA(1, 0), a3, voffA);
            PG8_BAR; PG8_WAIT_L(0); PG8_MMA(1, 0, At, B0); PG8_BAR; PG8_SCHED;
            PG8_STAGE(PG8_SB(1, 1), b3 + hstep, voffB);
            PG8_WAIT_V(6); PG8_BAR; PG8_MMA(1, 1, At, B1); PG8_BAR;
            }
        }
        if constexpr (ALIGN_EPI) { if (wr == 0) PG8_BAR; }
        if constexpr (!Epi::AFTER_DRAIN) { E(acc, cur, wr, wc, fr, fq); S.done(cur); }
        if (!has_next) break;
#pragma unroll
        for (int a = 0; a < 2; ++a)
#pragma unroll
            for (int b = 0; b < 2; ++b)
#pragma unroll
                for (int m = 0; m < 4; ++m)
#pragma unroll
                    for (int n = 0; n < 2; ++n) acc[a][b][m][n] = (f32x4){0.f, 0.f, 0.f, 0.f};
        cur = nxt; cA = nA; cB = nB; ++ui;
        if constexpr (ALIGN_EPI) { if (wr == 1) PG8_BAR; }
    }
    PG8_WAIT_V(0);
    if constexpr (!ALIGN_EPI) { if (wr == 0) PG8_BAR; }
    PG8_BAR;
    if constexpr (Epi::AFTER_DRAIN) { E.fused(acc, cur, wr, wc, fr, fq, lds, wid, lane); S.done(cur); }
#undef PG8_SA
#undef PG8_SB
#undef PG8_STAGE
#undef PG8_LDA
#undef PG8_LDB
#undef PG8_MMA
#undef PG8_WAIT_V
#undef PG8_WAIT_L
#undef PG8_BAR
#undef PG8_SCHED
}

struct GUnit { int pm, pn, e, row0; };
template <int STAGE> struct GroupedOrder {
    typedef GUnit UnitT;
    const PG8_LAS int* tab; int G, c; const int* list; const char* Bt;
    __device__ __forceinline__ bool next(int i, GUnit& u) const {
        const int L = i * G + c; if (L >= tab[16]) return false;
        int e = 0;
#pragma unroll
        for (int j = 1; j < 16; ++j) e = (L >= tab[j]) ? j : e;
        const int lt = L - tab[e]; u.e = e; u.pm = lt >> 2; u.pn = lt & 3; u.row0 = tab[48 + e] + u.pm * 256; return true;
    }
    __device__ __forceinline__ unsigned rowoff(const GUnit& u, int r) const {
        if (STAGE == 1) { const int idx = u.pm * 256 + r; const int tok = idx < tab[32 + u.e] ? list[u.e * T + idx] : 0; return (unsigned)tok * 2048u; }
        return (unsigned)(u.row0 + r) * 1024u;
    }
    __device__ __forceinline__ const char* bbase(const GUnit& u) const { return Bt + (size_t)u.e * (3u << 20) + (size_t)u.pn * (STAGE == 1 ? 256 * 1024 * 2 : 256 * 512 * 2); }
    __device__ __forceinline__ void a_ready(const GUnit&) const {}
    __device__ __forceinline__ void done(const GUnit&) const {}
};
struct EpiExp1 {
    static constexpr bool PERM = true, AFTER_DRAIN = false;
    bf16_t* HG; const float* cwl; const PG8_LAS int* tab;
    __device__ __forceinline__ void operator()(const f32x4 (&acc)[2][2][4][2], const GUnit& u, int wr, int wc, int fr, int fq) const {
        const int cnt = tab[32 + u.e];
#pragma unroll
        for (int ai = 0; ai < 2; ++ai)
#pragma unroll
            for (int m = 0; m < 4; ++m) { const int rl = wr * 64 + fr + ai * HALF + m * 16, idx = u.pm * 256 + rl;
                const float cw = idx < cnt ? cwl[u.e * T + idx] : 0.f;
                const f32x4 g0 = acc[ai][0][m][0], g1 = acc[ai][0][m][1], u0 = acc[ai][1][m][0], u1 = acc[ai][1][m][1];
                f32x4 h0, h1;
#pragma unroll
                for (int j = 0; j < 4; ++j) { h0[j] = fsilu(g0[j]) * u0[j] * cw; h1[j] = fsilu(g1[j]) * u1[j] * cw; }
                *(u32x4*)(HG + (size_t)(u.row0 + rl) * 512 + u.pn * 128 + wc * 32 + 8 * fq) = pk8(h0, h1); }
    }
};
struct EpiExp2 {
    static constexpr bool PERM = true, AFTER_DRAIN = false;
    bf16_t* YG;
    __device__ __forceinline__ void operator()(const f32x4 (&acc)[2][2][4][2], const GUnit& u, int wr, int wc, int fr, int fq) const {
#pragma unroll
        for (int ai = 0; ai < 2; ++ai)
#pragma unroll
            for (int m = 0; m < 4; ++m) { const int rl = wr * 64 + fr + ai * HALF + m * 16; bf16_t* p = YG + (size_t)(u.row0 + rl) * 1024 + u.pn * 256 + wc * 32 + 8 * fq;
#pragma unroll
                for (int bj = 0; bj < 2; ++bj) *(u32x4*)(p + bj * HALF) = pk8(acc[ai][bj][m][0], acc[ai][bj][m][1]); }
    }
};
template <class Epi, class Sched, bool ALIGN_EPI = false>
__device__ __forceinline__ void gemm_phase_g(PG8_LAS unsigned char* lds, const char* Abase, const int K, const Sched& S, const Epi& E) {
    constexpr bool SP2 = true;
    const int tid = otid(), wid = __builtin_amdgcn_readfirstlane(tid >> 6), lane = tid & 63, wr = wid >> 2, wc = wid & 3, fr = lane & 15, fq = lane >> 4;
    const int nt = K / BK;
    unsigned voffB[2];
#pragma unroll
    for (int i = 0; i < 2; ++i) { int R, C; stage_rc(tid * 16 + i * 8192, R, C); const int Rb = Epi::PERM ? ((R & ~31) + perm32(R & 31)) : R;
        voffB[i] = (unsigned)(Rb * K + C) * 2u; }
    const size_t kstep = (size_t)(BK * 2);
    const size_t hstep = (size_t)HALF * K * 2;
    const size_t tstep = 2 * hstep;
    const unsigned ldsw = (unsigned)wid * 1024u;
    const int aoff = lds_byte(wr * 64 + fr, fq * 8), boff = lds_byte(wc * 32 + fr, fq * 8);
#define PG8_SA(b, h) (((b) * 2 + (h)) * HTB)
#define PG8_SB(b, h) ((4 + (b) * 2 + (h)) * HTB)
#define PG8_STAGE_A(bufoff, h, kb, nx) do { _Pragma("unroll") for (int _i = 0; _i < 2; ++_i) \
        __builtin_amdgcn_global_load_lds((const unsigned*)(Abase + ((nx) ? vAn[h][_i] : vAc[h][_i]) + (kb)), (PG8_LAS unsigned*)(lds + (bufoff) + ldsw + _i * 8192), 16, 0, 0); } while (0)
#define PG8_STAGE(bufoff, gbase, voff) do { _Pragma("unroll") for (int _i = 0; _i < 2; ++_i) \
        __builtin_amdgcn_global_load_lds((const unsigned*)((const char*)(gbase) + (voff)[_i]), (PG8_LAS unsigned*)(lds + (bufoff) + ldsw + _i * 8192), 16, 0, 0); } while (0)
#define PG8_LDA(dst, b, h) do { _Pragma("unroll") for (int m = 0; m < 4; ++m) _Pragma("unroll") for (int k = 0; k < 2; ++k) dst[m][k] = *(const PG8_LAS bf16x8*)(lds + PG8_SA(b, h) + aoff + m * 2048 + k * 1024); } while (0)
#define PG8_LDB(dst, b, h) do { _Pragma("unroll") for (int n = 0; n < 2; ++n) _Pragma("unroll") for (int k = 0; k < 2; ++k) dst[n][k] = *(const PG8_LAS bf16x8*)(lds + PG8_SB(b, h) + boff + n * 2048 + k * 1024); } while (0)
#define PG8_MMA(ai, bj, At, Bt) do { __builtin_amdgcn_s_setprio(1); _Pragma("unroll") for (int m = 0; m < 4; ++m) _Pragma("unroll") for (int n = 0; n < 2; ++n) _Pragma("unroll") for (int k = 0; k < 2; ++k) \
        acc[ai][bj][m][n] = __builtin_amdgcn_mfma_f32_16x16x32_bf16(Bt[n][k], At[m][k], acc[ai][bj][m][n], 0, 0, 0); __builtin_amdgcn_s_setprio(0); } while (0)
#define PG8_WAIT_V(n) asm volatile("s_waitcnt vmcnt(" #n ")" ::: "memory")
#define PG8_WAIT_L(n) asm volatile("s_waitcnt lgkmcnt(" #n ")" ::: "memory")
#define PG8_BAR __builtin_amdgcn_s_barrier()
#define PG8_SCHED __builtin_amdgcn_sched_barrier(0)
    typename Sched::UnitT cur, nxt; int ui = 0;
    if (!S.next(0, cur)) return;
    unsigned vAc[2][2], vAn[2][2];
#pragma unroll
    for (int h = 0; h < 2; ++h)
#pragma unroll
        for (int i = 0; i < 2; ++i) { int R, C; stage_rc(tid * 16 + i * 8192, R, C); vAc[h][i] = S.rowoff(cur, h * HALF + R) + (unsigned)(C * 2); vAn[h][i] = vAc[h][i]; }
    f32x4 acc[2][2][4][2];
#pragma unroll
    for (int a = 0; a < 2; ++a)
#pragma unroll
        for (int b = 0; b < 2; ++b)
#pragma unroll
            for (int m = 0; m < 4; ++m)
#pragma unroll
                for (int n = 0; n < 2; ++n) acc[a][b][m][n] = (f32x4){0.f, 0.f, 0.f, 0.f};
    bf16x8 At[4][2], B0[2][2], B1[2][2];
    const char* cB = S.bbase(cur);
    S.a_ready(cur);
    if constexpr (SP2) {
        PG8_STAGE(PG8_SB(0, 0), cB, voffB); PG8_STAGE(PG8_SB(0, 1), cB + hstep, voffB); PG8_STAGE_A(PG8_SA(0, 0), 0, 0, false); PG8_STAGE_A(PG8_SA(0, 1), 1, 0, false);
        if (wr == 1) PG8_BAR;
        PG8_WAIT_V(2); PG8_BAR;
        PG8_STAGE(PG8_SB(1, 0), cB + kstep, voffB); PG8_STAGE_A(PG8_SA(1, 0), 0, (unsigned)kstep, false); PG8_STAGE(PG8_SB(1, 1), cB + hstep + kstep, voffB);
        PG8_WAIT_V(6); PG8_BAR;
    }
    for (;;) {
        const bool has_next = S.next(ui + 1, nxt);
        const char* nB = has_next ? S.bbase(nxt) : cB;
        if (has_next) {
#pragma unroll
            for (int h = 0; h < 2; ++h)
#pragma unroll
                for (int i = 0; i < 2; ++i) { int R, C; stage_rc(tid * 16 + i * 8192, R, C); vAn[h][i] = S.rowoff(nxt, h * HALF + R) + (unsigned)(C * 2); }
        }
        for (int t = 0; t < nt; t += 2) {
            const bool last = (t == nt - 2);
            const unsigned kb1 = (unsigned)(t + 1) * (unsigned)kstep;
            const unsigned kb2 = last ? 0u : (unsigned)(t + 2) * (unsigned)kstep; const char* b2 = last ? nB : cB + (size_t)(t + 2) * kstep;
            const unsigned kb3 = kb2 + (unsigned)kstep; const char* b3 = b2 + kstep;
            if (last && has_next) S.a_ready(nxt);
            if constexpr (SP2) {
            PG8_LDB(B0, 0, 0); PG8_LDB(B1, 0, 1); PG8_SCHED; PG8_LDA(At, 0, 0); PG8_STAGE_A(PG8_SA(1, 1), 1, kb1, false);
            PG8_WAIT_V(8); PG8_WAIT_L(0); PG8_BAR; PG8_MMA(0, 0, At, B0); PG8_MMA(0, 1, At, B1); PG8_BAR; PG8_SCHED;
            PG8_LDA(At, 0, 1); PG8_STAGE(PG8_SB(0, 0), b2, voffB); PG8_STAGE(PG8_SB(0, 1), b2 + hstep, voffB); PG8_STAGE_A(PG8_SA(0, 0), 0, kb2, last);
            PG8_WAIT_V(8); PG8_WAIT_L(0); PG8_BAR; PG8_MMA(1, 0, At, B0); PG8_MMA(1, 1, At, B1); PG8_BAR; PG8_SCHED;
            PG8_LDB(B0, 1, 0); PG8_LDB(B1, 1, 1); PG8_SCHED; PG8_LDA(At, 1, 0); PG8_STAGE_A(PG8_SA(0, 1), 1, kb2, last);
            PG8_WAIT_V(8); PG8_WAIT_L(0); PG8_BAR; PG8_MMA(0, 0, At, B0); PG8_MMA(0, 1, At, B1); PG8_BAR; PG8_SCHED;
            PG8_LDA(At, 1, 1); PG8_STAGE(PG8_SB(1, 0), b3, voffB); PG8_STAGE(PG8_SB(1, 1), b3 + hstep, voffB); PG8_STAGE_A(PG8_SA(1, 0), 0, kb3, last);
            PG8_WAIT_V(8); PG8_WAIT_L(0); PG8_BAR; PG8_MMA(1, 0, At, B0); PG8_MMA(1, 1, At, B1); PG8_BAR; PG8_SCHED;
            }
        }
        if constexpr (ALIGN_EPI) { if (wr == 0) PG8_BAR; }
        if constexpr (!Epi::AFTER_DRAIN) { E(acc, cur, wr, wc, fr, fq); S.done(cur); }
        if (!has_next) break;
#pragma unroll
        for (int a = 0; a < 2; ++a)
#pragma unroll
            for (int b = 0; b < 2; ++b)
#pragma unroll
                for (int m = 0; m < 4; ++m)
#pragma unroll
                    for (int n = 0; n < 2; ++n) acc[a][b][m][n] = (f32x4){0.f, 0.f, 0.f, 0.f};
        cur = nxt; cB = nB; ++ui;
#pragma unroll
        for (int h = 0; h < 2; ++h)
#pragma unroll
            for (int i = 0; i < 2; ++i) vAc[h][i] = vAn[h][i];
        if constexpr (ALIGN_EPI) { if (wr == 1) PG8_BAR; }
    }
    PG8_WAIT_V(0);
    if constexpr (!ALIGN_EPI) { if (wr == 0) PG8_BAR; }
    PG8_BAR;
    if constexpr (Epi::AFTER_DRAIN) { E.fused(acc, cur, wr, wc, fr, fq, lds, wid, lane); S.done(cur); }
#undef PG8_SA
#undef PG8_SB
#undef PG8_STAGE
#undef PG8_STAGE_A
#undef PG8_LDA
#undef PG8_LDB
#undef PG8_MMA
#undef PG8_WAIT_V
#undef PG8_WAIT_L
#undef PG8_BAR
#undef PG8_SCHED
}
}


struct TrItem { const float* W; int ldw, k0, n0; bf16_t* WT; int K, drow0; const float* gain; float scale; };
__device__ __forceinline__ void tr_load(const TrItem& t, v4f (&v)[4], int tid) {
#pragma unroll
    for (int it = 0; it < 4; ++it) { const int idx = it * 512 + tid, row = idx >> 5, c4 = idx & 31; v[it] = *(const v4f*)(t.W + (size_t)(t.k0 + row) * t.ldw + t.n0 + 4 * c4); }
}
__device__ __forceinline__ void tr_finish(const TrItem& t, const v4f (&v)[4], LAS float* scr, int tid) {
#pragma unroll
    for (int it = 0; it < 4; ++it) { const int idx = it * 512 + tid, row = idx >> 5, c4 = idx & 31; const float g = t.gain ? t.gain[t.k0 + row] * t.scale : t.scale;
        LAS float* d = scr + row * 129 + 4 * c4; d[0] = v[it][0] * g; d[1] = v[it][1] * g; d[2] = v[it][2] * g; d[3] = v[it][3] * g; }
    __syncthreads();
#pragma unroll
    for (int it = 0; it < 2; ++it) { const int idx = it * 512 + tid, n = idx >> 3, c = idx & 7; const LAS float* s = scr + (8 * c) * 129 + n;
        v4u o; o.x = pack2(s[0 * 129], s[1 * 129]); o.y = pack2(s[2 * 129], s[3 * 129]); o.z = pack2(s[4 * 129], s[5 * 129]); o.w = pack2(s[6 * 129], s[7 * 129]);
        *(v4u*)(t.WT + (size_t)(t.drow0 + n) * t.K + t.k0 + 8 * c) = o; }
    __syncthreads();
}
__device__ __forceinline__ TrItem tr_job(int it, const float* W, int ldw, int K, int N, bf16_t* WT, int drow_base, const float* gain, float scale) {
    const int nblk = N / 128, kb = it / nblk, nb = it % nblk;
    return TrItem{W, ldw, kb * 64, nb * 128, WT, K, drow_base + nb * 128, gain, scale};
}
template <class F> __device__ __forceinline__ void tr_pipeline(int nitems, const F& get, unsigned char* lds) {
    const int tid = otid(); LAS float* scr = (LAS float*)(LAS unsigned char*)lds;
    int it = obid(); if (it >= nitems) return;
    TrItem cur = get(it); v4f v[4]; tr_load(cur, v, tid);
    for (;;) {
        const int nx = it + (int)gridDim.x; const bool has = nx < nitems; TrItem nxt = cur; v4f vn[4];
        if (has) { nxt = get(nx); tr_load(nxt, vn, tid); }
        tr_finish(cur, v, scr, tid);
        if (!has) break;
        cur = nxt; it = nx;
#pragma unroll
        for (int k = 0; k < 4; ++k) v[k] = vn[k];
    }
}
__device__ void convert_dense_weights(const Params& p, unsigned char* lds) {
    bf16_t* WB = (bf16_t*)(p.ws + OFF_WB);
    bf16_t* Win = WB + W_IN / 2; bf16_t* Wout = WB + W_OUT / 2; bf16_t* Wkvq = WB + W_KVQ / 2; bf16_t* Wo = WB + W_O / 2;
    constexpr int I0 = 16 * 48, I1 = 32 * 8, I2 = 16 * 16, I3 = 16 * 8, I4 = 16 * 8, NIT = I0 + I1 + I2 + I3 + I4;
    const float *w_in = p.ret_w_in, *w_out = p.ret_w_out, *w_kv = p.w_kv, *w_q = p.w_q, *w_o = p.w_o, *g_ret = p.ret_norm, *g_kv = p.kv_norm, *g_at = p.attn_norm;
    auto get = [=](int it) {
        int r = it;
        if (r < I0) { const int nb = r % 48; const float sc = (nb >= 8 && nb < 16) ? 0.0625f : 1.f;
            return tr_job(r, w_in, 6144, 1024, 6144, Win, 0, g_ret, sc); } r -= I0;
        if (r < I1) return tr_job(r, w_out, 1024, 2048, 1024, Wout, 0, nullptr, 1.f); r -= I1;
        if (r < I2) return tr_job(r, w_kv, 2048, 1024, 2048, Wkvq, 0, g_kv, 1.f); r -= I2;
        if (r < I3) return tr_job(r, w_q, 1024, 1024, 1024, Wkvq, 2048, g_at, 0.08838834764831845f); r -= I3;
        return tr_job(r, w_o, 1024, 1024, 1024, Wo, 0, nullptr, 1.f);
    };
    tr_pipeline(NIT, get, lds);
}
__device__ void convert_expert_weights(const Params& p, int L, unsigned char* lds) {
    bf16_t* E = (bf16_t*)(p.ws + OFF_BIG + B_E);
    const float* gain = p.ffn_norm + L * 1024;
    const float *wg = p.wg, *wu = p.wu, *wd = p.wd;
    auto get = [=](int it) {
        const int e = it / 192; int r = it % 192;
        bf16_t* W1 = E + (size_t)e * 3 * 512 * 1024; bf16_t* W2 = W1 + 1024 * 1024;
        if (r < 128) { const int up = r >= 64; r &= 63; const int kb = r / 4, nb = r % 4;
            const float* W = (up ? wu : wg) + (size_t)(L * 16 + e) * 1024 * 512;
            return TrItem{W, 512, kb * 64, nb * 128, W1, 1024, nb * 256 + up * 128, gain, 1.f}; }
        r -= 128; return tr_job(r, wd + (size_t)(L * 16 + e) * 512 * 1024, 1024, 512, 1024, W2, 0, nullptr, 1.f);
    };
    tr_pipeline(16 * 192, get, lds);
}

__device__ void phase_prologue(const Params& p, unsigned char* lds) {
    const int gtid = obid() * 512 + otid(), gsz = gridDim.x * 512;
    int* cnt = (int*)(p.ws + OFF_CTRL);
    if (gtid < 64 + 512) cnt[gtid] = 0;
    if (gtid < 65536) ((float*)(p.ws + OFF_KMEAN))[gtid] = 0.f;
    float* rc = (float*)(p.ws + OFF_TABRET); float* rs = rc + 8192 * 128;
    for (int i = gtid; i < 8192 * 128; i += gsz) { const int pos = i >> 7, f = i & 127;
        const float inv = (float)exp(-9.2103403719761836 * ((double)f / 128.0));
        const float ang = (float)pos * inv; double s, c; sincos_big((double)ang, s, c); rc[i] = (float)c; rs[i] = (float)s; }
    float* pc = (float*)(p.ws + OFF_TABROPE); float* ps = pc + 8192 * 16;
    for (int i = gtid; i < 8192 * 16; i += gsz) { const int pos = i >> 4, f = i & 15;
        const float inv = (float)exp(-13.122363377404328 * ((double)f / 16.0));
        const float ang = (float)pos * inv; double s, c; sincos_big((double)ang, s, c); pc[i] = (float)c; ps[i] = (float)s; }
    convert_dense_weights(p, lds);
    norm_pass<0>(p, 0, lds);
}

__device__ void phase_ret_rotary(const Params& p) {
    bf16_t* QK = (bf16_t*)(p.ws + OFF_BIG + B_QK);
    const float* rc = (const float*)(p.ws + OFF_TABRET); const float* rs = rc + 8192 * 128;
    const size_t total = (size_t)T * 8 * 128;
    for (size_t i = (size_t)obid() * 512 + otid(); i < total; i += (size_t)gridDim.x * 512) {
        const int f = (int)(i & 127), slot = (int)((i >> 7) & 7), t = (int)(i >> 10), pos = t & 8191;
        bf16_t* px = QK + (size_t)t * 2048 + slot * 256 + f;
        const float x1 = bf2f(px[0]), x2 = bf2f(px[128]), c = rc[pos * 128 + f], s = rs[pos * 128 + f];
        const float sc = slot >= 4 ? 0.0625f : 1.f;
        px[0] = f2bf((x1 * c - x2 * s) * sc); px[128] = f2bf((x2 * c + x1 * s) * sc);
    }
}

__device__ void phase_ret_scan(const Params& p) {
    const bf16_t* QK = (const bf16_t*)(p.ws + OFF_BIG + B_QK); const bf16_t* V = (const bf16_t*)(p.ws + OFF_BIG + B_V); bf16_t* O = (bf16_t*)(p.ws + OFF_BIG + B_O);
    const int wave = otid() >> 6, lane = otid() & 63;
    for (int item = obid() * 8 + wave; item < 2048; item += gridDim.x * 8) {
        const int b = item >> 10, h = (item >> 8) & 3, ep = item & 255;
        const float gamma = 1.f - exp2f(-5.f - (float)h);
        float S[4][2];
#pragma unroll
        for (int d = 0; d < 4; ++d) { S[d][0] = 0.f; S[d][1] = 0.f; }
        const bf16_t* qp = QK + (size_t)b * SEQ * 2048 + h * 256 + lane * 4;
        const bf16_t* kp = qp + 1024;
        const bf16_t* vp = V + (size_t)(h * 512 + ep * 2) * 16384 + (size_t)b * SEQ;
        bf16_t* op = O + (size_t)b * SEQ * 2048 + h * 512 + ep * 2;
#pragma unroll 4
        for (int t = 0; t < SEQ; ++t) {
            const uint2 qv = *(const uint2*)(qp + (size_t)t * 2048), kv = *(const uint2*)(kp + (size_t)t * 2048);
            const float q[4] = {bflo(qv.x), bfhi(qv.x), bflo(qv.y), bfhi(qv.y)}, k[4] = {bflo(kv.x), bfhi(kv.x), bflo(kv.y), bfhi(kv.y)};
            const float v0 = bf2f(vp[t]), v1 = bf2f(vp[16384 + t]);
            float p0 = 0.f, p1 = 0.f;
#pragma unroll
            for (int d = 0; d < 4; ++d) { S[d][0] = gamma * S[d][0] + k[d] * v0; S[d][1] = gamma * S[d][1] + k[d] * v1; p0 += q[d] * S[d][0]; p1 += q[d] * S[d][1]; }
            p0 = wsum(p0); p1 = wsum(p1);
            if (lane == 0) *(unsigned*)(op + (size_t)t * 2048) = pack2(p0, p1);
        }
    }
}

__device__ void phase_ret_gnorm(const Params& p) {
    bf16_t* O = (bf16_t*)(p.ws + OFF_BIG + B_O);
    const int wave = otid() >> 6, lane = otid() & 63;
    for (int item = obid() * 8 + wave; item < T * 4; item += gridDim.x * 8) {
        bf16_t* po = O + (size_t)item * 512 + lane * 8;
        const uint4 u = *(const uint4*)po;
        float v[8] = {bflo(u.x), bfhi(u.x), bflo(u.y), bfhi(u.y), bflo(u.z), bfhi(u.z), bflo(u.w), bfhi(u.w)};
        float ss = 0.f;
#pragma unroll
        for (int i = 0; i < 8; ++i) ss += v[i] * v[i];
        ss = wsum(ss);
        const float rstd = 1.0f / sqrtf(ss * (1.0f / 512.0f) + 1e-6f);
        uint4 o; o.x = pack2(v[0] * rstd, v[1] * rstd); o.y = pack2(v[2] * rstd, v[3] * rstd); o.z = pack2(v[4] * rstd, v[5] * rstd); o.w = pack2(v[6] * rstd, v[7] * rstd);
        *(uint4*)po = o;
    }
}

__device__ void phase_rope(const Params& p) {
    bf16_t* Kb = (bf16_t*)(p.ws + OFF_BIG + B_K); bf16_t* Qb = (bf16_t*)(p.ws + OFF_BIG + B_Q);
    const float* pc = (const float*)(p.ws + OFF_TABROPE); const float* ps = pc + 8192 * 16;
    const size_t total = (size_t)T * 2 * 8 * 16;
    for (size_t i = (size_t)obid() * 512 + otid(); i < total; i += (size_t)gridDim.x * 512) {
        const int f = (int)(i & 15), h = (int)((i >> 4) & 7), which = (int)((i >> 7) & 1), t = (int)(i >> 8), pos = t & 8191;
        bf16_t* px = (which ? Qb : Kb) + (size_t)t * 1024 + h * 128 + f;
        const float x1 = bf2f(px[0]), x2 = bf2f(px[16]), c = pc[pos * 16 + f], s = ps[pos * 16 + f];
        px[0] = f2bf(x1 * c - x2 * s); px[16] = f2bf(x2 * c + x1 * s);
    }
}
__device__ void phase_qscale(const Params& p) {
    bf16_t* Qb = (bf16_t*)(p.ws + OFF_BIG + B_Q);
    const size_t total = (size_t)T * 1024;
    const float sc = 0.08838834764831845f;
    for (size_t i = (size_t)obid() * 512 + otid(); i < total; i += (size_t)gridDim.x * 512) Qb[i] = f2bf(bf2f(Qb[i]) * sc);
}

__device__ void phase_kmean(const Params& p) {
    const bf16_t* Kb = (const bf16_t*)(p.ws + OFF_BIG + B_K); float* km = (float*)(p.ws + OFF_KMEAN);
    for (int i = obid() * 512 + otid(); i < 2 * 32 * 1024; i += gridDim.x * 512) {
        const int col = i & 1023, n = (i >> 10) & 31, b = i >> 15, h = col >> 7, d = col & 127;
        const bf16_t* pk = Kb + ((size_t)b * SEQ + n * 256) * 1024 + col;
        float s = 0.f;
        for (int j = 0; j < 256; ++j) s += bf2f(pk[(size_t)j * 1024]);
        km[(((size_t)b * 8 + h) * 32 + n) * 128 + d] = s * (1.0f / 256.0f);
    }
}

__device__ void phase_moba_naive(const Params& p, float* sm) {
    const bf16_t* Kb = (const bf16_t*)(p.ws + OFF_BIG + B_K); const bf16_t* Vb = (const bf16_t*)(p.ws + OFF_BIG + B_VB); const bf16_t* Qb = (const bf16_t*)(p.ws + OFF_BIG + B_Q);
    const float* kmean = (const float*)(p.ws + OFF_KMEAN); bf16_t* AO = (bf16_t*)(p.ws + OFF_BIG + B_AO);
    const int wave = otid() >> 6, lane = otid() & 63;
    float* qs = sm + wave * 128;
    for (int item = obid() * 8 + wave; item < T * 8; item += gridDim.x * 8) {
        const int tg = item >> 3, h = item & 7, b = tg >> 13, s = tg & 8191, blk = s >> 8;
        const unsigned qq = *(const unsigned*)(Qb + (size_t)tg * 1024 + h * 128 + lane * 2);
        qs[lane * 2] = bflo(qq); qs[lane * 2 + 1] = bfhi(qq);
        __builtin_amdgcn_wave_barrier();
        float g = -INFINITY;
        if (lane < blk) { const float* km = kmean + (((size_t)b * 8 + h) * 32 + lane) * 128; float a = 0.f; for (int d = 0; d < 128; ++d) a += qs[d] * km[d]; g = a; }
        const int nsel = blk < 3 ? blk : 3;
        int sel[3];
#pragma unroll
        for (int j = 0; j < 3; ++j) {
            sel[j] = 0;
            if (j < nsel) { const float m = wmax(g); const unsigned long long bal = __ballot(g == m); const int idx = __ffsll((long long)bal) - 1; sel[j] = idx; if (lane == idx) g = -INFINITY; }
        }
        float sc[4][4];
#pragma unroll
        for (int seg = 0; seg < 4; ++seg) {
            const int bid = seg < 3 ? sel[seg] : blk; const bool valid = seg < 3 ? (seg < nsel) : true; const int nkeys = seg < 3 ? 256 : (s - blk * 256 + 1);
#pragma unroll
            for (int kk = 0; kk < 4; ++kk) {
                const int key = kk * 64 + lane; float v = -INFINITY;
                if (valid && key < nkeys) {
                    const bf16_t* kr = Kb + ((size_t)b * SEQ + bid * 256 + key) * 1024 + h * 128; float a = 0.f;
#pragma unroll 4
                    for (int d8 = 0; d8 < 16; ++d8) { const uint4 u = *(const uint4*)(kr + d8 * 8); const float* q8 = qs + d8 * 8;
                        a += q8[0] * bflo(u.x) + q8[1] * bfhi(u.x) + q8[2] * bflo(u.y) + q8[3] * bfhi(u.y) + q8[4] * bflo(u.z) + q8[5] * bfhi(u.z) + q8[6] * bflo(u.w) + q8[7] * bfhi(u.w); }
                    v = a;
                }
                sc[seg][kk] = v;
            }
        }
        float m = -INFINITY;
#pragma unroll
        for (int seg = 0; seg < 4; ++seg)
#pragma unroll
            for (int kk = 0; kk < 4; ++kk) m = fmaxf(m, sc[seg][kk]);
        m = wmax(m);
        float l = 0.f;
#pragma unroll
        for (int seg = 0; seg < 4; ++seg)
#pragma unroll
            for (int kk = 0; kk < 4; ++kk) { const float e = expf(sc[seg][kk] - m); sc[seg][kk] = e; l += e; }
        l = wsum(l);
        float o0 = 0.f, o1 = 0.f;
#pragma unroll
        for (int seg = 0; seg < 4; ++seg) {
            const int bid = seg < 3 ? sel[seg] : blk; const bool valid = seg < 3 ? (seg < nsel) : true; const int nkeys = seg < 3 ? 256 : (s - blk * 256 + 1);
            if (valid) {
#pragma unroll
                for (int kk = 0; kk < 4; ++kk) {
                    if (kk * 64 < nkeys) {
                        const bf16_t* vr = Vb + ((size_t)b * SEQ + bid * 256 + kk * 64) * 1024 + h * 128 + lane * 2;
                        for (int src = 0; src < 64; ++src) { const float pp = __shfl(sc[seg][kk], src); const unsigned vv = *(const unsigned*)(vr + (size_t)src * 1024); o0 += pp * bflo(vv); o1 += pp * bfhi(vv); }
                    }
                }
            }
        }
        const float il = 1.0f / l;
        *(unsigned*)(AO + (size_t)tg * 1024 + h * 128 + lane * 2) = pack2(o0 * il, o1 * il);
        __builtin_amdgcn_wave_barrier();
    }
}

typedef short bf16x8_t __attribute__((ext_vector_type(8)));
typedef short s16x4_t __attribute__((ext_vector_type(4)));
constexpr int QCAP = 8192;
constexpr size_t X_QLIST = 0, X_ML = 16 * MiB;
constexpr int CT_QCNT = 64;

__device__ void phase_kmean2(const Params& p) {
    const bf16_t* Kb = (const bf16_t*)(p.ws + OFF_BIG + B_K); bf16_t* kh = (bf16_t*)(p.ws + OFF_KMEAN); bf16_t* kl = kh + 2 * 8 * 32 * 128;
    for (int i = obid() * 512 + otid(); i < 2 * 32 * 1024; i += gridDim.x * 512) {
        const int col = i & 1023, n = (i >> 10) & 31, b = i >> 15, h = col >> 7, d = col & 127;
        const bf16_t* pk = Kb + ((size_t)b * SEQ + n * 256) * 1024 + col;
        float s = 0.f;
#pragma unroll 8
        for (int j = 0; j < 256; ++j) s += bf2f(pk[(size_t)j * 1024]);
        s *= (1.0f / 256.0f);
        const bf16_t hi = f2bf(s); const size_t o = (((size_t)b * 8 + h) * 32 + n) * 128 + d;
        kh[o] = hi; kl[o] = f2bf(s - bf2f(hi));
    }
}

__device__ void phase_moba_gate(const Params& p, unsigned char* lds) {
    const int tid = otid(), wave = tid >> 6, lane = tid & 63, g = lane >> 4, i = lane & 15;
    LAS int* lcnt = (LAS int*)(LAS unsigned char*)lds; LAS int* lbase = lcnt + 32; LAS unsigned* lsel = (LAS unsigned*)(lcnt + 64);
    const bf16_t* Qb = (const bf16_t*)(p.ws + OFF_BIG + B_Q); const float* kms = (const float*)(p.ws + OFF_KMEAN);
    int* qcnt = (int*)(p.ws + OFF_CTRL) + CT_QCNT; unsigned* qlist = (unsigned*)(p.ws + OFF_XN + X_QLIST);
    for (int unit = obid(); unit < 256; unit += gridDim.x) {
        const int b = unit >> 7, h = (unit >> 4) & 7, s0 = (unit & 15) * 512;
        if (tid < 32) lcnt[tid] = 0;
        __syncthreads();
        bf16x8_t ah[2][4], al[2][4];
#pragma unroll
        for (int nt = 0; nt < 2; ++nt)
#pragma unroll
            for (int ks = 0; ks < 4; ++ks) { const float* src = kms + (((size_t)b * 8 + h) * 32 + nt * 16 + i) * 128 + ks * 32 + 8 * g;
                const v4f x0 = *(const v4f*)src * (1.0f / 256.0f), x1 = *(const v4f*)(src + 4) * (1.0f / 256.0f);
                union { bf16x8_t v; bf16_t s[8]; } hh, ll;
#pragma unroll
                for (int e = 0; e < 4; ++e) { hh.s[e] = f2bf(x0[e]); ll.s[e] = f2bf(x0[e] - bf2f(hh.s[e])); hh.s[4 + e] = f2bf(x1[e]); ll.s[4 + e] = f2bf(x1[e] - bf2f(hh.s[4 + e])); }
                ah[nt][ks] = hh.v; al[nt][ks] = ll.v; }
#pragma unroll 1
        for (int it = 0; it < 4; ++it) {
            const int tl = wave * 64 + it * 16 + i, s = s0 + tl, tg = b * SEQ + s, blk = s >> 8;
            v4f acc[2] = {{0.f, 0.f, 0.f, 0.f}, {0.f, 0.f, 0.f, 0.f}};
#pragma unroll
            for (int ks = 0; ks < 4; ++ks) { const bf16x8_t bq = *(const bf16x8_t*)(Qb + (size_t)tg * 1024 + h * 128 + ks * 32 + 8 * g);
#pragma unroll
                for (int nt = 0; nt < 2; ++nt) { acc[nt] = __builtin_amdgcn_mfma_f32_16x16x32_bf16(ah[nt][ks], bq, acc[nt], 0, 0, 0); acc[nt] = __builtin_amdgcn_mfma_f32_16x16x32_bf16(al[nt][ks], bq, acc[nt], 0, 0, 0); } }
            float gv[8];
#pragma unroll
            for (int q = 0; q < 8; ++q) { const int n = (q >> 2) * 16 + 4 * g + (q & 3); gv[q] = n < blk ? acc[q >> 2][q & 3] : -INFINITY; }
            const int nsel = blk < 3 ? blk : 3;
#pragma unroll
            for (int j = 0; j < 3; ++j) {
                float bm = -INFINITY; int bn = 64;
#pragma unroll
                for (int q = 0; q < 8; ++q) { const int n = (q >> 2) * 16 + 4 * g + (q & 3); if (gv[q] > bm) { bm = gv[q]; bn = n; } }
#pragma unroll
                for (int off = 16; off <= 32; off <<= 1) { const float om = __shfl_xor(bm, off); const int on = __shfl_xor(bn, off); if (om > bm || (om == bm && on < bn)) { bm = om; bn = on; } }
#pragma unroll
                for (int q = 0; q < 8; ++q) { const int n = (q >> 2) * 16 + 4 * g + (q & 3); if (n == bn) gv[q] = -INFINITY; }
                if (g == 0 && j < nsel) { const int off = atomicAdd((int*)&lcnt[bn], 1); lsel[tl * 3 + j] = (unsigned)bn | ((unsigned)off << 8); }
            }
        }
        __syncthreads();
        if (tid < 32) { const int c = lcnt[tid]; lbase[tid] = c ? atomicAdd(qcnt + (b * 8 + h) * 32 + tid, c) : 0; }
        __syncthreads();
        { const int s = s0 + tid, blk = s >> 8, nsel = blk < 3 ? blk : 3;
            for (int j = 0; j < nsel; ++j) { const unsigned e = lsel[tid * 3 + j]; const int sel = e & 255, off = e >> 8;
                qlist[((size_t)(b * 8 + h) * 32 + sel) * QCAP + lbase[sel] + off] = (unsigned)(b * SEQ + s) | ((unsigned)j << 16); } }
        __syncthreads();
    }
}

__device__ __forceinline__ void moba_stage_kv(const bf16_t* Kb, const bf16_t* Vb, int b, int h, int n, LAS unsigned char* Ks, LAS unsigned char* Vs, int tid) {
    const size_t rowbase = ((size_t)b * SEQ + n * 256) * 1024 + h * 128;
#pragma unroll
    for (int it = 0; it < 8; ++it) { const int idx = it * 512 + tid, row = idx >> 4, ch = idx & 15;
        const v4u kv = *(const v4u*)(Kb + rowbase + (size_t)row * 1024 + ch * 8), vv = *(const v4u*)(Vb + rowbase + (size_t)row * 1024 + ch * 8);
        *(LAS v4u*)(Ks + row * 256 + ((ch ^ (row & 15)) << 4)) = kv; *(LAS v4u*)(Vs + row * 256 + ((ch ^ ((row & 7) << 1)) << 4)) = vv; }
}

__device__ __forceinline__ void moba_wave_attn(const bf16x8_t (&bq)[4], LAS unsigned char* Ks, LAS unsigned char* Vs, int g, int i, bool own, int t_local, int nkt, v4f (&o)[8], float& m_out, float& l_out) {
    v4f st[16];
#pragma unroll
    for (int kt = 0; kt < 16; ++kt) {
        st[kt] = (v4f){0.f, 0.f, 0.f, 0.f};
        if (kt < nkt) {
            const int row = kt * 16 + i;
#pragma unroll
            for (int ks = 0; ks < 4; ++ks) { const bf16x8_t a = *(const LAS bf16x8_t*)(Ks + row * 256 + (((ks * 4 + g) ^ (row & 15)) << 4)); st[kt] = __builtin_amdgcn_mfma_f32_16x16x32_bf16(a, bq[ks], st[kt], 0, 0, 0); }
        }
    }
    float m = -INFINITY;
#pragma unroll
    for (int kt = 0; kt < 16; ++kt)
#pragma unroll
        for (int r = 0; r < 4; ++r) { const int key = kt * 16 + 4 * g + r; const bool ok = (kt < nkt) && (!own || key <= t_local); st[kt][r] = ok ? st[kt][r] : -INFINITY; m = fmaxf(m, st[kt][r]); }
    m = fmaxf(m, __shfl_xor(m, 16)); m = fmaxf(m, __shfl_xor(m, 32));
    float l = 0.f;
#pragma unroll
    for (int kt = 0; kt < 16; ++kt)
#pragma unroll
        for (int r = 0; r < 4; ++r) { const float e = __expf(st[kt][r] - m); st[kt][r] = e; l += e; }
    l += __shfl_xor(l, 16); l += __shfl_xor(l, 32);
#pragma unroll
    for (int dt = 0; dt < 8; ++dt) o[dt] = (v4f){0.f, 0.f, 0.f, 0.f};
    const int q = i >> 2, pp = i & 3;
#pragma unroll
    for (int k2 = 0; k2 < 8; ++k2) {
        if (2 * k2 < nkt) {
            union { bf16x8_t v; unsigned u[4]; } pb;
            pb.u[0] = pg8::cvt_pk_bf16(st[2 * k2][0], st[2 * k2][1]); pb.u[1] = pg8::cvt_pk_bf16(st[2 * k2][2], st[2 * k2][3]);
            pb.u[2] = pg8::cvt_pk_bf16(st[2 * k2 + 1][0], st[2 * k2 + 1][1]); pb.u[3] = pg8::cvt_pk_bf16(st[2 * k2 + 1][2], st[2 * k2 + 1][3]);
            const int r0 = (2 * k2) * 16 + 4 * g + q, r1 = r0 + 16;
#pragma unroll
            for (int dt = 0; dt < 8; ++dt) {
                const int ch = dt * 2 + (pp >> 1);
                const s16x4_t a0 = __builtin_amdgcn_ds_read_tr16_b64_v4i16((LAS s16x4_t*)(Vs + r0 * 256 + ((ch ^ ((r0 & 7) << 1)) << 4) + (pp & 1) * 8));
                const s16x4_t a1 = __builtin_amdgcn_ds_read_tr16_b64_v4i16((LAS s16x4_t*)(Vs + r1 * 256 + ((ch ^ ((r1 & 7) << 1)) << 4) + (pp & 1) * 8));
                const bf16x8_t a = {a0[0], a0[1], a0[2], a0[3], a1[0], a1[1], a1[2], a1[3]};
                o[dt] = __builtin_amdgcn_mfma_f32_16x16x32_bf16(a, pb.v, o[dt], 0, 0, 0);
            }
        }
    }
    m_out = m; l_out = l;
}

__device__ void phase_moba_sel(const Params& p, unsigned char* lds) {
    const int tid = otid(), wave = __builtin_amdgcn_readfirstlane(tid >> 6), lane = tid & 63, g = lane >> 4, i = lane & 15;
    LAS unsigned char* Ks = (LAS unsigned char*)lds; LAS unsigned char* Vs = Ks + 65536; LAS int* pre = (LAS int*)(Ks + 131072);
    const bf16_t* Kb = (const bf16_t*)(p.ws + OFF_BIG + B_K); const bf16_t* Vb = (const bf16_t*)(p.ws + OFF_BIG + B_VB); const bf16_t* Qb = (const bf16_t*)(p.ws + OFF_BIG + B_Q);
    bf16_t* PART = (bf16_t*)(p.ws + OFF_BIG + B_PART); float* ML = (float*)(p.ws + OFF_XN + X_ML);
    const int* qcnt = (const int*)(p.ws + OFF_CTRL) + CT_QCNT; const unsigned* qlist = (const unsigned*)(p.ws + OFF_XN + X_QLIST);
    __syncthreads();
    pre[516 + tid] = qcnt[tid];
    __syncthreads();
    if (tid == 0) { int s = 0; for (int l = 0; l < 512; ++l) { pre[l] = s; s += (pre[516 + l] + 127) >> 7; } pre[512] = s; }
    __syncthreads();
    const int NT = pre[512], G = (int)gridDim.x, c = obid();
    const int t_begin = (int)(((long)NT * c) / G), t_end = (int)(((long)NT * (c + 1)) / G);
    LAS unsigned* ent = (LAS unsigned*)(Ks + 131072 + 8192);
    int li = 0, cur = -1;
    { int lo = 0, hi = 511;
        while (lo < hi) { const int mid = (lo + hi + 1) >> 1; if (pre[mid] <= t_begin) lo = mid; else hi = mid - 1; }
        li = lo; }
    for (int tb = t_begin; tb < t_end; tb += 12) {
        const int nt_chunk = (t_end - tb) < 12 ? (t_end - tb) : 12;
        __syncthreads();
        for (int idx = tid; idx < nt_chunk * 128; idx += 512) { const int tl = idx >> 7, r = idx & 127, tile = tb + tl; int l2 = li; while (tile >= pre[l2 + 1]) ++l2;
            const int row = (tile - pre[l2]) * 128 + r; ent[idx] = qlist[(size_t)l2 * QCAP + (row < pre[516 + l2] ? row : 0)] | (row < pre[516 + l2] ? 0x80000000u : 0u); }
        __syncthreads();
        bf16x8_t bq[4], bqn[4];
        { int l2 = li; while (tb >= pre[l2 + 1]) ++l2; const unsigned e0 = ent[wave * 16 + i]; const bf16_t* qr = Qb + (size_t)(e0 & 0xffff) * 1024 + ((l2 >> 5) & 7) * 128 + 8 * g;
#pragma unroll
            for (int ks = 0; ks < 4; ++ks) bq[ks] = *(const bf16x8_t*)(qr + ks * 32); }
#pragma unroll 1
        for (int tl = 0; tl < nt_chunk; ++tl) {
            const int tile = tb + tl;
            while (tile >= pre[li + 1]) ++li;
            const int b = li >> 8, h = (li >> 5) & 7, n = li & 31;
            if (li != cur) { __syncthreads(); moba_stage_kv(Kb, Vb, b, h, n, Ks, Vs, tid); __syncthreads(); cur = li; }
            const unsigned e = ent[tl * 128 + wave * 16 + i]; const bool valid = (e >> 31) != 0u; const int tg = e & 0xffff, j = (e >> 16) & 3;
            if (tl + 1 < nt_chunk) { int l2 = li; while (tile + 1 >= pre[l2 + 1]) ++l2; const unsigned e1 = ent[(tl + 1) * 128 + wave * 16 + i];
                const bf16_t* qr = Qb + (size_t)(e1 & 0xffff) * 1024 + ((l2 >> 5) & 7) * 128 + 8 * g;
#pragma unroll
                for (int ks = 0; ks < 4; ++ks) bqn[ks] = *(const bf16x8_t*)(qr + ks * 32); }
            v4f o[8]; float m, l;
            moba_wave_attn(bq, Ks, Vs, g, i, false, 0, 16, o, m, l);
            if (valid) {
                bf16_t* po = PART + ((size_t)(tg * 8 + h) * 3 + j) * 128 + 4 * g;
#pragma unroll
                for (int dt = 0; dt < 8; ++dt) *(uint2*)(po + dt * 16) = make_uint2(pg8::cvt_pk_bf16(o[dt][0], o[dt][1]), pg8::cvt_pk_bf16(o[dt][2], o[dt][3]));
                if (g == 0) *(float2*)(ML + ((size_t)(tg * 8 + h) * 3 + j) * 2) = make_float2(m, l);
            }
#pragma unroll
            for (int ks = 0; ks < 4; ++ks) bq[ks] = bqn[ks];
        }
    }
}

__device__ void phase_moba_own(const Params& p, unsigned char* lds) {
    const int tid = otid(), wave = __builtin_amdgcn_readfirstlane(tid >> 6), lane = tid & 63, g = lane >> 4, i = lane & 15;
    LAS unsigned char* Ks = (LAS unsigned char*)lds; LAS unsigned char* Vs = Ks + 65536;
    const bf16_t* Kb = (const bf16_t*)(p.ws + OFF_BIG + B_K); const bf16_t* Vb = (const bf16_t*)(p.ws + OFF_BIG + B_VB); const bf16_t* Qb = (const bf16_t*)(p.ws + OFF_BIG + B_Q);
    const bf16_t* PART = (const bf16_t*)(p.ws + OFF_BIG + B_PART); const float* ML = (const float*)(p.ws + OFF_XN + X_ML); bf16_t* AO = (bf16_t*)(p.ws + OFF_BIG + B_AO);
    for (int unit = obid(); unit < 512; unit += gridDim.x) {
        const int b = unit >> 8, h = (unit >> 5) & 7, blk = unit & 31, nsel = blk < 3 ? blk : 3;
        __syncthreads(); moba_stage_kv(Kb, Vb, b, h, blk, Ks, Vs, tid); __syncthreads();
#pragma unroll 1
        for (int tile = 0; tile < 2; ++tile) {
            const int t_local = tile * 128 + wave * 16 + i, tg = b * SEQ + blk * 256 + t_local, nkt = tile * 8 + wave + 1;
            v4f o[8]; float m, l;
            { bf16x8_t bq[4];
#pragma unroll
                for (int ks = 0; ks < 4; ++ks) bq[ks] = *(const bf16x8_t*)(Qb + (size_t)tg * 1024 + h * 128 + ks * 32 + 8 * g);
                moba_wave_attn(bq, Ks, Vs, g, i, true, t_local, nkt, o, m, l); }
            float mj[3], lj[3], M = m;
#pragma unroll
            for (int j = 0; j < 3; ++j) { mj[j] = -INFINITY; lj[j] = 0.f; if (j < nsel) { const float2 v = *(const float2*)(ML + ((size_t)(tg * 8 + h) * 3 + j) * 2); mj[j] = v.x; lj[j] = v.y; } M = fmaxf(M, mj[j]); }
            const float w0 = __expf(m - M); float den = l * w0; float wj[3];
#pragma unroll
            for (int j = 0; j < 3; ++j) { wj[j] = (j < nsel) ? __expf(mj[j] - M) : 0.f; den += lj[j] * wj[j]; }
            const float inv = 1.0f / den;
#pragma unroll
            for (int dt = 0; dt < 8; ++dt) {
                v4f acc = o[dt] * w0;
#pragma unroll
                for (int j = 0; j < 3; ++j) if (j < nsel) { const uint2 u = *(const uint2*)(PART + ((size_t)(tg * 8 + h) * 3 + j) * 128 + dt * 16 + 4 * g);
                    acc[0] += bflo(u.x) * wj[j]; acc[1] += bfhi(u.x) * wj[j]; acc[2] += bflo(u.y) * wj[j]; acc[3] += bfhi(u.y) * wj[j]; }
                acc = acc * inv;
                *(uint2*)(AO + (size_t)tg * 1024 + h * 128 + dt * 16 + 4 * g) = make_uint2(pg8::cvt_pk_bf16(acc[0], acc[1]), pg8::cvt_pk_bf16(acc[2], acc[3]));
            }
        }
    }
}

constexpr int RL = 512;
constexpr size_t ST_SLOT = (size_t)512 * 256;
__device__ __forceinline__ float ret_lg(int h) { return log2f(1.f - exp2f(-5.f - (float)h)); }

__device__ void phase_ret_kv(const Params& p, unsigned char* lds) {
    const int tid = otid(), wave = __builtin_amdgcn_readfirstlane(tid >> 6), lane = tid & 63, g = lane >> 4, i = lane & 15, q = i >> 2, pp = i & 3;
    const int we = wave >> 2, wd = wave & 3;
    LAS unsigned char* Ks = (LAS unsigned char*)lds;
    const bf16_t* QK = (const bf16_t*)(p.ws + OFF_BIG + B_QK); const bf16_t* Vt = (const bf16_t*)(p.ws + OFF_BIG + B_V); bf16_t* ST = (bf16_t*)(p.ws + OFF_BIG + B_ST);
    for (int unit = obid(); unit < 240; unit += gridDim.x) {
        const int eh = unit & 1, s = (unit >> 1) % 15, bh = (unit >> 1) / 15, b = bh >> 2, h = bh & 3;
        const float lg = ret_lg(h);
        v4f acc[4][8];
#pragma unroll
        for (int m = 0; m < 4; ++m)
#pragma unroll
            for (int n = 0; n < 8; ++n) acc[m][n] = (v4f){0.f, 0.f, 0.f, 0.f};
        const bf16_t* krow = QK + ((size_t)b * SEQ + s * RL) * 2048 + 1024 + h * 256;
        const bf16_t* vrow = Vt + (size_t)(h * 512 + eh * 256 + we * 128 + i) * 16384 + (size_t)b * SEQ + s * RL + 8 * g;
        v4u kreg[4];
#pragma unroll
        for (int it = 0; it < 4; ++it) { const int idx = it * 512 + tid, row = idx >> 5, ch = idx & 31; kreg[it] = *(const v4u*)(krow + (size_t)row * 2048 + ch * 8); }
        bf16x8_t bfA[4], bfB[4];
#pragma unroll 1
        for (int st = 0; st < 8; ++st) {
            LAS unsigned char* Kb = Ks + (st & 1) * 32768;
#pragma unroll
            for (int it = 0; it < 4; ++it) { const int idx = it * 512 + tid, row = idx >> 5, ch = idx & 31; const v4u kv = kreg[it];
                const float w = exp2f((float)(RL - 1 - (st * 64 + row)) * lg);
                v4u o; o.x = pg8::cvt_pk_bf16(bflo(kv.x) * w, bfhi(kv.x) * w); o.y = pg8::cvt_pk_bf16(bflo(kv.y) * w, bfhi(kv.y) * w); o.z = pg8::cvt_pk_bf16(bflo(kv.z) * w, bfhi(kv.z) * w); o.w = pg8::cvt_pk_bf16(bflo(kv.w) * w, bfhi(kv.w) * w);
                const int f = ((row & 3) | ((row >> 1) & 4)) << 1;
                *(LAS v4u*)(Kb + row * 512 + ((ch ^ f) << 4)) = o; }
            if (st < 7) {
#pragma unroll
                for (int it = 0; it < 4; ++it) { const int idx = it * 512 + tid, row = idx >> 5, ch = idx & 31; kreg[it] = *(const v4u*)(krow + (size_t)((st + 1) * 64 + row) * 2048 + ch * 8); } }
#pragma unroll
            for (int n = 0; n < 4; ++n) bfA[n] = *(const bf16x8_t*)(vrow + (size_t)(16 * n) * 16384 + st * 64);
            __syncthreads();
#pragma unroll 1
            for (int kk = 0; kk < 2; ++kk) {
                bf16x8_t af[4];
#pragma unroll
                for (int m = 0; m < 4; ++m) {
                    const int r0 = kk * 32 + 8 * g + q, r1 = r0 + 4, ch = (wd * 64 + m * 16) / 8 + (pp >> 1);
                    const int f0 = ((r0 & 3) | ((r0 >> 1) & 4)) << 1, f1 = ((r1 & 3) | ((r1 >> 1) & 4)) << 1;
                    const s16x4_t a0 = __builtin_amdgcn_ds_read_tr16_b64_v4i16((LAS s16x4_t*)(Kb + r0 * 512 + ((ch ^ f0) << 4) + (pp & 1) * 8));
                    const s16x4_t a1 = __builtin_amdgcn_ds_read_tr16_b64_v4i16((LAS s16x4_t*)(Kb + r1 * 512 + ((ch ^ f1) << 4) + (pp & 1) * 8));
                    af[m] = (bf16x8_t){a0[0], a0[1], a0[2], a0[3], a1[0], a1[1], a1[2], a1[3]};
                }
#pragma unroll
                for (int n = 0; n < 4; ++n) bfB[n] = *(const bf16x8_t*)(vrow + (size_t)(16 * (4 + n)) * 16384 + st * 64 + kk * 32);
#pragma unroll
                for (int m = 0; m < 4; ++m)
#pragma unroll
                    for (int n = 0; n < 4; ++n) acc[m][n] = __builtin_amdgcn_mfma_f32_16x16x32_bf16(af[m], bfA[n], acc[m][n], 0, 0, 0);
                if (kk == 0) {
#pragma unroll
                    for (int n = 0; n < 4; ++n) bfA[n] = *(const bf16x8_t*)(vrow + (size_t)(16 * n) * 16384 + st * 64 + 32); }
#pragma unroll
                for (int m = 0; m < 4; ++m)
#pragma unroll
                    for (int n = 0; n < 4; ++n) acc[m][4 + n] = __builtin_amdgcn_mfma_f32_16x16x32_bf16(af[m], bfB[n], acc[m][4 + n], 0, 0, 0);
            }
        }
        __syncthreads();
        bf16_t* out = ST + ((size_t)bh * 15 + s) * ST_SLOT;
#pragma unroll
        for (int m = 0; m < 4; ++m)
#pragma unroll
            for (int n = 0; n < 8; ++n) { const int e = eh * 256 + we * 128 + n * 16 + i, d = wd * 64 + m * 16 + 4 * g;
                *(uint2*)(out + (size_t)e * 256 + d) = make_uint2(pg8::cvt_pk_bf16(acc[m][n][0], acc[m][n][1]), pg8::cvt_pk_bf16(acc[m][n][2], acc[m][n][3])); }
    }
}

__device__ void phase_ret_scan2(const Params& p) {
    bf16_t* ST = (bf16_t*)(p.ws + OFF_BIG + B_ST);
    for (int gid = obid() * 512 + otid(); gid < 8 * 16384; gid += gridDim.x * 512) {
        const int bh = gid >> 14, h = bh & 3; const size_t off = (size_t)(gid & 16383) * 8;
        const float cd = exp2f((float)RL * ret_lg(h));
        float S[8];
#pragma unroll
        for (int k = 0; k < 8; ++k) S[k] = 0.f;
        bf16_t* base = ST + (size_t)bh * 15 * ST_SLOT + off;
        v4u uu[15];
#pragma unroll
        for (int s = 0; s < 15; ++s) uu[s] = *(const v4u*)(base + s * ST_SLOT);
#pragma unroll
        for (int s = 0; s < 15; ++s) { const v4u u = uu[s];
            S[0] = S[0] * cd + bflo(u.x); S[1] = S[1] * cd + bfhi(u.x); S[2] = S[2] * cd + bflo(u.y); S[3] = S[3] * cd + bfhi(u.y);
            S[4] = S[4] * cd + bflo(u.z); S[5] = S[5] * cd + bfhi(u.z); S[6] = S[6] * cd + bflo(u.w); S[7] = S[7] * cd + bfhi(u.w);
            v4u o; o.x = pg8::cvt_pk_bf16(S[0], S[1]); o.y = pg8::cvt_pk_bf16(S[2], S[3]); o.z = pg8::cvt_pk_bf16(S[4], S[5]); o.w = pg8::cvt_pk_bf16(S[6], S[7]);
            *(v4u*)(base + s * ST_SLOT) = o;
        }
    }
}

__device__ void phase_ret_out(const Params& p, unsigned char* lds) {
    const int tid = otid(), wave = __builtin_amdgcn_readfirstlane(tid >> 6), lane = tid & 63, g = lane >> 4, i = lane & 15;
    LAS unsigned char* Ks = (LAS unsigned char*)lds;
    LAS unsigned char* Ps = Ks + 65536;
    LAS float* red = (LAS float*)(Ks + 98304);
    const bf16_t* QK = (const bf16_t*)(p.ws + OFF_BIG + B_QK); const bf16_t* Vt = (const bf16_t*)(p.ws + OFF_BIG + B_V); const bf16_t* ST = (const bf16_t*)(p.ws + OFF_BIG + B_ST);
    bf16_t* O = (bf16_t*)(p.ws + OFF_BIG + B_O);
    for (int unit = obid(); unit < 256; unit += gridDim.x) {
        const int pi = unit & 1, s = (unit >> 1) & 15, bh = unit >> 5, b = bh >> 2, h = bh & 3;
        const float lg = ret_lg(h);
#pragma unroll 1
        for (int half = 0; half < 2; ++half) {
            const int a = half ? 3 - pi : pi;
            const size_t trow0 = (size_t)b * SEQ + s * RL + a * 128;
            v4f o[4][8];
#pragma unroll
            for (int mt = 0; mt < 4; ++mt)
#pragma unroll
                for (int nt = 0; nt < 8; ++nt) o[mt][nt] = (v4f){0.f, 0.f, 0.f, 0.f};
            if (s > 0) {
                const bf16_t* sp = ST + ((size_t)bh * 15 + (s - 1)) * ST_SLOT + (size_t)(wave * 64 + i) * 256 + 8 * g;
                const bf16_t* qp = QK + (trow0 + i) * 2048 + h * 256 + 8 * g;
#pragma unroll 1
                for (int ks = 0; ks < 8; ++ks) {
                    bf16x8_t af[4];
#pragma unroll
                    for (int mt = 0; mt < 4; ++mt) af[mt] = *(const bf16x8_t*)(sp + (size_t)(16 * mt) * 256 + ks * 32);
#pragma unroll
                    for (int nh = 0; nh < 2; ++nh) { bf16x8_t bfq[4];
#pragma unroll
                        for (int nt = 0; nt < 4; ++nt) bfq[nt] = *(const bf16x8_t*)(qp + (size_t)(16 * (nh * 4 + nt)) * 2048 + ks * 32);
#pragma unroll
                        for (int mt = 0; mt < 4; ++mt)
#pragma unroll
                            for (int nt = 0; nt < 4; ++nt) o[mt][nh * 4 + nt] = __builtin_amdgcn_mfma_f32_16x16x32_bf16(af[mt], bfq[nt], o[mt][nh * 4 + nt], 0, 0, 0); }
                }
#pragma unroll
                for (int nt = 0; nt < 8; ++nt) { const float sc = exp2f((float)(a * 128 + nt * 16 + i + 1) * lg);
#pragma unroll
                    for (int mt = 0; mt < 4; ++mt) o[mt][nt] = o[mt][nt] * sc; }
            }
#pragma unroll 1
            for (int j = 0; j <= a; ++j) {
                __syncthreads();
                { const bf16_t* krow = QK + ((size_t)b * SEQ + s * RL + j * 128) * 2048 + 1024 + h * 256;
#pragma unroll
                    for (int it = 0; it < 8; ++it) { const int idx = it * 512 + tid, row = idx >> 5, ch = idx & 31;
                        *(LAS v4u*)(Ks + row * 512 + ((ch ^ (row & 15)) << 4)) = *(const v4u*)(krow + (size_t)row * 2048 + ch * 8); } }
                __syncthreads();
                {
                    const bf16_t* qp = QK + (trow0 + wave * 16 + i) * 2048 + h * 256 + 8 * g;
                    const int prow = wave * 16 + i, tq = a * 128 + prow;
#pragma unroll 1
                    for (int kh = 0; kh < 2; ++kh) {
                        v4f st[4];
#pragma unroll
                        for (int kt = 0; kt < 4; ++kt) st[kt] = (v4f){0.f, 0.f, 0.f, 0.f};
#pragma unroll 2
                        for (int ks = 0; ks < 8; ++ks) { const bf16x8_t bq = *(const bf16x8_t*)(qp + ks * 32);
#pragma unroll
                            for (int kt = 0; kt < 4; ++kt) { const int row = (kh * 4 + kt) * 16 + i; const bf16x8_t ak = *(const LAS bf16x8_t*)(Ks + row * 512 + (((ks * 4 + g) ^ (row & 15)) << 4));
                                st[kt] = __builtin_amdgcn_mfma_f32_16x16x32_bf16(ak, bq, st[kt], 0, 0, 0); } }
#pragma unroll
                        for (int kt = 0; kt < 4; ++kt) { float v[4]; const int ktt = kh * 4 + kt;
#pragma unroll
                            for (int r = 0; r < 4; ++r) { const int dist = tq - (j * 128 + ktt * 16 + 4 * g + r); v[r] = dist >= 0 ? st[kt][r] * exp2f((float)dist * lg) : 0.f; }
                            const int ch = 2 * ktt + (g >> 1);
                            pg8::u32x2 pw; pw.x = pg8::cvt_pk_bf16(v[0], v[1]); pw.y = pg8::cvt_pk_bf16(v[2], v[3]); *(LAS pg8::u32x2*)(Ps + prow * 256 + ((ch ^ (prow & 15)) << 4) + (g & 1) * 8) = pw; }
                    }
                }
                __syncthreads();
                const bf16_t* vp = Vt + (size_t)(h * 512 + wave * 64 + i) * 16384 + (size_t)b * SEQ + s * RL + j * 128 + 8 * g;
#pragma unroll 1
                for (int ks = 0; ks < 4; ++ks) {
                    bf16x8_t af[4];
#pragma unroll
                    for (int mt = 0; mt < 4; ++mt) af[mt] = *(const bf16x8_t*)(vp + (size_t)(16 * mt) * 16384 + ks * 32);
#pragma unroll
                    for (int nh = 0; nh < 2; ++nh) { bf16x8_t bp[4];
#pragma unroll
                        for (int nt = 0; nt < 4; ++nt) { const int row = (nh * 4 + nt) * 16 + i; bp[nt] = *(const LAS bf16x8_t*)(Ps + row * 256 + (((ks * 4 + g) ^ (row & 15)) << 4)); }
#pragma unroll
                        for (int mt = 0; mt < 4; ++mt)
#pragma unroll
                            for (int nt = 0; nt < 4; ++nt) o[mt][nh * 4 + nt] = __builtin_amdgcn_mfma_f32_16x16x32_bf16(af[mt], bp[nt], o[mt][nh * 4 + nt], 0, 0, 0); }
                }
            }
            float ssq[8];
#pragma unroll
            for (int nt = 0; nt < 8; ++nt) { float a2 = 0.f;
#pragma unroll
                for (int mt = 0; mt < 4; ++mt)
#pragma unroll
                    for (int r = 0; r < 4; ++r) a2 += o[mt][nt][r] * o[mt][nt][r];
                a2 += __shfl_xor(a2, 16); a2 += __shfl_xor(a2, 32); ssq[nt] = a2; }
            __syncthreads();
            if (g == 0) {
#pragma unroll
                for (int nt = 0; nt < 8; ++nt) red[wave * 128 + nt * 16 + i] = ssq[nt]; }
            __syncthreads();
#pragma unroll
            for (int nt = 0; nt < 8; ++nt) { float tot = 0.f;
#pragma unroll
                for (int w = 0; w < 8; ++w) tot += red[w * 128 + nt * 16 + i];
                const float rstd = 1.0f / sqrtf(tot * (1.0f / 512.0f) + 1e-6f);
                bf16_t* po = O + (trow0 + nt * 16 + i) * 2048 + h * 512 + wave * 64 + 4 * g;
#pragma unroll
                for (int mt = 0; mt < 4; ++mt) { const uint2 gg = *(const uint2*)(po + mt * 16);
                    *(uint2*)(po + mt * 16) = make_uint2(pg8::cvt_pk_bf16(pg8::fsilu(bflo(gg.x)) * o[mt][nt][0] * rstd, pg8::fsilu(bfhi(gg.x)) * o[mt][nt][1] * rstd),
                                                         pg8::cvt_pk_bf16(pg8::fsilu(bflo(gg.y)) * o[mt][nt][2] * rstd, pg8::fsilu(bfhi(gg.y)) * o[mt][nt][3] * rstd)); } }
        }
    }
}

template <class Epi>
__device__ __forceinline__ void dense_gemm(unsigned char* lds, const bf16_t* A, const bf16_t* Bt, int N, int K, const Epi& E, int M = T) {
    pg8::Gemm g{A, Bt, M, N, K}; pg8::StaticOrder S; S.init(M, N, (int)gridDim.x, obid());
    pg8::gemm_phase<Epi, pg8::StaticOrder, true, true>((LAS unsigned char*)lds, g, S, E);
}

template <int STAGE>
__device__ __forceinline__ void expert_gemm(const Params& p, int L, unsigned char* lds) {
    Route R = get_route(p, L);
    LAS int* tab = (LAS int*)((LAS unsigned char*)lds + 131072);
    __syncthreads();
    if (otid() == 0) { int s = 0, b = 0; for (int e = 0; e < 16; ++e) { const int c = R.cnt[e]; tab[e] = s; tab[32 + e] = c; tab[48 + e] = b; s += ((c + 255) >> 8) * 4; b += (c + 255) & ~255; } tab[16] = s; }
    __syncthreads();
    const bf16_t* E = (const bf16_t*)(p.ws + OFF_BIG + B_E);
    bf16_t* HG = (bf16_t*)(p.ws + OFF_BIG + B_HG); bf16_t* YG = (bf16_t*)(p.ws + OFF_BIG + B_YG);
    if (STAGE == 1) {
        pg8::GroupedOrder<1> S{tab, (int)gridDim.x, obid(), R.list, (const char*)E};
        pg8::EpiExp1 Ep{HG, R.cwl, tab};
        pg8::gemm_phase_g<pg8::EpiExp1, pg8::GroupedOrder<1>, true>((LAS unsigned char*)lds, (const char*)(p.ws + OFF_XN), 1024, S, Ep);
    } else {
        pg8::GroupedOrder<2> S{tab, (int)gridDim.x, obid(), nullptr, (const char*)E + (2u << 20)};
        pg8::EpiExp2 Ep{YG};
        pg8::gemm_phase_g<pg8::EpiExp2, pg8::GroupedOrder<2>, true>((LAS unsigned char*)lds, (const char*)HG, 512, S, Ep);
    }
}

constexpr int NPHASE = 20;
__device__ __forceinline__ void run_phase(const Params& p, int ph, unsigned char* lds) {
    float* sm = (float*)lds;
    unsigned char* big = p.ws + OFF_BIG;
    const bf16_t* XN = (const bf16_t*)(p.ws + OFF_XN);
    const bf16_t* WB = (const bf16_t*)(p.ws + OFF_WB);
    switch (ph) {
    case 0: phase_prologue(p, lds); break;
    case 1: { pg8::EpiInproj E{(bf16_t*)(big + B_QK), (const float*)(p.ws + OFF_TABRET), (const float*)(p.ws + OFF_TABRET) + 8192 * 128};
        dense_gemm(lds, XN, WB + W_IN / 2, 2048, 1024, E);
        pg8::EpiVt E2{(bf16_t*)(big + B_V)};
        dense_gemm(lds, WB + W_IN / 2 + (size_t)2048 * 1024, XN, 16384, 1024, E2, 2048);
        pg8::EpiStore2048 E3{(bf16_t*)(big + B_O)};
        dense_gemm(lds, XN, WB + W_IN / 2 + (size_t)4096 * 1024, 2048, 1024, E3); } break;
    case 2: phase_ret_kv(p, lds); break;
    case 3: phase_ret_scan2(p); break;
    case 4: phase_ret_out(p, lds); break;
    case 5: { pg8::EpiResid E{p.x, p.out}; dense_gemm(lds, (const bf16_t*)(big + B_O), WB + W_OUT / 2, 1024, 2048, E); } break;
    case 6: convert_expert_weights(p, 0, lds); __syncthreads(); norm_pass<1>(p, 0, lds); break;
    case 7: expert_gemm<1>(p, 0, lds); break;
    case 8: expert_gemm<2>(p, 0, lds); break;
    case 9: norm_pass<2>(p, 0, lds); break;
    case 10: { pg8::EpiKVQ E{(bf16_t*)(big + B_K), (bf16_t*)(big + B_VB), (bf16_t*)(big + B_Q), (const float*)(p.ws + OFF_TABROPE), (const float*)(p.ws + OFF_TABROPE) + 8192 * 16, (float*)(p.ws + OFF_KMEAN)};
        dense_gemm(lds, XN, WB + W_KVQ / 2, 3072, 1024, E); } break;
    case 11: phase_moba_gate(p, lds); break;
    case 12: phase_moba_sel(p, lds); break;
    case 13: phase_moba_own(p, lds); break;
    case 14: { pg8::EpiResid E{p.out, p.out}; dense_gemm(lds, (const bf16_t*)(big + B_AO), WB + W_O / 2, 1024, 1024, E); } break;
    case 15: convert_expert_weights(p, 1, lds); __syncthreads(); norm_pass<1>(p, 1, lds); break;
    case 16: expert_gemm<1>(p, 1, lds); break;
    case 17: expert_gemm<2>(p, 1, lds); break;
    case 18: norm_pass<3>(p, 1, lds); break;
    default: break;
    }
}
constexpr int LAST_PHASE = 18;

#if MK_SINGLE
#define XB_TMO      128
#define XB_XCNT(j)  (256  + 64 * (j))
#define XB_XSUB(j)  (1280 + 64 * (j))
#define XB_XGEN(j)  (2304 + 64 * (j))
#define XB_TOP      3328
#define XB_TOPGEN   3392
#define XCD_BAR_WORDS 3456
#define XB_SPIN_CAP (1u << 18)

__device__ __forceinline__ unsigned xb_ld(unsigned* p)              { return __hip_atomic_load(p, __ATOMIC_RELAXED, __HIP_MEMORY_SCOPE_AGENT); }
__device__ __forceinline__ unsigned xb_add(unsigned* p, unsigned v) { return __hip_atomic_fetch_add(p, v, __ATOMIC_RELAXED, __HIP_MEMORY_SCOPE_AGENT); }
__device__ __forceinline__ unsigned xb_xcc_id() { return (unsigned)__builtin_amdgcn_s_getreg((3 << 11) | 20) & 0xFu; }
#define XB_SPIN(cond, bar) do { unsigned _sp = 0; while (cond) { __builtin_amdgcn_s_sleep(1); \
    if ((++_sp & 255u) == 0u) { if (xb_ld(&(bar)[XB_TMO])) break; if (_sp > XB_SPIN_CAP) { atomicAdd(&(bar)[XB_TMO], 1u); break; } } } } while (0)

struct XcdBarrier {
    unsigned* bar; unsigned x;
    volatile LAS unsigned* st;
};

__device__ __forceinline__ XcdBarrier xcd_barrier_post(unsigned* bar, volatile LAS unsigned* st) {
    XcdBarrier b; b.bar = bar; b.x = xb_xcc_id(); b.st = st;
    if (threadIdx.x == 0) (void)xb_add(&bar[XB_XCNT(b.x)], 1u);
    return b;
}
__device__ __forceinline__ void xcd_barrier_complete(unsigned* bar, unsigned x, unsigned& nloc, unsigned& nx) {
    const unsigned G = gridDim.x * gridDim.y * gridDim.z;
    unsigned sum, cnt, mine, sp = 0u;
    for (;;) {
        sum = 0u; cnt = 0u; mine = 0u;
#pragma unroll
        for (unsigned j = 0; j < 16; ++j) { const unsigned c = xb_ld(&bar[XB_XCNT(j)]); sum += c; cnt += (c > 0u) ? 1u : 0u; mine = (j == x) ? c : mine; }
        if (sum == G) break;
        __builtin_amdgcn_s_sleep(1);
        if ((++sp & 255u) == 0u) { if (xb_ld(&bar[XB_TMO])) break; if (sp > XB_SPIN_CAP) { atomicAdd(&bar[XB_TMO], 1u); break; } }
    }
    nloc = mine > 0u ? mine : 1u; nx = cnt > 0u ? cnt : 1u;
}

__device__ __forceinline__ void xcd_barrier(const XcdBarrier& b) {
    asm volatile("s_waitcnt vmcnt(0)" ::: "memory");
    __syncthreads();
    if (threadIdx.x == 0) {
        unsigned* bar = b.bar;
        __builtin_amdgcn_s_waitcnt(0);
        unsigned nloc = b.st[0], nx = b.st[1];
        if (nloc == 0u) { xcd_barrier_complete(bar, b.x, nloc, nx); b.st[0] = nloc; b.st[1] = nx; }
        const unsigned old = xb_add(&bar[XB_XSUB(b.x)], 1u);
        const unsigned gen = old / nloc;
        if (old + 1u == (gen + 1u) * nloc) {
            __builtin_amdgcn_fence(__ATOMIC_RELEASE, "agent");
            asm volatile("s_waitcnt vmcnt(0)" ::: "memory");
            const unsigned og = xb_add(&bar[XB_TOP], 1u);
            const unsigned tg = og / nx;
            if (og + 1u == (tg + 1u) * nx) xb_add(&bar[XB_TOPGEN], 1u);
            else XB_SPIN(xb_ld(&bar[XB_TOPGEN]) == tg, bar);
            __builtin_amdgcn_fence(__ATOMIC_ACQUIRE, "agent");
            xb_add(&bar[XB_XGEN(b.x)], 1u);
            asm volatile("s_waitcnt vmcnt(0)" ::: "memory");
        } else {
            XB_SPIN(xb_ld(&bar[XB_XGEN(b.x)]) == gen, bar);
            __builtin_amdgcn_fence(__ATOMIC_ACQUIRE, "agent");
            asm volatile("s_waitcnt vmcnt(0)" ::: "memory");
        }
    }
    __syncthreads();
}

constexpr size_t CTRL_BAR_OFF = 65536;
constexpr int PARAM_LDS_OFF = LDS_BYTES - 256;
constexpr int BARST_LDS_OFF = LDS_BYTES - 512;
__device__ __forceinline__ Params get_params(unsigned char* lds) {
    const LAS unsigned* w = (const LAS unsigned*)((LAS unsigned char*)lds + PARAM_LDS_OFF);
    union { Params p; unsigned u[sizeof(Params) / 4]; } x;
#pragma unroll
    for (int k = 0; k < (int)(sizeof(Params) / 4); ++k) x.u[k] = __builtin_amdgcn_readfirstlane(w[k]);
    return x.p;
}
template <int PH, int LAST> __device__ __forceinline__ void run_all(unsigned char* lds, cg::grid_group& grid, const XcdBarrier& bar) {
    { const Params q = get_params(lds); run_phase(q, PH, lds); }
    if constexpr (PH < LAST) {
        xcd_barrier(bar);
        run_all<PH + 1, LAST>(lds, grid, bar);
    }
}
__global__ void __launch_bounds__(512) mega(Params p) {
    extern __shared__ __attribute__((aligned(16))) unsigned char lds[];
    cg::grid_group grid = cg::this_grid();
    if (threadIdx.x == 0) { union { Params p; unsigned u[sizeof(Params) / 4]; } x; x.p = p; LAS unsigned* w = (LAS unsigned*)((LAS unsigned char*)lds + PARAM_LDS_OFF);
#pragma unroll
        for (int k = 0; k < (int)(sizeof(Params) / 4); ++k) w[k] = x.u[k];
        LAS unsigned* st = (LAS unsigned*)((LAS unsigned char*)lds + BARST_LDS_OFF); st[0] = 0u; st[1] = 0u; }
    __syncthreads();
    const XcdBarrier bar = xcd_barrier_post((unsigned*)(p.ws + OFF_CTRL + CTRL_BAR_OFF), (volatile LAS unsigned*)((LAS unsigned char*)lds + BARST_LDS_OFF));
    if (p.ws == nullptr) grid.sync();
    run_all<0, LAST_PHASE>(lds, grid, bar);
}
#else
template <int PH> __global__ void __launch_bounds__(512) phase_kernel(Params p) {
    extern __shared__ __attribute__((aligned(16))) unsigned char lds[];
    run_phase(p, PH, lds);
}
template <int PH> static void launch_phases(const Params& p, int grid, hipStream_t stream) {
    if constexpr (PH <= LAST_PHASE) {
        static bool attr = false;
        if (!attr) { (void)hipFuncSetAttribute((const void*)phase_kernel<PH>, hipFuncAttributeMaxDynamicSharedMemorySize, LDS_BYTES); attr = true; }
        phase_kernel<PH><<<grid, 512, LDS_BYTES, stream>>>(p); launch_phases<PH + 1>(p, grid, stream); }
}
#endif

extern "C" void kernel_launch(void* const* d_in, const int* in_sizes, int n_in, void* d_out, int out_size, void* d_ws, size_t ws_size, hipStream_t stream) {
    if (ws_size < WS_NEED) { fprintf(stderr, "workspace too small: %zu < %zu\n", ws_size, WS_NEED); return; }
    Params p{};
    p.x = (const float*)d_in[0]; p.ret_norm = (const float*)d_in[1]; p.ret_w_in = (const float*)d_in[2]; p.ret_w_out = (const float*)d_in[3]; p.kv_norm = (const float*)d_in[4];
    p.w_kv = (const float*)d_in[5]; p.attn_norm = (const float*)d_in[6]; p.w_q = (const float*)d_in[7]; p.w_o = (const float*)d_in[8]; p.ffn_norm = (const float*)d_in[9];
    p.rg_w = (const float*)d_in[10]; p.rg_b = (const float*)d_in[11]; p.re_w = (const float*)d_in[12]; p.re_b = (const float*)d_in[13]; p.wg = (const float*)d_in[14];
    p.wu = (const float*)d_in[15]; p.wd = (const float*)d_in[16]; p.final_norm = (const float*)d_in[17];
    p.out = (float*)d_out; p.ws = (unsigned char*)d_ws;
    static int grid_blocks = 0;
    if (!grid_blocks) {
        int dev = 0, cus = 0, per_cu = 0;
        (void)hipGetDevice(&dev);
        (void)hipDeviceGetAttribute(&cus, hipDeviceAttributeMultiprocessorCount, dev);
#if MK_SINGLE
        if (hipFuncSetAttribute((const void*)mega, hipFuncAttributeMaxDynamicSharedMemorySize, LDS_BYTES) != hipSuccess) fprintf(stderr, "hipFuncSetAttribute failed\n");
        if (hipOccupancyMaxActiveBlocksPerMultiprocessor(&per_cu, (const void*)mega, 512, LDS_BYTES) != hipSuccess || per_cu < 1) fprintf(stderr, "occupancy query: %d blocks per CU\n", per_cu);
#endif
        grid_blocks = cus;
    }
#if MK_SINGLE
    if (hipMemsetAsync((unsigned char*)d_ws + OFF_CTRL, 0, 131072, stream) != hipSuccess) fprintf(stderr, "memset failed\n");
    void* args[] = {&p};
    hipError_t e = hipLaunchCooperativeKernel((void*)mega, dim3(grid_blocks), dim3(512), args, LDS_BYTES, stream);
    if (e != hipSuccess) fprintf(stderr, "cooperative launch failed: %s (grid %d)\n", hipGetErrorString(e), grid_blocks);
#else
    launch_phases<0>(p, grid_blocks, stream);
#endif
}
```
